# Optimizing an MI355X kernel written in HIP

```python
import jax, jax.numpy as jnp
from jax import lax
import numpy as np

D_MODEL = 1024
BATCH = 2
SEQ = 8192
DEPTH = 2

N_MIXERS = 2
N_A = (DEPTH + 1) // 2
N_B = DEPTH // 2
HG_EXPAND = 128
HG_HEADS = D_MODEL // 128
HG_FDIM = HG_HEADS * HG_EXPAND
HG_VDIM = D_MODEL // HG_HEADS
HG_CHUNK = 64
FOX_HEAD_DIM = 64
FOX_HEADS = D_MODEL // FOX_HEAD_DIM
FOX_BLOCK = 128
D_FF = 4 * D_MODEL
N_MOD = 6
EPS = 1e-6

kernel_name = "hybrid_hgrn2_fox_adaln_block"


def rmsnorm(x, w):
    xf = x.astype(jnp.float32)
    y = xf * lax.rsqrt(jnp.mean(xf * xf, axis=-1, keepdims=True) + EPS)
    return (y * w.astype(jnp.float32)).astype(x.dtype)


def modulate(x, w, shift, scale):
    return rmsnorm(x, w) * (1 + scale[:, None, :]) + shift[:, None, :]


def hgrn2_mixer(h, w_in, w_out, lb, gn_w):
    B, S, _ = h.shape
    H, dk, dv, C = HG_HEADS, HG_EXPAND, HG_VDIM, HG_CHUNK
    N = S // C
    proj = h @ w_in
    q, fz, i, g = jnp.split(proj, [HG_FDIM, 2 * HG_FDIM, 2 * HG_FDIM + D_MODEL], axis=-1)
    q = jax.nn.silu(q.astype(jnp.float32))
    lbf = lb.astype(jnp.float32)
    logf = jnp.logaddexp(jnp.log(lbf), jnp.log1p(-lbf) + jax.nn.log_sigmoid(fz.astype(jnp.float32)))
    k = -jnp.expm1(logf)
    v = i.astype(jnp.float32)

    def to_chunks(t, d):
        return t.reshape(B, N, C, H, d).transpose(1, 0, 3, 2, 4)

    qc, kc, gc, vc = to_chunks(q, dk), to_chunks(k, dk), to_chunks(logf, dk), to_chunks(v, dv)
    causal = jnp.tril(jnp.ones((C, C), dtype=bool))

    def step(state, inp):
        qb, kb, gb, vb = inp
        G = jnp.cumsum(gb, axis=2)
        diff = G[:, :, :, None, :] - G[:, :, None, :, :]
        decay = jnp.exp(jnp.where(causal[:, :, None], diff, -jnp.inf))
        A = jnp.einsum('bhtk,bhsk,bhtsk->bhts', qb, kb, decay)
        o = jnp.einsum('bhts,bhsv->bhtv', A, vb) + jnp.einsum('bhtk,bhkv->bhtv', qb * jnp.exp(G), state)
        G_last = G[:, :, -1:, :]
        new_state = jnp.exp(G_last[:, :, 0, :])[..., None] * state + \
            jnp.einsum('bhsk,bhsv->bhkv', kb * jnp.exp(G_last - G), vb)
        return new_state, o

    state0 = jnp.zeros((B, H, dk, dv), jnp.float32)
    _, o = lax.scan(step, state0, (qc, kc, gc, vc))
    o = o.transpose(1, 0, 3, 2, 4).reshape(B, S, H, dv)
    o = rmsnorm(o, gn_w).reshape(B, S, D_MODEL)
    o = (o * jax.nn.silu(g.astype(jnp.float32))).astype(h.dtype)
    return o @ w_out


def fox_mixer(h, w_in, b_f, qn_w, kn_w, w_out):
    B, S, _ = h.shape
    H, dh, blk = FOX_HEADS, FOX_HEAD_DIM, FOX_BLOCK
    proj = h @ w_in
    q, k, v, g, fz = jnp.split(proj, [D_MODEL, 2 * D_MODEL, 3 * D_MODEL, 4 * D_MODEL], axis=-1)
    q = rmsnorm(q.reshape(B, S, H, dh), qn_w).transpose(0, 2, 1, 3)
    k = rmsnorm(k.reshape(B, S, H, dh), kn_w).transpose(0, 2, 1, 3)
    v = v.reshape(B, S, H, dh).transpose(0, 2, 1, 3)
    logf = jax.nn.log_sigmoid(fz.astype(jnp.float32) + b_f.astype(jnp.float32))
    F = jnp.cumsum(logf, axis=1).transpose(0, 2, 1)
    scale = 1.0 / np.sqrt(dh)
    kpos = jnp.arange(S)

    def block(bi):
        start = bi * blk
        qb = lax.dynamic_slice_in_dim(q, start, blk, axis=2)
        Fq = lax.dynamic_slice_in_dim(F, start, blk, axis=2)
        s = jnp.einsum('bhqd,bhkd->bhqk', qb, k).astype(jnp.float32) * scale
        s = s + (Fq[..., :, None] - F[..., None, :])
        qpos = start + jnp.arange(blk)
        s = jnp.where(kpos[None, :] <= qpos[:, None], s, -jnp.inf)
        p = jax.nn.softmax(s, axis=-1)
        return jnp.einsum('bhqk,bhkd->bhqd', p.astype(v.dtype), v)

    o = lax.map(block, jnp.arange(S // blk))
    o = o.transpose(1, 0, 3, 2, 4).reshape(B, S, D_MODEL)
    o = o * jax.nn.sigmoid(g)
    return o @ w_out


def sqrelu_mlp(h, w1, w2):
    a = jax.nn.relu(h @ w1)
    return (a * a) @ w2


def setup_inputs(seed: int = 0) -> dict:
    key = jax.random.key(seed)
    ks = jax.random.split(key, 20)
    D, F = D_MODEL, HG_FDIM
    nrm = jax.random.normal
    return {
        "x": nrm(ks[0], (BATCH, SEQ, D), jnp.float32),
        "c": nrm(ks[1], (BATCH, D), jnp.float32),
        "w_mod": nrm(ks[2], (DEPTH, D, N_MOD * D), jnp.float32) * (0.5 * D ** -0.5),
        "b_mod": nrm(ks[3], (DEPTH, N_MOD * D), jnp.float32) * 0.02,
        "norm1_w": 1.0 + 0.05 * nrm(ks[4], (DEPTH, D), jnp.float32),
        "norm2_w": 1.0 + 0.05 * nrm(ks[5], (DEPTH, D), jnp.float32),
        "hg_w_in": nrm(ks[6], (N_A, D, 2 * F + 2 * D), jnp.float32) * D ** -0.5,
        "hg_w_out": nrm(ks[7], (N_A, D, D), jnp.float32) * D ** -0.5,
        "hg_lb": 0.5 * nrm(ks[8], (DEPTH + 1, F), jnp.float32),
        "hg_gn_w": 1.0 + 0.05 * nrm(ks[9], (N_A, HG_VDIM), jnp.float32),
        "fox_w_in": nrm(ks[10], (N_B, D, 4 * D + FOX_HEADS), jnp.float32) * D ** -0.5,
        "fox_b_f": jax.random.uniform(ks[11], (N_B, FOX_HEADS), jnp.float32, 1.0, 4.0),
        "fox_qn_w": 1.0 + 0.05 * nrm(ks[12], (N_B, FOX_HEAD_DIM), jnp.float32),
        "fox_kn_w": 1.0 + 0.05 * nrm(ks[13], (N_B, FOX_HEAD_DIM), jnp.float32),
        "fox_w_out": nrm(ks[14], (N_B, D, D), jnp.float32) * D ** -0.5,
        "mlp_w1": nrm(ks[15], (DEPTH, D, D_FF), jnp.float32) * D ** -0.5,
        "mlp_w2": nrm(ks[16], (DEPTH, D_FF, D), jnp.float32) * D_FF ** -0.5,
        "final_w": 1.0 + 0.05 * nrm(ks[17], (D,), jnp.float32),
    }


def reference(x, c, w_mod, b_mod, norm1_w, norm2_w, hg_w_in, hg_w_out, hg_lb, hg_gn_w,
              fox_w_in, fox_b_f, fox_qn_w, fox_kn_w, fox_w_out, mlp_w1, mlp_w2, final_w):
    lb_all = jnp.cumsum(jax.nn.softmax(hg_lb.astype(jnp.float32), axis=0), axis=0)
    c_act = jax.nn.silu(c)
    for i in range(DEPTH):
        mod = c_act @ w_mod[i] + b_mod[i]
        sh1, sc1, g1, sh2, sc2, g2 = jnp.split(mod, N_MOD, axis=-1)
        h = modulate(x, norm1_w[i], sh1, sc1)
        j = i // N_MIXERS
        if i % N_MIXERS == 0:
            y = hgrn2_mixer(h, hg_w_in[j], hg_w_out[j], lb_all[i], hg_gn_w[j])
        else:
            y = fox_mixer(h, fox_w_in[j], fox_b_f[j], fox_qn_w[j], fox_kn_w[j], fox_w_out[j])
        x = x + g1[:, None, :] * y
        h = modulate(x, norm2_w[i], sh2, sc2)
        x = x + g2[:, None, :] * sqrelu_mlp(h, mlp_w1[i], mlp_w2[i])
    return rmsnorm(x, final_w)
```

```cpp
#include <hip/hip_runtime.h>
#include <hip/hip_cooperative_groups.h>
#include <cstdio>
#include <cstdint>
namespace cg = cooperative_groups;
namespace pg8 {
#define PG8_LAS __attribute__((address_space(3)))
typedef unsigned short bf16_t;
typedef short bf16x8 __attribute__((ext_vector_type(8)));
typedef float f32x4 __attribute__((ext_vector_type(4)));
typedef unsigned u32x4 __attribute__((ext_vector_type(4)));
constexpr int BM = 256, BK = 64, HALF = 128, HTB = HALF * BK * 2  , STAGE_BYTES = 8 * HTB, NXCD = 8, WGM = 8;

__host__ __device__ __forceinline__ int lds_byte(int r, int c) { const int st = (r >> 4) * 2 + (c >> 5), rr = r & 15, cc = c & 31, ob = rr * 64 + cc * 2; return st * 1024 + (ob ^ (((ob >> 9) & 1) << 5)); }
__host__ __device__ __forceinline__ void stage_rc(int b, int& R, int& C) { const int st = b / 1024, sb = b % 1024, swz = sb ^ (((sb >> 9) & 1) << 5); R = (st >> 1) * 16 + swz / 64; C = (st & 1) * 32 + (swz % 64) / 2; }
__host__ __device__ __forceinline__ int perm32(int rho) { const int n = rho >> 4, i = rho & 15; return 8 * (i >> 2) + 4 * n + (i & 3); }

struct Unit { int pm, pn; };
struct Gemm { const bf16_t* A; const bf16_t* Bt; int M, N, K; };

struct StaticOrder {
    int nM, nN, nwg, G, c;
    __host__ __device__ void init(int M, int N, int G_, int c_) { nM = M / BM; nN = N / BM; nwg = nM * nN; G = G_; c = c_; }
    __host__ __device__ bool next(int i, Unit& u) const {
        const long L = (long)i * G + c; if (L >= nwg) return false;
        int wgid = (int)L; { const int q = nwg / NXCD, r = nwg % NXCD, xcd = wgid % NXCD, off = wgid / NXCD; wgid = (xcd < r ? xcd * (q + 1) : r * (q + 1) + (xcd - r) * q) + off; }
        const int nig = WGM * nN, gid = wgid / nig, fm = gid * WGM, gsz = (nM - fm) < WGM ? (nM - fm) : WGM;
        u.pm = fm + ((wgid % nig) % gsz); u.pn = (wgid % nig) / gsz; return true;
    }
    __device__ __forceinline__ void a_ready(const Unit&) const {}
    __device__ __forceinline__ void done(const Unit&) const {}
};

typedef float f32x2_cv __attribute__((ext_vector_type(2))); typedef __bf16 bf16x2_cv __attribute__((ext_vector_type(2)));
__device__ __forceinline__ unsigned cvt_pk_bf16(float lo, float hi) { f32x2_cv v = {lo, hi}; bf16x2_cv b = __builtin_convertvector(v, bf16x2_cv); return __builtin_bit_cast(unsigned, b); }
typedef float f32x2 __attribute__((ext_vector_type(2)));
enum { EPI_HG_IN = 0, EPI_FOX_IN = 1, EPI_RES = 2, EPI_RELU2 = 3 };
__device__ __forceinline__ float sigmoid_f(float z) { return __builtin_amdgcn_rcpf(1.0f + __expf(-z)); }
template <int MODE> struct Epi {
    static constexpr bool PERM = true, AFTER_DRAIN = false;
    bf16_t* o0;
    static constexpr size_t OSTR = (size_t)16 * 1024 * 1024;
    float* f0;
    const float* base;
    const float* p0;
    float qscale;
    __device__ __forceinline__ void operator()(const f32x4 (&acc)[2][2][4][2], const Unit& u, int wr, int wc, int fr, int fq) const {
        const int row0 = u.pm * BM + wr * 64 + fr;
        if constexpr (MODE == EPI_HG_IN) {
            const int seg = u.pn >> 2, col0 = (u.pn & 3) * BM + wc * 32 + 8 * fq;
            if (seg == 1) {
                f32x4 lbv[2][2];
#pragma unroll
                for (int bj = 0; bj < 2; ++bj)
#pragma unroll
                    for (int n = 0; n < 2; ++n) lbv[bj][n] = *(const f32x4*)(p0 + col0 + bj * HALF + 4 * n);
#pragma unroll
                for (int ai = 0; ai < 2; ++ai)
#pragma unroll
                    for (int m = 0; m < 4; ++m) { float* rowp = f0 + (size_t)(row0 + ai * HALF + m * 16) * 1024 + col0;
#pragma unroll
                        for (int bj = 0; bj < 2; ++bj)
#pragma unroll
                            for (int n = 0; n < 2; ++n) { const f32x4 z = acc[ai][bj][m][n], lb = lbv[bj][n]; f32x4 o;
#pragma unroll
                                for (int e = 0; e < 4; ++e) o[e] = __logf(lb[e] + (1.0f - lb[e]) * sigmoid_f(z[e]));
                                *(f32x4*)(rowp + bj * HALF + 4 * n) = o; } }
            } else {
                bf16_t* ob = o0 + (size_t)(seg == 0 ? 0 : seg - 1) * OSTR;
#pragma unroll
                for (int ai = 0; ai < 2; ++ai)
#pragma unroll
                    for (int m = 0; m < 4; ++m) { bf16_t* rowp = ob + (size_t)(row0 + ai * HALF + m * 16) * 1024 + col0;
#pragma unroll
                        for (int bj = 0; bj < 2; ++bj) { f32x4 v0 = acc[ai][bj][m][0], v1 = acc[ai][bj][m][1];
                            if (seg != 2) {
#pragma unroll
                                for (int e = 0; e < 4; ++e) { v0[e] = v0[e] * sigmoid_f(v0[e]); v1[e] = v1[e] * sigmoid_f(v1[e]); } }
                            u32x4 w; w.x = cvt_pk_bf16(v0[0], v0[1]); w.y = cvt_pk_bf16(v0[2], v0[3]); w.z = cvt_pk_bf16(v1[0], v1[1]); w.w = cvt_pk_bf16(v1[2], v1[3]);
                            *(u32x4*)(rowp + bj * HALF) = w; } }
            }
        } else if constexpr (MODE == EPI_FOX_IN) {
            const int seg = u.pn >> 2, colt = (u.pn & 3) * BM;
            if (seg <= 1) {
                const float* w = p0 + 64 * seg; const float sc = seg == 0 ? qscale : 1.0f; bf16_t* ob = o0 + (size_t)seg * OSTR;
                f32x4 wv[2][2];
#pragma unroll
                for (int bj = 0; bj < 2; ++bj)
#pragma unroll
                    for (int n = 0; n < 2; ++n) wv[bj][n] = *(const f32x4*)(w + 32 * bj + 8 * fq + 4 * n);
#pragma unroll
                for (int ai = 0; ai < 2; ++ai)
#pragma unroll
                    for (int m = 0; m < 4; ++m) { float ss = 0.f;
#pragma unroll
                        for (int bj = 0; bj < 2; ++bj)
#pragma unroll
                            for (int n = 0; n < 2; ++n) { const f32x4 x = acc[ai][bj][m][n]; ss += (x[0] * x[0] + x[1] * x[1]) + (x[2] * x[2] + x[3] * x[3]); }
                        ss += __shfl_xor(ss, 16); ss += __shfl_xor(ss, 32);
                        const float rs = __builtin_amdgcn_rsqf(ss * (1.0f / 64.0f) + 1e-6f) * sc;
                        bf16_t* rowp = ob + (size_t)(row0 + ai * HALF + m * 16) * 1024 + colt + 64 * wc + 8 * fq;
#pragma unroll
                        for (int bj = 0; bj < 2; ++bj) { const f32x4 v0 = acc[ai][bj][m][0] * rs * wv[bj][0], v1 = acc[ai][bj][m][1] * rs * wv[bj][1];
                            u32x4 ww; ww.x = cvt_pk_bf16(v0[0], v0[1]); ww.y = cvt_pk_bf16(v0[2], v0[3]); ww.z = cvt_pk_bf16(v1[0], v1[1]); ww.w = cvt_pk_bf16(v1[2], v1[3]);
                            *(u32x4*)(rowp + 32 * bj) = ww; } }
            } else {
                bf16_t* ob = o0 + (size_t)seg * OSTR; const int col0 = colt + wc * 32 + 8 * fq;
#pragma unroll
                for (int ai = 0; ai < 2; ++ai)
#pragma unroll
                    for (int m = 0; m < 4; ++m) { bf16_t* rowp = ob + (size_t)(row0 + ai * HALF + m * 16) * 1024 + col0;
#pragma unroll
                        for (int bj = 0; bj < 2; ++bj) { f32x4 v0 = acc[ai][bj][m][0], v1 = acc[ai][bj][m][1];
                            if (seg == 3) {
#pragma unroll
                                for (int e = 0; e < 4; ++e) { v0[e] = sigmoid_f(v0[e]); v1[e] = sigmoid_f(v1[e]); } }
                            u32x4 w; w.x = cvt_pk_bf16(v0[0], v0[1]); w.y = cvt_pk_bf16(v0[2], v0[3]); w.z = cvt_pk_bf16(v1[0], v1[1]); w.w = cvt_pk_bf16(v1[2], v1[3]);
                            *(u32x4*)(rowp + bj * HALF) = w; } }
            }
        } else if constexpr (MODE == EPI_RES) {
            const int col0 = u.pn * BM + wc * 32 + 8 * fq; const float* gp = p0 + (size_t)(u.pm >> 5) * 6144 + col0;
            f32x4 gv[2][2];
#pragma unroll
            for (int bj = 0; bj < 2; ++bj)
#pragma unroll
                for (int n = 0; n < 2; ++n) gv[bj][n] = *(const f32x4*)(gp + bj * HALF + 4 * n);
#pragma unroll
            for (int ai = 0; ai < 2; ++ai)
#pragma unroll
                for (int m = 0; m < 4; ++m) { const size_t off = (size_t)(row0 + ai * HALF + m * 16) * 1024 + col0;
#pragma unroll
                    for (int bj = 0; bj < 2; ++bj)
#pragma unroll
                        for (int n = 0; n < 2; ++n) { const f32x4 bs = *(const f32x4*)(base + off + bj * HALF + 4 * n);
                            *(f32x4*)(f0 + off + bj * HALF + 4 * n) = bs + gv[bj][n] * acc[ai][bj][m][n]; } }
        } else {
            const int col0 = u.pn * BM + wc * 32 + 8 * fq;
#pragma unroll
            for (int ai = 0; ai < 2; ++ai)
#pragma unroll
                for (int m = 0; m < 4; ++m) { bf16_t* rowp = o0 + (size_t)(row0 + ai * HALF + m * 16) * 4096 + col0;
#pragma unroll
                    for (int bj = 0; bj < 2; ++bj) { f32x4 v0 = acc[ai][bj][m][0], v1 = acc[ai][bj][m][1];
#pragma unroll
                        for (int e = 0; e < 4; ++e) { const float a = fmaxf(v0[e], 0.f), b = fmaxf(v1[e], 0.f); v0[e] = a * a; v1[e] = b * b; }
                        u32x4 w; w.x = cvt_pk_bf16(v0[0], v0[1]); w.y = cvt_pk_bf16(v0[2], v0[3]); w.z = cvt_pk_bf16(v1[0], v1[1]); w.w = cvt_pk_bf16(v1[2], v1[3]);
                        *(u32x4*)(rowp + bj * HALF) = w; } }
        }
    }
};
template <class Epi, class Sched, bool ALIGN_EPI = false, bool SP2 = false>
__device__ __forceinline__ void gemm_phase(PG8_LAS unsigned char* lds, const Gemm g, const Sched& S, const Epi& E) {
    int tid_ = threadIdx.x; asm volatile("" : "+v"(tid_));
    const int tid = tid_, wid = __builtin_amdgcn_readfirstlane(tid >> 6), lane = tid & 63, wr = wid >> 2, wc = wid & 3, fr = lane & 15, fq = lane >> 4;
    const int K = g.K, nt = K / BK;
    unsigned voffA[2], voffB[2];
#pragma unroll
    for (int i = 0; i < 2; ++i) { int R, C; stage_rc(tid * 16 + i * 8192, R, C); const int Rb = Epi::PERM ? ((R & ~31) + perm32(R & 31)) : R;
        voffA[i] = (unsigned)(R * K + C) * 2u; voffB[i] = (unsigned)(Rb * K + C) * 2u; }
    const size_t kstep = (size_t)(BK * 2);
    const size_t hstep = (size_t)HALF * K * 2;
    const size_t tstep = 2 * hstep;
    const unsigned ldsw = (unsigned)wid * 1024u;
    const int aoff = lds_byte(wr * 64 + fr, fq * 8), boff = lds_byte(wc * 32 + fr, fq * 8);
#define PG8_SA(b, h) (((b) * 2 + (h)) * HTB)
#define PG8_SB(b, h) ((4 + (b) * 2 + (h)) * HTB)
#define PG8_STAGE(bufoff, gbase, voff) do { _Pragma("unroll") for (int _i = 0; _i < 2; ++_i) \
        __builtin_amdgcn_global_load_lds((const unsigned*)((const char*)(gbase) + (voff)[_i]), (PG8_LAS unsigned*)(lds + (bufoff) + ldsw + _i * 8192), 16, 0, 0); } while (0)
#define PG8_LDA(dst, b, h) do { _Pragma("unroll") for (int m = 0; m < 4; ++m) _Pragma("unroll") for (int k = 0; k < 2; ++k) dst[m][k] = *(const PG8_LAS bf16x8*)(lds + PG8_SA(b, h) + aoff + m * 2048 + k * 1024); } while (0)
#define PG8_LDB(dst, b, h) do { _Pragma("unroll") for (int n = 0; n < 2; ++n) _Pragma("unroll") for (int k = 0; k < 2; ++k) dst[n][k] = *(const PG8_LAS bf16x8*)(lds + PG8_SB(b, h) + boff + n * 2048 + k * 1024); } while (0)
#define PG8_MMA(ai, bj, At, Bt) do { __builtin_amdgcn_s_setprio(1); _Pragma("unroll") for (int m = 0; m < 4; ++m) _Pragma("unroll") for (int n = 0; n < 2; ++n) _Pragma("unroll") for (int k = 0; k < 2; ++k) \
        acc[ai][bj][m][n] = __builtin_amdgcn_mfma_f32_16x16x32_bf16(Bt[n][k], At[m][k], acc[ai][bj][m][n], 0, 0, 0); __builtin_amdgcn_s_setprio(0); } while (0)
#define PG8_WAIT_V(n) asm volatile("s_waitcnt vmcnt(" #n ")" ::: "memory")
#define PG8_WAIT_L(n) asm volatile("s_waitcnt lgkmcnt(" #n ")" ::: "memory")
#define PG8_BAR __builtin_amdgcn_s_barrier()
#define PG8_SCHED __builtin_amdgcn_sched_barrier(0)
    Unit cur, nxt; int ui = 0;
    if (!S.next(0, cur)) return;
    f32x4 acc[2][2][4][2];
#pragma unroll
    for (int a = 0; a < 2; ++a)
#pragma unroll
        for (int b = 0; b < 2; ++b)
#pragma unroll
            for (int m = 0; m < 4; ++m)
#pragma unroll
                for (int n = 0; n < 2; ++n) acc[a][b][m][n] = (f32x4){0.f, 0.f, 0.f, 0.f};
    bf16x8 At[4][2], B0[2][2], B1[2][2];
    const char* cA = (const char*)g.A + (size_t)cur.pm * tstep; const char* cB = (const char*)g.Bt + (size_t)cur.pn * tstep;
    S.a_ready(cur);
    if constexpr (SP2) {
        PG8_STAGE(PG8_SB(0, 0), cB, voffB); PG8_STAGE(PG8_SB(0, 1), cB + hstep, voffB); PG8_STAGE(PG8_SA(0, 0), cA, voffA); PG8_STAGE(PG8_SA(0, 1), cA + hstep, voffA);
        if (wr == 1) PG8_BAR;
        PG8_WAIT_V(2); PG8_BAR;
        PG8_STAGE(PG8_SB(1, 0), cB + kstep, voffB); PG8_STAGE(PG8_SA(1, 0), cA + kstep, voffA); PG8_STAGE(PG8_SB(1, 1), cB + hstep + kstep, voffB);
        PG8_WAIT_V(6); PG8_BAR;
    } else {
        PG8_STAGE(PG8_SB(0, 0), cB, voffB); PG8_STAGE(PG8_SA(0, 0), cA, voffA); PG8_STAGE(PG8_SB(0, 1), cB + hstep, voffB); PG8_STAGE(PG8_SA(0, 1), cA + hstep, voffA);
        if (wr == 1) PG8_BAR;
        PG8_WAIT_V(4); PG8_BAR;
        PG8_STAGE(PG8_SB(1, 0), cB + kstep, voffB); PG8_STAGE(PG8_SA(1, 0), cA + kstep, voffA); PG8_STAGE(PG8_SB(1, 1), cB + hstep + kstep, voffB);
        PG8_WAIT_V(6); PG8_BAR;
    }
    for (;;) {
        const bool has_next = S.next(ui + 1, nxt);
        const char* nA = has_next ? (const char*)g.A + (size_t)nxt.pm * tstep : cA; const char* nB = has_next ? (const char*)g.Bt + (size_t)nxt.pn * tstep : cB;
        for (int t = 0; t < nt; t += 2) {
            const bool last = (t == nt - 2);
            const char* a1 = cA + (size_t)(t + 1) * kstep;
            const char* a2 = last ? nA : cA + (size_t)(t + 2) * kstep; const char* b2 = last ? nB : cB + (size_t)(t + 2) * kstep;
            const char* a3 = a2 + kstep; const char* b3 = b2 + kstep;
            if (last && has_next) S.a_ready(nxt);
            if constexpr (SP2) {
            PG8_LDB(B0, 0, 0); PG8_LDB(B1, 0, 1); PG8_SCHED; PG8_LDA(At, 0, 0); PG8_STAGE(PG8_SA(1, 1), a1 + hstep, voffA);
            PG8_WAIT_V(8); PG8_WAIT_L(0); PG8_BAR; PG8_MMA(0, 0, At, B0); PG8_MMA(0, 1, At, B1); PG8_BAR; PG8_SCHED;
            PG8_LDA(At, 0, 1); PG8_STAGE(PG8_SB(0, 0), b2, voffB); PG8_STAGE(PG8_SB(0, 1), b2 + hstep, voffB); PG8_STAGE(PG8_SA(0, 0), a2, voffA);
            PG8_WAIT_V(8); PG8_WAIT_L(0); PG8_BAR; PG8_MMA(1, 0, At, B0); PG8_MMA(1, 1, At, B1); PG8_BAR; PG8_SCHED;
            PG8_LDB(B0, 1, 0); PG8_LDB(B1, 1, 1); PG8_SCHED; PG8_LDA(At, 1, 0); PG8_STAGE(PG8_SA(0, 1), a2 + hstep, voffA);
            PG8_WAIT_V(8); PG8_WAIT_L(0); PG8_BAR; PG8_MMA(0, 0, At, B0); PG8_MMA(0, 1, At, B1); PG8_BAR; PG8_SCHED;
            PG8_LDA(At, 1, 1); PG8_STAGE(PG8_SB(1, 0), b3, voffB); PG8_STAGE(PG8_SB(1, 1), b3 + hstep, voffB); PG8_STAGE(PG8_SA(1, 0), a3, voffA);
            PG8_WAIT_V(8); PG8_WAIT_L(0); PG8_BAR; PG8_MMA(1, 0, At, B0); PG8_MMA(1, 1, At, B1); PG8_BAR; PG8_SCHED;
            } else {
            PG8_LDB(B0, 0, 0); PG8_SCHED; PG8_LDA(At, 0, 0); PG8_STAGE(PG8_SA(1, 1), a1 + hstep, voffA);
            PG8_WAIT_L(8); PG8_BAR; PG8_WAIT_L(0); PG8_MMA(0, 0, At, B0); PG8_BAR; PG8_SCHED;
            PG8_LDB(B1, 0, 1); PG8_STAGE(PG8_SB(0, 0), b2, voffB);
            PG8_BAR; PG8_WAIT_L(0); PG8_MMA(0, 1, At, B1); PG8_BAR;
            PG8_LDA(At, 0, 1); PG8_STAGE(PG8_SA(0, 0), a2, voffA);
            PG8_BAR; PG8_WAIT_L(0); PG8_MMA(1, 0, At, B0); PG8_BAR; PG8_SCHED;
            PG8_STAGE(PG8_SB(0, 1), b2 + hstep, voffB);
            PG8_WAIT_V(6); PG8_BAR; PG8_MMA(1, 1, At, B1); PG8_BAR;
            PG8_LDB(B0, 1, 0); PG8_SCHED; PG8_LDA(At, 1, 0); PG8_STAGE(PG8_SA(0, 1), a2 + hstep, voffA);
            PG8_WAIT_L(8); PG8_BAR; PG8_WAIT_L(0); PG8_MMA(0, 0, At, B0); PG8_BAR; PG8_SCHED;
            PG8_LDB(B1, 1, 1); PG8_STAGE(PG8_SB(1, 0), b3, voffB);
            PG8_BAR; PG8_WAIT_L(0); PG8_MMA(0, 1, At, B1); PG8_BAR;
            PG8_LDA(At, 1, 1); PG8_STAGE(PG8_SA(1, 0), a3, voffA);
            PG8_BAR; PG8_WAIT_L(0); PG8_MMA(1, 0, At, B0); PG8_BAR; PG8_SCHED;
            PG8_STAGE(PG8_SB(1, 1), b3 + hstep, voffB);
            PG8_WAIT_V(6); PG8_BAR; PG8_MMA(1, 1, At, B1); PG8_BAR;
            }
        }
        if constexpr (ALIGN_EPI) { if (wr == 0) PG8_BAR; }
        if constexpr (!Epi::AFTER_DRAIN) { E(acc, cur, wr, wc, fr, fq); S.done(cur); }
        if (!has_next) break;
#pragma unroll
        for (int a = 0; a < 2; ++a)
#pragma unroll
            for (int b = 0; b < 2; ++b)
#pragma unroll
                for (int m = 0; m < 4; ++m)
#pragma unroll
                    for (int n = 0; n < 2; ++n) acc[a][b][m][n] = (f32x4){0.f, 0.f, 0.f, 0.f};
        cur = nxt; cA = nA; cB = nB; ++ui;
        if constexpr (ALIGN_EPI) { if (wr == 1) PG8_BAR; }
    }
    PG8_WAIT_V(0);
    if constexpr (!ALIGN_EPI) { if (wr == 0) PG8_BAR; }
    PG8_BAR;
    if constexpr (Epi::AFTER_DRAIN) { E.fused(acc, cur, wr, wc, fr, fq, lds, wid, lane); S.done(cur); }
#undef PG8_SA
#undef PG8_SB
#undef PG8_STAGE
#undef PG8_LDA
#undef PG8_LDB
#undef PG8_MMA
#undef PG8_WAIT_V
#undef PG8_WAIT_L
#undef PG8_BAR
#undef PG8_SCHED
}
}
#include <hip/hip_bf16.h>
#include <cmath>
namespace attn_body {
using bf16=__hip_bfloat16;
using bf16x8=__attribute__((ext_vector_type(8)))short;
using s16x4=__attribute__((ext_vector_type(4)))short;
using f32x16=__attribute__((ext_vector_type(16)))float;
using u32x4=__attribute__((ext_vector_type(4)))unsigned;
constexpr int BATCH=2,NHEAD=16,SEQ=8192,D=64,DM=NHEAD*D;
constexpr int NW=8,QBLK=32,QB=QBLK*NW,KVBLK=64,NQB=SEQ/QB;
constexpr int ATTN_PITCH=DM, ATTN_UNIT_ROWS=QB;
__device__ __forceinline__ int crow(int r,int hi){return (r&3)+8*(r>>2)+4*hi;}
#define SBAR() __builtin_amdgcn_sched_barrier(0)
__device__ __forceinline__ void cmask(f32x16&p0,f32x16&p1,int jb,int qrel,int hi){
  const float NEG=-INFINITY; int qd=qrel-64*jb-4*hi; asm volatile("":"+v"(qd));
  #pragma unroll
  for(int r=0;r<16;++r){ if((r&3)+8*(r>>2)>qd)p0[r]=NEG; if((r&3)+8*(r>>2)+32>qd)p1[r]=NEG;}
}

constexpr int NSLOT=3, SLOTB=8192;
constexpr int LDS_K=0, LDS_V=NSLOT*SLOTB, LDS_WS=2*NSLOT*SLOTB, LDS_OST=LDS_WS+NW*64*4, LDS_NF=LDS_OST+NW*4096, LDS_BYTES=LDS_NF+SEQ*4;
constexpr float C2=0.125f*1.4426950408889634f;
__device__ __forceinline__ void glds16(const void*gsrc,unsigned lds_dst){unsigned keep;
  asm volatile("s_mov_b32 %0, m0\n\ts_mov_b32 m0, %2\n\ts_nop 0\n\tglobal_load_lds_dwordx4 %1, off\n\ts_mov_b32 m0, %0":"=&s"(keep):"v"(gsrc),"s"(lds_dst):"memory");}
__device__ __forceinline__ float max3f(float a,float b,float c){float r;asm("v_max3_f32 %0, %1, %2, %3":"=v"(r):"v"(a),"v"(b),"v"(c));return r;}
__device__ __forceinline__ float max2f(float a,float b){float r;asm("v_max_f32_e32 %0, %1, %2":"=v"(r):"v"(a),"v"(b));return r;}
__device__ __forceinline__ float fadd_s(float a,float b){float r;asm("v_add_f32_e32 %0, %1, %2":"=v"(r):"v"(a),"v"(b));return r;}
__device__ __forceinline__ float fsub_s(float a,float b){float r;asm("v_sub_f32_e32 %0, %1, %2":"=v"(r):"v"(a),"v"(b));return r;}
typedef float f32x2_t __attribute__((ext_vector_type(2))); typedef __bf16 bf16x2_t __attribute__((ext_vector_type(2)));
__device__ __forceinline__ unsigned cvtpk_s(float lo,float hi){f32x2_t v={lo,hi};bf16x2_t b=__builtin_convertvector(v,bf16x2_t);return __builtin_bit_cast(unsigned,b);}
#define WAIT_BAR(N) asm volatile("s_waitcnt vmcnt(" #N ") lgkmcnt(0)\n\ts_barrier":::"memory")

__device__ __forceinline__ void qkt(f32x16&p0,f32x16&p1,const char*Kslot,const bf16x8*qr,int r32,int hi){ const f32x16 negm=f32x16{};
  const char*kb=Kslot+hi*1024+r32*16;
  #pragma unroll
  for(int d0=0;d0<4;++d0){
    const bf16x8 b0=*reinterpret_cast<const bf16x8*>(kb+d0*2048);
    const bf16x8 b1=*reinterpret_cast<const bf16x8*>(kb+d0*2048+512);
    if(d0==0){p0=__builtin_amdgcn_mfma_f32_32x32x16_bf16(b0,qr[0],negm,0,0,0);p1=__builtin_amdgcn_mfma_f32_32x32x16_bf16(b1,qr[0],negm,0,0,0);}
    else{p0=__builtin_amdgcn_mfma_f32_32x32x16_bf16(b0,qr[d0],p0,0,0,0);p1=__builtin_amdgcn_mfma_f32_32x32x16_bf16(b1,qr[d0],p1,0,0,0);}}
}
typedef __attribute__((address_space(3))) const char* lds_cptr;
typedef short v4i16_t __attribute__((ext_vector_type(4)));
__device__ __forceinline__ void kload8(bf16x8*kf,lds_cptr kp){
  kf[0]=*(const __attribute__((address_space(3))) bf16x8*)(kp);      kf[1]=*(const __attribute__((address_space(3))) bf16x8*)(kp+512);
  kf[2]=*(const __attribute__((address_space(3))) bf16x8*)(kp+2048); kf[3]=*(const __attribute__((address_space(3))) bf16x8*)(kp+2560);
  kf[4]=*(const __attribute__((address_space(3))) bf16x8*)(kp+4096); kf[5]=*(const __attribute__((address_space(3))) bf16x8*)(kp+4608);
  kf[6]=*(const __attribute__((address_space(3))) bf16x8*)(kp+6144); kf[7]=*(const __attribute__((address_space(3))) bf16x8*)(kp+6656);
}
__device__ __forceinline__ void kload2(bf16x8*kf,lds_cptr kp,int j){ kf[2*j]=*(const __attribute__((address_space(3))) bf16x8*)(kp+j*2048); kf[2*j+1]=*(const __attribute__((address_space(3))) bf16x8*)(kp+j*2048+512); }
__device__ __forceinline__ s16x4 vtr(lds_cptr p){ return __builtin_bit_cast(s16x4,__builtin_amdgcn_ds_read_tr16_b64_v4i16((__attribute__((address_space(3))) v4i16_t*)p)); }
__device__ __forceinline__ float rowmax(const f32x16&p0,const f32x16&p1){
  float a=max3f(p0[0],p0[1],p1[0]),b=max3f(p0[2],p0[3],p1[1]);a=max3f(a,p1[2],p1[3]);
  #pragma unroll
  for(int r=4;r<16;r+=4){a=max3f(a,p0[r],p0[r+1]);b=max3f(b,p0[r+2],p0[r+3]);a=max3f(a,p1[r],p1[r+1]);b=max3f(b,p1[r+2],p1[r+3]);}
  const float m=max2f(a,b);
  auto rr=__builtin_amdgcn_permlane32_swap(__float_as_uint(m),__float_as_uint(m),false,false);
  return max2f(__uint_as_float(rr[0]),__uint_as_float(rr[1]));
}
__device__ __forceinline__ void pv(f32x16*o,int vb,bf16x8 pa0,bf16x8 pa1,bf16x8 pa2,bf16x8 pa3){
  #pragma unroll
  for(int d0=0;d0<2;++d0){s16x4 lo[4],hi[4];
    #pragma unroll
    for(int ks=0;ks<4;++ks){
      asm volatile("ds_read_b64_tr_b16 %0,%1 offset:%c2":"=&v"(lo[ks]):"v"(vb),"i"(d0*4096+ks*1024):"memory");
      asm volatile("ds_read_b64_tr_b16 %0,%1 offset:%c2":"=&v"(hi[ks]):"v"(vb),"i"(d0*4096+ks*1024+512):"memory");}
    asm volatile("s_waitcnt lgkmcnt(0)":::"memory");SBAR();
    #define PK(k) (bf16x8){lo[k][0],lo[k][1],lo[k][2],lo[k][3],hi[k][0],hi[k][1],hi[k][2],hi[k][3]}
    o[d0]=__builtin_amdgcn_mfma_f32_32x32x16_bf16(pa0,PK(0),o[d0],0,0,0);
    o[d0]=__builtin_amdgcn_mfma_f32_32x32x16_bf16(pa1,PK(1),o[d0],0,0,0);
    o[d0]=__builtin_amdgcn_mfma_f32_32x32x16_bf16(pa2,PK(2),o[d0],0,0,0);
    o[d0]=__builtin_amdgcn_mfma_f32_32x32x16_bf16(pa3,PK(3),o[d0],0,0,0);
    #undef PK
  }
}

#ifndef ATTN_STORE16
#define ATTN_STORE16(p,v) (*(u32x4*)(p)=(v))
#endif
typedef float f32x4_t __attribute__((ext_vector_type(4)));
template<int THRL> __device__ __forceinline__ void attn_unit(int b,int h,int qb,const bf16*Q,const bf16*__restrict__ K,const bf16*__restrict__ V,bf16*O,const float*__restrict__ NFg,const bf16*__restrict__ SG,char*shm){
  int tid_=threadIdx.x; asm volatile("":"+v"(tid_)); const int tid=tid_,lane=tid&63,r32=lane&31,hi=lane>>5; const int wid=__builtin_amdgcn_readfirstlane(tid>>6);
  const long rowbase=(long)b*SEQ; const int q0=qb*QB;
  const bf16*Qw=Q+(rowbase+q0+wid*QBLK)*DM+h*D;
  const bf16*Kh=K+rowbase*DM+h*D,*Vh=V+rowbase*DM+h*D;
  const unsigned lds0=(unsigned)(uintptr_t)shm;
  float*wsf=(float*)(shm+LDS_WS)+wid*64;
  const bf16*ksrc=Kh+(long)lane*DM+wid*8;
  const bf16*vsrc=Vh+(long)(16*(wid&3)+(lane>>2))*DM+(wid>>2)*32+(lane&3)*8;
  const unsigned kdst=lds0+LDS_K+wid*1024, vdst=lds0+LDS_V+wid*1024;
  #define DMA_K(t,slot) glds16(ksrc+(long)(t)*KVBLK*DM,(unsigned)__builtin_amdgcn_readfirstlane(kdst+(slot)))
  #define DMA_V(t,slot) glds16(vsrc+(long)(t)*KVBLK*DM,(unsigned)__builtin_amdgcn_readfirstlane(vdst+(slot)))
  const int vb0=(int)(lds0+LDS_V)+((lane>>4)&1)*32+(lane&3)*8+(4*hi+((lane&15)>>2))*64;
  const char*Kbase=shm+LDS_K; bf16x8 kf[8];
  const lds_cptr shm3=(lds_cptr)shm; const lds_cptr kp0=shm3+LDS_K+hi*1024+r32*16; const lds_cptr vp0=shm3+LDS_V+((lane>>4)&1)*32+(lane&3)*8+(4*hi+((lane&15)>>2))*64;
  const int NT=(q0+QB)/KVBLK;
  { const f32x4_t*nsrc=(const f32x4_t*)(NFg+(long)(b*NHEAD+h)*SEQ); __attribute__((address_space(3))) f32x4_t*ndst=(__attribute__((address_space(3))) f32x4_t*)(shm3+LDS_NF);
    for(int i_=tid;i_<NT*16;i_+=NW*64)ndst[i_]=nsrc[i_]; }
  #define BIAS(P0,P1,t) do{ const __attribute__((address_space(3))) f32x4_t*nb_=(const __attribute__((address_space(3))) f32x4_t*)(shm3+LDS_NF+(t)*256+hi*16); \
    _Pragma("unroll") for(int j_=0;j_<4;++j_){ const f32x4_t a_=nb_[2*j_]; const f32x4_t b_=nb_[2*j_+8]; \
      P0[4*j_]+=a_[0];P0[4*j_+1]+=a_[1];P0[4*j_+2]+=a_[2];P0[4*j_+3]+=a_[3]; P1[4*j_]+=b_[0];P1[4*j_+1]+=b_[1];P1[4*j_+2]+=b_[2];P1[4*j_+3]+=b_[3]; } }while(0)
  DMA_K(0,0);DMA_V(0,0);DMA_K(1,SLOTB);
  bf16x8 qr[4];
  #pragma unroll
  for(int d0=0;d0<4;++d0)qr[d0]=*reinterpret_cast<const bf16x8*>(&Qw[(long)r32*DM+d0*16+hi*8]);
  float mhat=0.f,l_reg=0.f;f32x16 o[2];o[0]=f32x16{};o[1]=f32x16{};const f32x16 negm=f32x16{};
  const int qrel=wid*QBLK+r32;
  #define CMASK(P0,P1,t) do{int jb_=(t)-(NT-4); if(jb_>=0)cmask(P0,P1,jb_,qrel,hi);}while(0)
  bool resc=false;
  #define START(P0,P1) do{ const float rm=rowmax(P0,P1); resc=false; mhat=rm; \
    _Pragma("unroll") for(int r=0;r<16;++r)P0[r]=__builtin_amdgcn_exp2f(fsub_s(P0[r],mhat)); }while(0)
  #define RESC() do{ if(resc){ asm volatile("s_waitcnt lgkmcnt(0)":::"memory"); \
      _Pragma("unroll") for(int d_=0;d_<2;++d_) _Pragma("unroll") for(int r=0;r<16;++r)o[d_][r]*=wsf[crow(r,hi)]; } }while(0)
  f32x16 pA0,pA1,pB0,pB1;
  int sl_prev=0,sl_cur=0,sl_next=SLOTB;
  #define ROT() do{sl_prev=sl_cur;sl_cur=sl_next;sl_next=(sl_next==(NSLOT-1)*SLOTB)?0:sl_next+SLOTB;}while(0)
  DMA_K(2,2*SLOTB);
  WAIT_BAR(3);
  qkt(pA0,pA1,Kbase,qr,r32,hi);asm volatile("s_nop 15\n\ts_nop 7":"+v"(pA0),"+v"(pA1));BIAS(pA0,pA1,0);CMASK(pA0,pA1,0);
  START(pA0,pA1);
  _Pragma("unroll") for(int r=0;r<16;++r)pA1[r]=__builtin_amdgcn_exp2f(fsub_s(pA1[r],mhat));
  WAIT_BAR(0);
  DMA_K(3,0);DMA_V(1,SLOTB);
  ROT();
  kload8(kf,kp0+sl_cur);
  WAIT_BAR(2);
  s16x4 vlo[8],vhi[8]; u32x4 pw0,pw1,pw2,pw3;
  #define PKW(P,B) cvtpk_s(P[B],P[B+1])
  #define PAF(k) __builtin_bit_cast(bf16x8,pw##k)
  #define VFR(i) (bf16x8){vlo[i][0],vlo[i][1],vlo[i][2],vlo[i][3],vhi[i][0],vhi[i][1],vhi[i][2],vhi[i][3]}
  #define PIN(x) asm volatile("":"+v"(x))
  #define MX3(a,b,c) __builtin_fmaxf(__builtin_fmaxf((a),(b)),(c))
  #define GAPA(MF,A0,A1,A2,A3,W0,W1,PW) do{ MF; sacc+=A0; sacc+=A1; sacc+=A2; sacc+=A3; PIN(sacc); W0; W1; PIN(PW); SBAR(); }while(0)
  #define EX(v) __builtin_amdgcn_exp2f(v)
  #define GAPB(MF,X,B) do{ MF; X[B]=EX(X[B]-mhat); X[B+1]=EX(X[B+1]-mhat); X[B+2]=EX(X[B+2]-mhat); X[B+3]=EX(X[B+3]-mhat); PIN(X); SBAR(); }while(0)
  #define VRD(i) do{ vlo[i]=vtr(vp_+(((i)>>2)*4096+((i)&3)*1024)); vhi[i]=vtr(vp_+(((i)>>2)*4096+((i)&3)*1024+512)); }while(0)
  #define KRD(G,j) do{ if(G){ kload2(kf,kp0+sl_next,j); SBAR(); } }while(0)
  #define STEP(C0,C1,P0,P1,t,GK,GV,GL) do{ SBAR(); \
    const lds_cptr vp_=vp0+sl_prev; \
    VRD(0); SBAR(); float sacc=(P0[0]+P0[1]); \
    GAPA(C0=__builtin_amdgcn_mfma_f32_32x32x16_bf16(kf[0],qr[0],negm,0,0,0), P0[2],P0[3],P0[4],P0[5],     pw0[0]=PKW(P0,0), pw0[1]=PKW(P0,2), pw0); \
    VRD(4); SBAR(); GAPA(C1=__builtin_amdgcn_mfma_f32_32x32x16_bf16(kf[1],qr[0],negm,0,0,0), P0[6],P0[7],P0[8],P0[9],     pw0[2]=PKW(P0,4), pw0[3]=PKW(P0,6), pw0); \
    VRD(1); SBAR(); GAPA(C0=__builtin_amdgcn_mfma_f32_32x32x16_bf16(kf[2],qr[1],C0,0,0,0),   P0[10],P0[11],P0[12],P0[13], pw1[0]=PKW(P0,8), pw1[1]=PKW(P0,10), pw1); \
    VRD(5); SBAR(); GAPA(C1=__builtin_amdgcn_mfma_f32_32x32x16_bf16(kf[3],qr[1],C1,0,0,0),   P0[14],P0[15],P1[0],P1[1],   pw1[2]=PKW(P0,12),pw1[3]=PKW(P0,14), pw1); \
    VRD(2); SBAR(); GAPA(C0=__builtin_amdgcn_mfma_f32_32x32x16_bf16(kf[4],qr[2],C0,0,0,0),   P1[2],P1[3],P1[4],P1[5],     pw2[0]=PKW(P1,0), pw2[1]=PKW(P1,2), pw2); \
    VRD(6); SBAR(); GAPA(C1=__builtin_amdgcn_mfma_f32_32x32x16_bf16(kf[5],qr[2],C1,0,0,0),   P1[6],P1[7],P1[8],P1[9],     pw2[2]=PKW(P1,4), pw2[3]=PKW(P1,6), pw2); \
    VRD(3); SBAR(); GAPA(C0=__builtin_amdgcn_mfma_f32_32x32x16_bf16(kf[6],qr[3],C0,0,0,0),   P1[10],P1[11],P1[12],P1[13], pw3[0]=PKW(P1,8), pw3[1]=PKW(P1,10), pw3); \
    VRD(7); SBAR(); GAPA(C1=__builtin_amdgcn_mfma_f32_32x32x16_bf16(kf[7],qr[3],C1,0,0,0),   P1[14],P1[15],0.f,0.f,       pw3[2]=PKW(P1,12),pw3[3]=PKW(P1,14), pw3); \
    l_reg+=sacc; \
    if(GK){DMA_K((t)+3,sl_cur);} if(GV){DMA_V((t)+1,sl_next);} \
    BIAS(C0,C1,t); CMASK(C0,C1,t); \
    { float a=MX3(C0[0],C0[1],C1[0]),b=MX3(C0[2],C0[3],C1[1]); a=MX3(a,C1[2],C1[3]); \
      _Pragma("unroll") for(int r=4;r<16;r+=4){a=MX3(a,C0[r],C0[r+1]);b=MX3(b,C0[r+2],C0[r+3]);a=MX3(a,C1[r],C1[r+1]);b=MX3(b,C1[r+2],C1[r+3]);} \
      float rm=__builtin_fmaxf(a,b); { auto rr=__builtin_amdgcn_permlane32_swap(__float_as_uint(rm),__float_as_uint(rm),false,false); rm=__builtin_fmaxf(__uint_as_float(rr[0]),__uint_as_float(rr[1])); } \
      resc=false; \
      if(__builtin_expect(__any(rm-mhat>(float)THRL),0)){ const float dl=__builtin_fmaxf(rm-mhat,0.f); mhat+=dl; \
        const float f=__builtin_amdgcn_exp2f(-dl); l_reg*=f; if(hi==0)wsf[r32]=f; resc=true; } } \
    SBAR(); \
    GAPB(o[0]=__builtin_amdgcn_mfma_f32_32x32x16_bf16(PAF(0),VFR(0),o[0],0,0,0), C0,0); \
    GAPB(o[1]=__builtin_amdgcn_mfma_f32_32x32x16_bf16(PAF(0),VFR(4),o[1],0,0,0), C0,4); \
    KRD(GL,0); GAPB(o[0]=__builtin_amdgcn_mfma_f32_32x32x16_bf16(PAF(1),VFR(1),o[0],0,0,0), C0,8); \
    KRD(GL,1); GAPB(o[1]=__builtin_amdgcn_mfma_f32_32x32x16_bf16(PAF(1),VFR(5),o[1],0,0,0), C0,12); \
    KRD(GL,2); GAPB(o[0]=__builtin_amdgcn_mfma_f32_32x32x16_bf16(PAF(2),VFR(2),o[0],0,0,0), C1,0); \
    KRD(GL,3); GAPB(o[1]=__builtin_amdgcn_mfma_f32_32x32x16_bf16(PAF(2),VFR(6),o[1],0,0,0), C1,4); \
    GAPB(o[0]=__builtin_amdgcn_mfma_f32_32x32x16_bf16(PAF(3),VFR(3),o[0],0,0,0), C1,8); \
    GAPB(o[1]=__builtin_amdgcn_mfma_f32_32x32x16_bf16(PAF(3),VFR(7),o[1],0,0,0), C1,12); \
    }while(0)
  int t=1;
  #undef CMASK
  #define CMASK(P0,P1,t) do{}while(0)
  for(;t+5<NT;t+=2){
    STEP(pB0,pB1,pA0,pA1,t,true,true,true);     WAIT_BAR(2); RESC(); ROT();
    STEP(pA0,pA1,pB0,pB1,t+1,true,true,true);   WAIT_BAR(2); RESC(); ROT();
  }
  #undef CMASK
  #define CMASK(P0,P1,t) do{int jb_=(t)-(NT-4); if(jb_>=0)cmask(P0,P1,jb_,qrel,hi);}while(0)
  #define ENDW(tt) do{ if((tt)+3<NT){WAIT_BAR(2);} else if((tt)+2<NT){WAIT_BAR(1);} else {WAIT_BAR(0);} }while(0)
  for(;t+1<NT;t+=2){
    STEP(pB0,pB1,pA0,pA1,t,(t+3<NT),(t+1<NT),(t+1<NT));       ENDW(t);   RESC(); ROT();
    STEP(pA0,pA1,pB0,pB1,t+1,(t+4<NT),(t+2<NT),(t+2<NT));     ENDW(t+1); RESC(); ROT();
  }
  STEP(pB0,pB1,pA0,pA1,NT-1,false,false,false); RESC();
  { float sacc=pB0[0]+pB0[1]; _Pragma("unroll") for(int r=2;r<16;++r)sacc+=pB0[r]; _Pragma("unroll") for(int r=0;r<16;++r)sacc+=pB1[r]; l_reg+=sacc;
    pw0=(u32x4){PKW(pB0,0),PKW(pB0,2),PKW(pB0,4),PKW(pB0,6)};pw1=(u32x4){PKW(pB0,8),PKW(pB0,10),PKW(pB0,12),PKW(pB0,14)};pw2=(u32x4){PKW(pB1,0),PKW(pB1,2),PKW(pB1,4),PKW(pB1,6)};pw3=(u32x4){PKW(pB1,8),PKW(pB1,10),PKW(pB1,12),PKW(pB1,14)};
    SBAR(); pv(o,vb0+sl_cur,PAF(0),PAF(1),PAF(2),PAF(3)); }
  #undef PKW
  #undef PAF
  #undef VFR
  #undef PIN
  #undef MX3
  #undef GAPA
  #undef GAPB
  #undef EX
  #undef VRD
  #undef KRD
  #undef STEP
  #undef ENDW
  {auto rr=__builtin_amdgcn_permlane32_swap(__float_as_uint(l_reg),__float_as_uint(l_reg),false,false);l_reg=__uint_as_float(rr[0])+__uint_as_float(rr[1]);}
  if(hi==0)wsf[32+r32]=l_reg;asm volatile("s_waitcnt lgkmcnt(0)":::"memory");
  float rli[16];
  #pragma unroll
  for(int r=0;r<16;++r)rli[r]=__builtin_amdgcn_rcpf(wsf[32+crow(r,hi)]);
  bf16*Ow=O+(rowbase+q0+wid*QBLK)*DM+h*D; const bf16*SGw=SG+(rowbase+q0+wid*QBLK)*DM+h*D;
  { bf16*stg=(bf16*)(shm+LDS_OST)+wid*2048;
    #pragma unroll
    for(int r=0;r<16;++r){const int orow=crow(r,hi);
      #pragma unroll
      for(int d0=0;d0<2;++d0)stg[orow*64+d0*32+r32]=__float2bfloat16(o[d0][r]*rli[r]);}
    asm volatile("s_waitcnt lgkmcnt(0)":::"memory");
    #pragma unroll
    for(int i=0;i<4;++i){const int row=i*8+(lane>>3),ch=lane&7; u32x4 v=*(const u32x4*)(stg+row*64+ch*8); const u32x4 gq=*(const u32x4*)(SGw+(long)row*DM+ch*8);
      _Pragma("unroll") for(int e_=0;e_<4;++e_){ const float lo_=__uint_as_float(v[e_]<<16)*__uint_as_float(gq[e_]<<16), hi_=__uint_as_float(v[e_]&0xffff0000u)*__uint_as_float(gq[e_]&0xffff0000u); v[e_]=cvtpk_s(lo_,hi_); }
      ATTN_STORE16(Ow+(long)row*DM+ch*8,v);} }
  asm volatile("s_waitcnt lgkmcnt(0)\n\ts_barrier":::"memory");
  #undef DMA_K
  #undef BIAS
  #undef DMA_V
  #undef CMASK
  #undef START
  #undef RESC
  #undef ROT
}
constexpr int ATTN_LDS_BYTES=LDS_BYTES;
struct AttnTensors { const bf16* Q; const bf16* K; const bf16* V; bf16* O; const float* NF; const bf16* SG; };
struct AttnUnit { int bh; int qb; };
struct StaticOrder {
  int vcu;
  __device__ __forceinline__ explicit StaticOrder(int grid,int block):vcu((block%8)*(grid/8)+block/8){}
  __device__ __forceinline__ bool next(int i,AttnUnit&u)const{ if(i>=4)return false; const int s=vcu&7; u.bh=vcu>>3; u.qb=(i==0)?s:(i==1)?15-s:(i==2)?16+s:31-s; return true; }
  __device__ __forceinline__ void a_ready(const AttnUnit&)const{}
  __device__ __forceinline__ void done(const AttnUnit&)const{}
};
template<class Sched,int THRL=8> __device__ __forceinline__ void attn_phase(char*lds,const AttnTensors&T,const Sched&S){
  AttnUnit u;
  for(int i=0;S.next(i,u);++i){ S.a_ready(u); attn_unit<THRL>(u.bh/NHEAD,u.bh%NHEAD,u.qb,T.Q,T.K,T.V,T.O,T.NF,T.SG,lds); S.done(u); }
}
#undef SBAR
#undef WAIT_BAR
}
constexpr int NWAVES = 8, NTHR = 512;
constexpr int BATCH = 2, T = 8192, D = 1024, FF = 4096, M = BATCH * T;
constexpr int NIN_FOX = 4 * D + 16;
constexpr float EPS = 1e-6f;
constexpr size_t MiB = 1u << 20;
constexpr size_t WS_MOD = 0;
constexpr size_t WS_LB = 128 * 1024;
constexpr size_t WS_QKNW = 160 * 1024;
constexpr size_t WS_WFZ = 192 * 1024;
constexpr size_t WS_DN = 256 * 1024;
constexpr size_t WS_LFS = 1536 * 1024;
constexpr size_t WS_NF = 2560 * 1024;
constexpr size_t WS_W_HGIN = 4 * MiB, WS_W_HGOUT = 12 * MiB, WS_W_FOXIN = 14 * MiB, WS_W_FOXOUT = 22 * MiB;
constexpr size_t WS_W1_0 = 24 * MiB, WS_W2_0 = 32 * MiB, WS_W1_1 = 40 * MiB, WS_W2_1 = 48 * MiB;
constexpr size_t WS_XN = 56 * MiB;
constexpr size_t WS_R = 88 * MiB;
constexpr size_t WS_QO = WS_R, WS_B1 = WS_R + 32 * MiB, WS_B2 = WS_R + 64 * MiB, WS_B3 = WS_R + 96 * MiB;
constexpr size_t WS_ST = WS_R + 96 * MiB;
constexpr size_t WS_H = WS_R;
constexpr size_t WS_END = 256 * MiB;
static_assert(WS_ST + 64 * MiB <= WS_END && WS_H + 128 * MiB <= WS_END && WS_B1 - WS_QO == 32 * MiB, "ws map");
constexpr int LDS_BYTES = 147456;

#define GAS __attribute__((address_space(1)))
#define LAS __attribute__((address_space(3)))
typedef unsigned short bf16;
typedef unsigned v4u __attribute__((ext_vector_type(4)));
typedef unsigned v2u __attribute__((ext_vector_type(2)));
typedef float f32x4 __attribute__((ext_vector_type(4)));
typedef short bf16x8 __attribute__((ext_vector_type(8)));
typedef short s16x4v __attribute__((ext_vector_type(4)));
#define LDS_WAIT() asm volatile("s_waitcnt lgkmcnt(0)" ::: "memory")
__device__ __forceinline__ unsigned f2bf(float f) { unsigned u = __builtin_bit_cast(unsigned, f); return (u + 0x7fffu + ((u >> 16) & 1u)) >> 16; }
__device__ __forceinline__ unsigned pk2(float lo, float hi) { return pg8::cvt_pk_bf16(lo, hi); }
__device__ __forceinline__ float bf2f(unsigned short h) { return __uint_as_float((unsigned)h << 16); }
__device__ __forceinline__ float wave_sum(float v) {
#pragma unroll
    for (int o = 1; o < 64; o <<= 1) v += __shfl_xor(v, o);
    return v;
}

struct Args { const float* in[18]; float* out; unsigned char* ws; };

template <bool HEADPERM>
__device__ __forceinline__ void transpose_item(const float* W, int K, int ldw, int Ncols, bf16* WT, LAS float* scr, int item, int lane) {
    const int nblk = Ncols / 32, kb = item / nblk, nb = item % nblk, k0 = 64 * kb, n0 = 32 * nb;
#pragma unroll 8
    for (int i = 0; i < 32; ++i) { const int kk = 2 * i + (lane >> 5); scr[kk * 33 + (lane & 31)] = W[(size_t)(k0 + kk) * ldw + n0 + (lane & 31)]; }
    LDS_WAIT(); asm volatile("" ::: "memory");
    const int c = lane & 7;
#pragma unroll
    for (int j = 0; j < 4; ++j) { const int n = (lane >> 3) + 8 * j; const LAS float* s = scr + (8 * c) * 33 + n;
        v4u o; o.x = pk2(s[0 * 33], s[1 * 33]); o.y = pk2(s[2 * 33], s[3 * 33]); o.z = pk2(s[4 * 33], s[5 * 33]); o.w = pk2(s[6 * 33], s[7 * 33]);
        int col = n0 + n;
        if (HEADPERM && col < 2048) { const int nl = col & 255; col = (col & ~255) + 128 * ((nl >> 5) & 1) + 32 * (nl >> 6) + (nl & 31); }
        *(GAS v4u*)(WT + (size_t)col * K + k0 + 8 * c) = o; }
    LDS_WAIT(); asm volatile("" ::: "memory");
}

__device__ __forceinline__ void norm_rows(int gw, int NGW, int lane, const float* xin, const float* w, const float* modsh, const float* modsc, bf16* outb, float* outf) {
    for (int m = gw; m < M; m += NGW) {
        const GAS f32x4* xr = (const GAS f32x4*)(xin + (size_t)m * D) + lane;
        f32x4 v[4]; float s = 0.f;
#pragma unroll
        for (int j = 0; j < 4; ++j) { v[j] = xr[64 * j]; s += (v[j].x * v[j].x + v[j].y * v[j].y) + (v[j].z * v[j].z + v[j].w * v[j].w); }
        const float rstd = __builtin_amdgcn_rsqf(wave_sum(s) * (1.f / D) + EPS);
        const int b = m >> 13;
#pragma unroll
        for (int j = 0; j < 4; ++j) {
            const f32x4 wv = *((const f32x4*)w + lane + 64 * j);
            f32x4 y = v[j] * rstd * wv;
            if (modsc) { const f32x4 sc = *((const f32x4*)(modsc + b * 6144) + lane + 64 * j), sh = *((const f32x4*)(modsh + b * 6144) + lane + 64 * j); y = y * (1.0f + sc) + sh; }
            if (outf) *((GAS f32x4*)(outf + (size_t)m * D) + lane + 64 * j) = y;
            else { v2u o; o.x = pk2(y.x, y.y); o.y = pk2(y.z, y.w); *((GAS v2u*)(outb + (size_t)m * D) + lane + 64 * j) = o; }
        }
    }
}

constexpr int HG_QM = 0, HG_KM = 17408, HG_Q0 = 34816, HG_KT = 52224, HG_VT = 70656, HG_STL = 89088, HG_PART = 123904, HG_RED = 125952;
constexpr int PQ = 136, PT = 72;
#define MFMA16(a, b, c) __builtin_amdgcn_mfma_f32_16x16x32_bf16((a), (b), (c), 0, 0, 0)

__device__ __forceinline__ void hg_pass_a(LAS unsigned char* lds, int tid, int lane, int wave, const float* LF, const bf16* V, bf16* ST, float* DN) {
    const int p = tid >> 7, kk = tid & 127, g = lane >> 4, l15 = lane & 15;
    LAS float* part = (LAS float*)(lds + HG_PART);
    LAS bf16* KT = (LAS bf16*)(lds + HG_KT); LAS bf16* VT = (LAS bf16*)(lds + HG_VT);
    for (int u = blockIdx.x; u < 2048; u += gridDim.x) {
        const int bh = u >> 7, n = u & 127, b = bh >> 3, h = bh & 7;
        const size_t row0 = (size_t)b * T + n * 64 + 16 * p;
        float G[16], kv[16]; unsigned short vv[16];
        const float* lfp = LF + row0 * D + h * 128 + kk; const bf16* vp = V + row0 * D + h * 128 + kk;
#pragma unroll
        for (int j = 0; j < 16; ++j) { G[j] = lfp[(size_t)j * D]; vv[j] = vp[(size_t)j * D]; }
#pragma unroll
        for (int j = 0; j < 16; ++j) { kv[j] = 1.0f - __expf(G[j]); if (j) G[j] += G[j - 1]; }
        part[p * 128 + kk] = G[15];
        __syncthreads();
        const float t0 = part[kk], t1 = part[128 + kk], t2 = part[256 + kk], t3 = part[384 + kk];
        const float off = (p > 0 ? t0 : 0.f) + (p > 1 ? t1 : 0.f) + (p > 2 ? t2 : 0.f), glast = (t0 + t1) + (t2 + t3);
        unsigned kw[8], vw[8];
#pragma unroll
        for (int j = 0; j < 8; ++j) {
            const float a0 = kv[2 * j] * __expf(glast - (G[2 * j] + off)), a1 = kv[2 * j + 1] * __expf(glast - (G[2 * j + 1] + off));
            kw[j] = pk2(a0, a1); vw[j] = (unsigned)vv[2 * j] | ((unsigned)vv[2 * j + 1] << 16); }
        *(LAS v4u*)(KT + kk * PT + 16 * p) = (v4u){kw[0], kw[1], kw[2], kw[3]}; *(LAS v4u*)(KT + kk * PT + 16 * p + 8) = (v4u){kw[4], kw[5], kw[6], kw[7]};
        *(LAS v4u*)(VT + kk * PT + 16 * p) = (v4u){vw[0], vw[1], vw[2], vw[3]}; *(LAS v4u*)(VT + kk * PT + 16 * p + 8) = (v4u){vw[4], vw[5], vw[6], vw[7]};
        if (p == 0) DN[(size_t)u * 128 + kk] = __expf(glast);
        __syncthreads();
        bf16x8 bfr[2];
#pragma unroll
        for (int ss = 0; ss < 2; ++ss) bfr[ss] = *(const LAS bf16x8*)(VT + (16 * wave + l15) * PT + 32 * ss + 8 * g);
        bf16* stp = ST + ((size_t)u * 128 + 16 * wave + l15) * 128 + 4 * g;
#pragma unroll
        for (int kt = 0; kt < 8; ++kt) {
            f32x4 acc = (f32x4){0.f, 0.f, 0.f, 0.f};
#pragma unroll
            for (int ss = 0; ss < 2; ++ss) { const bf16x8 a = *(const LAS bf16x8*)(KT + (16 * kt + l15) * PT + 32 * ss + 8 * g); acc = MFMA16(a, bfr[ss], acc); }
            v2u o; o.x = pk2(acc[0], acc[1]); o.y = pk2(acc[2], acc[3]); *(GAS v2u*)(stp + 16 * kt) = o;
        }
        __syncthreads();
    }
}
__device__ __forceinline__ void hg_pass_b(int tid, bf16* ST, const float* DN) {
    const int gt = blockIdx.x * NTHR + tid;
    for (int e2 = gt; e2 < 16 * 8192; e2 += gridDim.x * NTHR) {
        const int bh = e2 >> 13, pe = e2 & 8191, k = (2 * pe) & 127;
        unsigned* sp = (unsigned*)ST + (size_t)bh * 128 * 8192 + pe; const float* dp = DN + (size_t)bh * 128 * 128 + k;
        float s0 = 0.f, s1 = 0.f;
        for (int n0 = 0; n0 < 128; n0 += 8) {
            unsigned dv[8]; float d0[8], d1[8];
#pragma unroll
            for (int j = 0; j < 8; ++j) { dv[j] = sp[(size_t)(n0 + j) * 8192]; const float2 dd = *(const float2*)(dp + (size_t)(n0 + j) * 128); d0[j] = dd.x; d1[j] = dd.y; }
#pragma unroll
            for (int j = 0; j < 8; ++j) { sp[(size_t)(n0 + j) * 8192] = pk2(s0, s1);
                s0 = d0[j] * s0 + __uint_as_float(dv[j] << 16); s1 = d1[j] * s1 + __uint_as_float(dv[j] & 0xffff0000u); }
        }
    }
}
__device__ __forceinline__ void hg_pass_c(LAS unsigned char* lds, int tid, int lane, int wave, const float* LF, bf16* QO, const bf16* V, const bf16* GS, const bf16* ST, const float* gnw) {
    const int p = tid >> 7, kk = tid & 127, g = lane >> 4, l15 = lane & 15, tt = wave & 3, vh = wave >> 2;
    LAS float* part = (LAS float*)(lds + HG_PART); LAS float* red = (LAS float*)(lds + HG_RED);
    LAS bf16* QM = (LAS bf16*)(lds + HG_QM); LAS bf16* KM = (LAS bf16*)(lds + HG_KM); LAS bf16* Q0 = (LAS bf16*)(lds + HG_Q0);
    LAS bf16* VT = (LAS bf16*)(lds + HG_VT); LAS bf16* STL = (LAS bf16*)(lds + HG_STL);
    for (int u = blockIdx.x; u < 2048; u += gridDim.x) {
        const int bh = u >> 7, n = u & 127, b = bh >> 3, h = bh & 7;
        const size_t rowu = (size_t)b * T + n * 64, row0 = rowu + 16 * p;
        { const v4u* src = (const v4u*)(ST + (size_t)u * 16384);
#pragma unroll
          for (int i = 0; i < 4; ++i) { const int q = tid + 512 * i; const v4u x = src[q]; *(LAS v4u*)(STL + (q >> 4) * PQ + (q & 15) * 8) = x; } }
        float G[16], lf[16]; unsigned short vv[16], qq[16];
        const float* lfp = LF + row0 * D + h * 128 + kk; const bf16* vp = V + row0 * D + h * 128 + kk; const bf16* qp = QO + row0 * D + h * 128 + kk;
#pragma unroll
        for (int j = 0; j < 16; ++j) { lf[j] = lfp[(size_t)j * D]; vv[j] = vp[(size_t)j * D]; qq[j] = qp[(size_t)j * D]; }
#pragma unroll
        for (int j = 0; j < 16; ++j) { G[j] = lf[j] + (j ? G[j - 1] : 0.f); }
        part[p * 128 + kk] = G[15];
        __syncthreads();
        const float t0 = part[kk], t1 = part[128 + kk], t2 = part[256 + kk];
        const float off = (p > 0 ? t0 : 0.f) + (p > 1 ? t1 : 0.f) + (p > 2 ? t2 : 0.f), gm = t0 + t1;
        unsigned vw[8];
#pragma unroll
        for (int j = 0; j < 16; ++j) {
            const float Gt = G[j] + off, qv = bf2f(qq[j]), kf = 1.0f - __expf(lf[j]);
            const int t = 16 * p + j;
            QM[t * PQ + kk] = (bf16)f2bf(qv * __expf(Gt - gm));
            KM[t * PQ + kk] = (bf16)f2bf(kf * __expf(gm - Gt));
            Q0[t * PQ + kk] = (bf16)f2bf(qv * __expf(Gt));
        }
#pragma unroll
        for (int j = 0; j < 8; ++j) vw[j] = (unsigned)vv[2 * j] | ((unsigned)vv[2 * j + 1] << 16);
        *(LAS v4u*)(VT + kk * PT + 16 * p) = (v4u){vw[0], vw[1], vw[2], vw[3]}; *(LAS v4u*)(VT + kk * PT + 16 * p + 8) = (v4u){vw[4], vw[5], vw[6], vw[7]};
        __syncthreads();
        f32x4 P[4];
        bf16x8 qf[4];
#pragma unroll
        for (int kc = 0; kc < 4; ++kc) qf[kc] = *(const LAS bf16x8*)(QM + (16 * tt + l15) * PQ + 32 * kc + 8 * g);
#pragma unroll
        for (int st = 0; st < 4; ++st) {
            P[st] = (f32x4){0.f, 0.f, 0.f, 0.f};
            if (st <= tt) {
#pragma unroll
                for (int kc = 0; kc < 4; ++kc) { const bf16x8 a = *(const LAS bf16x8*)(KM + (16 * st + l15) * PQ + 32 * kc + 8 * g); P[st] = MFMA16(a, qf[kc], P[st]); }
                if (st == tt) {
#pragma unroll
                    for (int i = 0; i < 4; ++i) if (4 * g + i > l15) P[st][i] = 0.f; }
            }
        }
        f32x4 O[4];
        bf16x8 pf[2];
#pragma unroll
        for (int sp = 0; sp < 2; ++sp) { v4u w; w.x = pk2(P[2 * sp][0], P[2 * sp][1]); w.y = pk2(P[2 * sp][2], P[2 * sp][3]); w.z = pk2(P[2 * sp + 1][0], P[2 * sp + 1][1]); w.w = pk2(P[2 * sp + 1][2], P[2 * sp + 1][3]);
            pf[sp] = __builtin_bit_cast(bf16x8, w); }
#pragma unroll
        for (int kc = 0; kc < 4; ++kc) qf[kc] = *(const LAS bf16x8*)(Q0 + (16 * tt + l15) * PQ + 32 * kc + 8 * g);
#pragma unroll
        for (int j = 0; j < 4; ++j) {
            const int vrow = 64 * vh + 16 * j + l15;
            O[j] = (f32x4){0.f, 0.f, 0.f, 0.f};
#pragma unroll
            for (int sp = 0; sp < 2; ++sp) {
                if (2 * sp <= tt) {
                    const v2u lo = *(const LAS v2u*)(VT + vrow * PT + 32 * sp + 4 * g), hi = *(const LAS v2u*)(VT + vrow * PT + 32 * sp + 16 + 4 * g);
                    const bf16x8 a = __builtin_bit_cast(bf16x8, (v4u){lo.x, lo.y, hi.x, hi.y});
                    O[j] = MFMA16(a, pf[sp], O[j]);
                }
            }
#pragma unroll
            for (int kc = 0; kc < 4; ++kc) { const bf16x8 a = *(const LAS bf16x8*)(STL + vrow * PQ + 32 * kc + 8 * g); O[j] = MFMA16(a, qf[kc], O[j]); }
        }
        float ss = 0.f;
#pragma unroll
        for (int j = 0; j < 4; ++j) ss += (O[j][0] * O[j][0] + O[j][1] * O[j][1]) + (O[j][2] * O[j][2] + O[j][3] * O[j][3]);
        ss += __shfl_xor(ss, 16); ss += __shfl_xor(ss, 32);
        if (g == 0) red[vh * 64 + 16 * tt + l15] = ss;
        __syncthreads();
        const float tot = red[16 * tt + l15] + red[64 + 16 * tt + l15];
        const float rstd = __builtin_amdgcn_rsqf(tot * (1.0f / 128.0f) + EPS);
        const size_t orow = (rowu + 16 * tt + l15) * D + h * 128;
#pragma unroll
        for (int j = 0; j < 4; ++j) {
            const int v0 = 64 * vh + 16 * j + 4 * g;
            const f32x4 gw = *(const f32x4*)(gnw + v0); const v2u gs = *(const GAS v2u*)(GS + orow + v0);
            const float o0 = O[j][0] * rstd * gw[0] * __uint_as_float(gs.x << 16), o1 = O[j][1] * rstd * gw[1] * __uint_as_float(gs.x & 0xffff0000u);
            const float o2 = O[j][2] * rstd * gw[2] * __uint_as_float(gs.y << 16), o3 = O[j][3] * rstd * gw[3] * __uint_as_float(gs.y & 0xffff0000u);
            v2u o; o.x = pk2(o0, o1); o.y = pk2(o2, o3); *(GAS v2u*)(QO + orow + v0) = o;
        }
        __syncthreads();
    }
}
__device__ __forceinline__ void fox_fz_tail(int lane, int wave, const bf16* XN, const bf16* WfzT, const float* bf, float* LFS) {
    if (wave < 4) {
        const int g = lane >> 4, l15 = lane & 15; const int rbase = 64 * blockIdx.x + 16 * wave;
        for (int rb = rbase; rb < M; rb += 64 * gridDim.x) {
            f32x4 acc = (f32x4){0.f, 0.f, 0.f, 0.f};
            const bf16* ap = WfzT + l15 * D + 8 * g; const bf16* bp = XN + (size_t)(rb + l15) * D + 8 * g;
#pragma unroll 8
            for (int kc = 0; kc < 32; ++kc) { const bf16x8 a = *(const GAS bf16x8*)(ap + 32 * kc), bb = *(const GAS bf16x8*)(bp + 32 * kc); acc = MFMA16(a, bb, acc); }
            const int row = rb + l15, b = row >> 13, s = row & 8191;
#pragma unroll
            for (int i = 0; i < 4; ++i) { const int hh = 4 * g + i; const float z = acc[i] + bf[hh];
                const float lfv = z >= 0.f ? -log1pf(__expf(-z)) : z - log1pf(__expf(z));
                LFS[(size_t)(b * 16 + hh) * T + s] = lfv; }
        }
    }
}
__device__ __forceinline__ void fox_scan(LAS unsigned char* lds, int tid, int lane, int wave, const float* LFS, float* NF) {
    LAS float* wtot = (LAS float*)lds;
    for (int bh = blockIdx.x; bh < 32; bh += gridDim.x) {
        const f32x4* src = (const f32x4*)(LFS + (size_t)bh * T) + tid * 4;
        f32x4 v[4]; float run = 0.f;
#pragma unroll
        for (int j = 0; j < 4; ++j) { v[j] = src[j]; v[j].x += run; v[j].y += v[j].x; v[j].z += v[j].y; v[j].w += v[j].z; run = v[j].w; }
        float inc = run;
#pragma unroll
        for (int o = 1; o < 64; o <<= 1) { const float t = __shfl_up(inc, o); if (lane >= o) inc += t; }
        if (lane == 63) wtot[wave] = inc;
        __syncthreads();
        float off = inc - run;
        for (int w = 0; w < wave; ++w) off += wtot[w];
        const float c = -1.4426950408889634f;
        f32x4* dst = (f32x4*)(NF + (size_t)bh * T) + tid * 4;
#pragma unroll
        for (int j = 0; j < 4; ++j) dst[j] = (v[j] + off) * c;
        __syncthreads();
    }
}


#ifdef DIAG_HG
__device__ __forceinline__ void diag_hg_naive(LAS unsigned char* lds, int tid, const float* LF, const bf16* QOq, const bf16* V, const bf16* GS, const float* gnw, float* DB) {
    LAS float* fl = (LAS float*)lds; LAS float* kl = fl + 128; LAS float* ql = fl + 256; LAS float* ps = fl + 384; LAS float* os = fl + 896;
    const int v = tid & 127, kq = tid >> 7;
    float S[32];
#pragma unroll
    for (int i = 0; i < 32; ++i) S[i] = 0.f;
    for (int t = 0; t < 192; ++t) {
        if (tid < 128) { const float lf = LF[(size_t)t * 1024 + tid]; const float ff = __expf(lf); fl[tid] = ff; kl[tid] = 1.0f - ff; ql[tid] = bf2f(QOq[(size_t)t * 1024 + tid]); }
        __syncthreads();
        const float vt = bf2f(V[(size_t)t * 1024 + v]); float acc = 0.f;
#pragma unroll
        for (int i = 0; i < 32; ++i) { const int k_ = 32 * kq + i; S[i] = fl[k_] * S[i] + kl[k_] * vt; acc += S[i] * ql[k_]; }
        ps[kq * 128 + v] = acc;
        __syncthreads();
        if (tid < 128) os[tid] = ps[tid] + ps[128 + tid] + ps[256 + tid] + ps[384 + tid];
        __syncthreads();
        if (tid < 128) { float ss = 0.f; for (int i = 0; i < 128; ++i) ss += os[i] * os[i];
            DB[t * 128 + tid] = os[tid] * __builtin_amdgcn_rsqf(ss * (1.0f / 128.0f) + EPS) * gnw[tid] * bf2f(GS[(size_t)t * 1024 + tid]); }
        __syncthreads();
    }
}
__device__ __forceinline__ void diag_hg_cmp(LAS unsigned char* lds, int tid, const bf16* O, const float* DB, float* DG) {
    LAS float* r = (LAS float*)lds; float sd = 0.f, ss = 0.f;
    for (int idx = tid + DIAG_T0 * 128; idx < DIAG_T1 * 128; idx += NTHR) { const int t = idx >> 7, v = idx & 127; const float a = DB[idx], b = bf2f(O[(size_t)t * 1024 + v]); sd += (a - b) * (a - b); ss += a * a; }
    sd = wave_sum(sd); ss = wave_sum(ss);
    if ((tid & 63) == 0) { r[(tid >> 6) * 2] = sd; r[(tid >> 6) * 2 + 1] = ss; }
    __syncthreads();
    if (tid == 0) { float a = 0.f, b = 0.f; for (int w = 0; w < 8; ++w) { a += r[2 * w]; b += r[2 * w + 1]; } DG[0] = sqrtf(a / b); }
    __syncthreads();
}
#endif
#ifndef NO_GEMM
#define NO_GEMM 0
#endif
__global__ void __launch_bounds__(NTHR, 2) fwd_megakernel(Args args) {
    extern __shared__ __attribute__((aligned(16))) unsigned char lds_raw[];
    cg::grid_group grid = cg::this_grid();
    LAS unsigned char* lds = (LAS unsigned char*)lds_raw;
    const int tid = threadIdx.x, lane = tid & 63, wave = __builtin_amdgcn_readfirstlane(tid >> 6);
    const int G = gridDim.x, gw = blockIdx.x * NWAVES + wave, NGW = G * NWAVES;
#define A_ws (args.ws)
#define A_x (args.in[0])
#define A_c (args.in[1])
#define A_w_mod (args.in[2])
#define A_b_mod (args.in[3])
#define A_norm1_w (args.in[4])
#define A_norm2_w (args.in[5])
#define A_hg_w_in (args.in[6])
#define A_hg_w_out (args.in[7])
#define A_hg_lb (args.in[8])
#define A_hg_gn_w (args.in[9])
#define A_fox_w_in (args.in[10])
#define A_fox_b_f (args.in[11])
#define A_fox_qn_w (args.in[12])
#define A_fox_kn_w (args.in[13])
#define A_fox_w_out (args.in[14])
#define A_mlp_w1 (args.in[15])
#define A_mlp_w2 (args.in[16])
#define A_final_w (args.in[17])
#define A_out (args.out)
#define MOD ((float*)(A_ws + WS_MOD))
#define LB ((float*)(A_ws + WS_LB))
#define WFZ ((bf16*)(A_ws + WS_WFZ))
#define DN ((float*)(A_ws + WS_DN))
#define LFS ((float*)(A_ws + WS_LFS))
#define NF ((float*)(A_ws + WS_NF))
#define QKNW ((float*)(A_ws + WS_QKNW))
#define W_HGIN ((bf16*)(A_ws + WS_W_HGIN))
#define W_HGOUT ((bf16*)(A_ws + WS_W_HGOUT))
#define W_FOXIN ((bf16*)(A_ws + WS_W_FOXIN))
#define W_FOXOUT ((bf16*)(A_ws + WS_W_FOXOUT))
#define W1_0 ((bf16*)(A_ws + WS_W1_0))
#define W2_0 ((bf16*)(A_ws + WS_W2_0))
#define W1_1 ((bf16*)(A_ws + WS_W1_1))
#define W2_1 ((bf16*)(A_ws + WS_W2_1))
#define XN ((bf16*)(A_ws + WS_XN))
#define QO ((bf16*)(A_ws + WS_QO))
#define B1 ((bf16*)(A_ws + WS_B1))
#define B2 ((bf16*)(A_ws + WS_B2))
#define B3 ((bf16*)(A_ws + WS_B3))
#define ST ((bf16*)(A_ws + WS_ST))
#define HB ((bf16*)(A_ws + WS_H))
#define GSYNC() do { __builtin_amdgcn_fence(__ATOMIC_RELEASE, "agent"); asm volatile("s_waitcnt vmcnt(0) lgkmcnt(0)" ::: "memory"); grid.sync(); __builtin_amdgcn_fence(__ATOMIC_ACQUIRE, "agent"); } while (0)
    {
        LAS float* sc = (LAS float*)lds;
        LAS float* red = (LAS float*)(lds + 8192);
        for (int it = blockIdx.x; it < 192; it += G) {
            for (int i = tid; i < 2048; i += NTHR) { const float cv = A_c[i]; sc[i] = cv * pg8::sigmoid_f(cv); }
            __syncthreads();
            const int li = it / 96, cgp = it % 96, col = 64 * cgp + lane;
            const float* wp = A_w_mod + ((size_t)li * D + 128 * wave) * 6144 + col;
            float a0 = 0.f, a1 = 0.f;
            for (int k0 = 0; k0 < 128; k0 += 8) {
                float wv[8];
#pragma unroll
                for (int j = 0; j < 8; ++j) wv[j] = wp[(size_t)(k0 + j) * 6144];
#pragma unroll
                for (int j = 0; j < 8; ++j) { a0 += sc[128 * wave + k0 + j] * wv[j]; a1 += sc[1024 + 128 * wave + k0 + j] * wv[j]; }
            }
            red[wave * 128 + lane] = a0; red[wave * 128 + 64 + lane] = a1;
            __syncthreads();
            if (wave == 0) { float s0 = 0.f, s1 = 0.f;
#pragma unroll
                for (int w = 0; w < 8; ++w) { s0 += red[w * 128 + lane]; s1 += red[w * 128 + 64 + lane]; }
                const float bb = A_b_mod[li * 6144 + col];
                MOD[(li * 2 + 0) * 6144 + col] = s0 + bb; MOD[(li * 2 + 1) * 6144 + col] = s1 + bb; }
            __syncthreads();
        }
        if (blockIdx.x == G - 1) {
            for (int i = tid; i < 1024; i += NTHR) { const float a0 = A_hg_lb[i], a1 = A_hg_lb[1024 + i], a2 = A_hg_lb[2048 + i]; const float mx = fmaxf(a0, fmaxf(a1, a2));
                const float e0 = __expf(a0 - mx), e1 = __expf(a1 - mx), e2 = __expf(a2 - mx); LB[i] = e0 / (e0 + e1 + e2); }
        }
        if (blockIdx.x == G - 2) {
            for (int i = tid; i < 16 * 1024; i += NTHR) { const int hh = i >> 10, k = i & 1023; WFZ[i] = (bf16)f2bf(A_fox_w_in[(size_t)k * NIN_FOX + 4096 + hh]); }
            if (tid < 64) { QKNW[tid] = A_fox_qn_w[tid]; QKNW[64 + tid] = A_fox_kn_w[tid]; }
        }
        LAS float* scr = (LAS float*)(lds + wave * 16384);
        constexpr int I_A = 16 * 128, I_B = 16 * 32, I_W2 = 64 * 32;
        constexpr int NITEMS = 2 * I_A + 2 * I_B + 2 * I_A + 2 * I_W2;
        for (int it = gw; it < NITEMS; it += NGW) {
            int r = it;
            if (r < I_A) { transpose_item<false>(A_hg_w_in, D, 4096, 4096, W_HGIN, scr, r, lane); continue; } r -= I_A;
            if (r < I_A) { transpose_item<true>(A_fox_w_in, D, NIN_FOX, 4096, W_FOXIN, scr, r, lane); continue; } r -= I_A;
            if (r < I_B) { transpose_item<false>(A_hg_w_out, D, D, D, W_HGOUT, scr, r, lane); continue; } r -= I_B;
            if (r < I_B) { transpose_item<false>(A_fox_w_out, D, D, D, W_FOXOUT, scr, r, lane); continue; } r -= I_B;
            if (r < I_A) { transpose_item<false>(A_mlp_w1, D, FF, FF, W1_0, scr, r, lane); continue; } r -= I_A;
            if (r < I_A) { transpose_item<false>(A_mlp_w1 + (size_t)D * FF, D, FF, FF, W1_1, scr, r, lane); continue; } r -= I_A;
            if (r < I_W2) { transpose_item<false>(A_mlp_w2, FF, D, D, W2_0, scr, r, lane); continue; } r -= I_W2;
            transpose_item<false>(A_mlp_w2 + (size_t)FF * D, FF, D, D, W2_1, scr, r, lane);
        }
    }
    GSYNC();
#define GEMM_PHASE(MODE, Aptr, Bptr, Nn, Kk, EE) do { pg8::Gemm g_{(const pg8::bf16_t*)(Aptr), (const pg8::bf16_t*)(Bptr), M, (Nn), (Kk)}; pg8::StaticOrder S_; S_.init(M, (Nn), G, (int)blockIdx.x); \
        if (!NO_GEMM) pg8::gemm_phase<pg8::Epi<MODE>, pg8::StaticOrder, true, true>(lds, g_, S_, EE); } while (0)
    {
        const float* mod = MOD;
        norm_rows(gw, NGW, lane, A_x, A_norm1_w, mod + 0, mod + 1024, XN, nullptr);
        GSYNC();
        { pg8::Epi<pg8::EPI_HG_IN> E{QO, A_out  , nullptr, LB, 1.f};
          GEMM_PHASE(pg8::EPI_HG_IN, XN, W_HGIN, 4096, D, E); }
        GSYNC();
#ifndef NO_HGA
        hg_pass_a(lds, tid, lane, wave, A_out, B1, ST, DN);
#endif
        GSYNC();
        hg_pass_b(tid, ST, DN);
#ifdef DIAG_HG
        if (blockIdx.x == 0) diag_hg_naive(lds, tid, A_out, QO, B1, B2, A_hg_gn_w, (float*)(A_ws + WS_XN));
#endif
        GSYNC();
#ifndef NO_HGC
        hg_pass_c(lds, tid, lane, wave, A_out, QO, B1, B2, ST, A_hg_gn_w);
#endif
        GSYNC();
#ifdef DIAG_HG
        if (blockIdx.x == 0) diag_hg_cmp(lds, tid, QO, (const float*)(A_ws + WS_XN), (float*)(A_ws + WS_QKNW + 1024));
#endif
        { pg8::Epi<pg8::EPI_RES> E{nullptr, A_out, A_x, mod + 2048, 1.f};
          GEMM_PHASE(pg8::EPI_RES, QO, W_HGOUT, D, D, E); }
        GSYNC();
        norm_rows(gw, NGW, lane, A_out, A_norm2_w, mod + 3072, mod + 4096, XN, nullptr);
        GSYNC();
        { pg8::Epi<pg8::EPI_RELU2> E{HB, nullptr, nullptr, nullptr, 1.f};
          GEMM_PHASE(pg8::EPI_RELU2, XN, W1_0, FF, D, E); }
        GSYNC();
        { pg8::Epi<pg8::EPI_RES> E{nullptr, A_out, A_out, mod + 5120, 1.f};
          GEMM_PHASE(pg8::EPI_RES, HB, W2_0, D, FF, E); }
        GSYNC();
    }
    {
        const float* mod = MOD + 2 * 6144;
        norm_rows(gw, NGW, lane, A_out, A_norm1_w + D, mod + 0, mod + 1024, XN, nullptr);
        GSYNC();
        { pg8::Epi<pg8::EPI_FOX_IN> E{QO, nullptr, nullptr, QKNW, attn_body::C2};
          GEMM_PHASE(pg8::EPI_FOX_IN, XN, W_FOXIN, 4096, D, E); }
        fox_fz_tail(lane, wave, XN, WFZ, A_fox_b_f, LFS);
        GSYNC();
        fox_scan(lds, tid, lane, wave, LFS, NF);
        GSYNC();
        { const attn_body::AttnTensors AT{(const attn_body::bf16*)QO, (const attn_body::bf16*)B1, (const attn_body::bf16*)B2, (attn_body::bf16*)QO, NF, (const attn_body::bf16*)B3};
          const attn_body::StaticOrder S((int)G, (int)blockIdx.x);
#ifndef NO_ATTN
          attn_body::attn_phase<attn_body::StaticOrder>((char*)lds_raw, AT, S);
#endif
        }
        GSYNC();
        { pg8::Epi<pg8::EPI_RES> E{nullptr, A_out, A_out, mod + 2048, 1.f};
          GEMM_PHASE(pg8::EPI_RES, QO, W_FOXOUT, D, D, E); }
        GSYNC();
        norm_rows(gw, NGW, lane, A_out, A_norm2_w + D, mod + 3072, mod + 4096, XN, nullptr);
        GSYNC();
        { pg8::Epi<pg8::EPI_RELU2> E{HB, nullptr, nullptr, nullptr, 1.f};
          GEMM_PHASE(pg8::EPI_RELU2, XN, W1_1, FF, D, E); }
        GSYNC();
        { pg8::Epi<pg8::EPI_RES> E{nullptr, A_out, A_out, mod + 5120, 1.f};
          GEMM_PHASE(pg8::EPI_RES, HB, W2_1, D, FF, E); }
        GSYNC();
    }
    norm_rows(gw, NGW, lane, A_out, A_final_w, nullptr, nullptr, nullptr, A_out);
#if defined(DIAG_HG) || defined(DIAG_ATT)
    GSYNC();
    if (blockIdx.x == 0 && tid == 0) A_out[0] = 1000.0f * (20.0f + log2f(*(const float*)(A_ws + WS_QKNW + 1024) + 1e-9f));
#endif
}

#undef A_ws
#undef A_x
#undef A_c
#undef A_w_mod
#undef A_b_mod
#undef A_norm1_w
#undef A_norm2_w
#undef A_hg_w_in
#undef A_hg_w_out
#undef A_hg_lb
#undef A_hg_gn_w
#undef A_fox_w_in
#undef A_fox_b_f
#undef A_fox_qn_w
#undef A_fox_kn_w
#undef A_fox_w_out
#undef A_mlp_w1
#undef A_mlp_w2
#undef A_final_w
#undef A_out
extern "C" void kernel_launch(void* const* d_in, const int* in_sizes, int n_in, void* d_out, int out_size, void* d_ws, size_t ws_size, hipStream_t stream) {
    static int grid = 0;
    if (grid == 0) {
        if (n_in != 18 || out_size != M * D || ws_size < WS_END) { fprintf(stderr, "kernel_launch: unexpected shapes (n_in %d, out %d, ws %zu)\n", n_in, out_size, ws_size); grid = -1; return; }
        int dev = 0, cus = 0, per_cu = 0;
        hipGetDevice(&dev); hipDeviceGetAttribute(&cus, hipDeviceAttributeMultiprocessorCount, dev);
        if (hipFuncSetAttribute((const void*)fwd_megakernel, hipFuncAttributeMaxDynamicSharedMemorySize, LDS_BYTES) != hipSuccess) { fprintf(stderr, "kernel_launch: hipFuncSetAttribute failed\n"); grid = -1; return; }
        if (hipOccupancyMaxActiveBlocksPerMultiprocessor(&per_cu, (const void*)fwd_megakernel, NTHR, LDS_BYTES) != hipSuccess || per_cu < 1) { fprintf(stderr, "kernel_launch: occupancy query says %d\n", per_cu); per_cu = 1; }
        (void)hipGetLastError();
        grid = cus * 1;
        if (grid != 256) fprintf(stderr, "kernel_launch: %d CUs; built for 256\n", grid);
    }
    if (grid < 0) return;
    Args a{};
    for (int i = 0; i < 18; ++i) a.in[i] = (const float*)d_in[i];
    a.out = (float*)d_out; a.ws = (unsigned char*)d_ws;
    void* kargs[] = {&a};
    hipError_t e = hipLaunchCooperativeKernel((const void*)fwd_megakernel, dim3(grid), dim3(NTHR), kargs, LDS_BYTES, stream);
    if (e != hipSuccess) fprintf(stderr, "cooperative launch failed: %s (grid %d)\n", hipGetErrorString(e), grid);
}
```

```cpp
#include <hip/hip_runtime.h>
#include <hip/hip_cooperative_groups.h>
#include <cstdio>
#include <cstdint>
namespace cg = cooperative_groups;
namespace pg8 {
#define PG8_LAS __attribute__((address_space(3)))
typedef unsigned short bf16_t;
typedef short bf16x8 __attribute__((ext_vector_type(8)));
typedef float f32x4 __attribute__((ext_vector_type(4)));
typedef unsigned u32x4 __attribute__((ext_vector_type(4)));
constexpr int BM = 256, BK = 64, HALF = 128, HTB = HALF * BK * 2  , STAGE_BYTES = 8 * HTB, NXCD = 8, WGM = 8;

__host__ __device__ __forceinline__ int lds_byte(int r, int c) { const int st = (r >> 4) * 2 + (c >> 5), rr = r & 15, cc = c & 31, ob = rr * 64 + cc * 2; return st * 1024 + (ob ^ (((ob >> 9) & 1) << 5)); }
__host__ __device__ __forceinline__ void stage_rc(int b, int& R, int& C) { const int st = b / 1024, sb = b % 1024, swz = sb ^ (((sb >> 9) & 1) << 5); R = (st >> 1) * 16 + swz / 64; C = (st & 1) * 32 + (swz % 64) / 2; }
__host__ __device__ __forceinline__ int perm32(int rho) { const int n = rho >> 4, i = rho & 15; return 8 * (i >> 2) + 4 * n + (i & 3); }

struct Unit { int pm, pn; };
struct Gemm { const bf16_t* A; const bf16_t* Bt; int M, N, K; };

struct StaticOrder {
    int nM, nN, nwg, G, c;
    __host__ __device__ void init(int M, int N, int G_, int c_) { nM = M / BM; nN = N / BM; nwg = nM * nN; G = G_; c = c_; }
    __host__ __device__ bool next(int i, Unit& u) const {
        const long L = (long)i * G + c; if (L >= nwg) return false;
        int wgid = (int)L; { const int q = nwg / NXCD, r = nwg % NXCD, xcd = wgid % NXCD, off = wgid / NXCD; wgid = (xcd < r ? xcd * (q + 1) : r * (q + 1) + (xcd - r) * q) + off; }
        const int nig = WGM * nN, gid = wgid / nig, fm = gid * WGM, gsz = (nM - fm) < WGM ? (nM - fm) : WGM;
        u.pm = fm + ((wgid % nig) % gsz); u.pn = (wgid % nig) / gsz; return true;
    }
    __device__ __forceinline__ void a_ready(const Unit&) const {}
    __device__ __forceinline__ void done(const Unit&) const {}
};

typedef float f32x2_cv __attribute__((ext_vector_type(2))); typedef __bf16 bf16x2_cv __attribute__((ext_vector_type(2)));
__device__ __forceinline__ unsigned cvt_pk_bf16(float lo, float hi) { f32x2_cv v = {lo, hi}; bf16x2_cv b = __builtin_convertvector(v, bf16x2_cv); return __builtin_bit_cast(unsigned, b); }
typedef float f32x2 __attribute__((ext_vector_type(2)));
enum { EPI_HG_IN = 0, EPI_FOX_IN = 1, EPI_RES = 2, EPI_RELU2 = 3 };
__device__ __forceinline__ float sigmoid_f(float z) { return __builtin_amdgcn_rcpf(1.0f + __expf(-z)); }
template <int MODE> struct Epi {
    static constexpr bool PERM = true, AFTER_DRAIN = false;
    bf16_t* o0;
    static constexpr size_t OSTR = (size_t)16 * 1024 * 1024;
    float* f0;
    const float* base;
    const float* p0;
    float qscale;
    __device__ __forceinline__ void operator()(const f32x4 (&acc)[2][2][4][2], const Unit& u, int wr, int wc, int fr, int fq) const {
        const int row0 = u.pm * BM + wr * 64 + fr;
        if constexpr (MODE == EPI_HG_IN) {
            const int seg = u.pn >> 2, col0 = (u.pn & 3) * BM + wc * 32 + 8 * fq;
            if (seg == 1) {
                f32x4 lbv[2][2];
#pragma unroll
                for (int bj = 0; bj < 2; ++bj)
#pragma unroll
                    for (int n = 0; n < 2; ++n) lbv[bj][n] = *(const f32x4*)(p0 + col0 + bj * HALF + 4 * n);
#pragma unroll
                for (int ai = 0; ai < 2; ++ai)
#pragma unroll
                    for (int m = 0; m < 4; ++m) { float* rowp = f0 + (size_t)(row0 + ai * HALF + m * 16) * 1024 + col0;
#pragma unroll
                        for (int bj = 0; bj < 2; ++bj)
#pragma unroll
                            for (int n = 0; n < 2; ++n) { const f32x4 z = acc[ai][bj][m][n], lb = lbv[bj][n]; f32x4 o;
#pragma unroll
                                for (int e = 0; e < 4; ++e) o[e] = __logf(lb[e] + (1.0f - lb[e]) * sigmoid_f(z[e]));
                                *(f32x4*)(rowp + bj * HALF + 4 * n) = o; } }
            } else {
                bf16_t* ob = o0 + (size_t)(seg == 0 ? 0 : seg - 1) * OSTR;
#pragma unroll
                for (int ai = 0; ai < 2; ++ai)
#pragma unroll
                    for (int m = 0; m < 4; ++m) { bf16_t* rowp = ob + (size_t)(row0 + ai * HALF + m * 16) * 1024 + col0;
#pragma unroll
                        for (int bj = 0; bj < 2; ++bj) { f32x4 v0 = acc[ai][bj][m][0], v1 = acc[ai][bj][m][1];
                            if (seg != 2) {
#pragma unroll
                                for (int e = 0; e < 4; ++e) { v0[e] = v0[e] * sigmoid_f(v0[e]); v1[e] = v1[e] * sigmoid_f(v1[e]); } }
                            u32x4 w; w.x = cvt_pk_bf16(v0[0], v0[1]); w.y = cvt_pk_bf16(v0[2], v0[3]); w.z = cvt_pk_bf16(v1[0], v1[1]); w.w = cvt_pk_bf16(v1[2], v1[3]);
                            *(u32x4*)(rowp + bj * HALF) = w; } }
            }
        } else if constexpr (MODE == EPI_FOX_IN) {
            const int seg = u.pn >> 2, colt = (u.pn & 3) * BM;
            if (seg <= 1) {
                const float* w = p0 + 64 * seg; const float sc = seg == 0 ? qscale : 1.0f; bf16_t* ob = o0 + (size_t)seg * OSTR;
                f32x4 wv[2][2];
#pragma unroll
                for (int bj = 0; bj < 2; ++bj)
#pragma unroll
                    for (int n = 0; n < 2; ++n) wv[bj][n] = *(const f32x4*)(w + 32 * bj + 8 * fq + 4 * n);
#pragma unroll
                for (int ai = 0; ai < 2; ++ai)
#pragma unroll
                    for (int m = 0; m < 4; ++m) { float ss = 0.f;
#pragma unroll
                        for (int bj = 0; bj < 2; ++bj)
#pragma unroll
                            for (int n = 0; n < 2; ++n) { const f32x4 x = acc[ai][bj][m][n]; ss += (x[0] * x[0] + x[1] * x[1]) + (x[2] * x[2] + x[3] * x[3]); }
                        ss += __shfl_xor(ss, 16); ss += __shfl_xor(ss, 32);
                        const float rs = __builtin_amdgcn_rsqf(ss * (1.0f / 64.0f) + 1e-6f) * sc;
                        bf16_t* rowp = ob + (size_t)(row0 + ai * HALF + m * 16) * 1024 + colt + 64 * wc + 8 * fq;
#pragma unroll
                        for (int bj = 0; bj < 2; ++bj) { const f32x4 v0 = acc[ai][bj][m][0] * rs * wv[bj][0], v1 = acc[ai][bj][m][1] * rs * wv[bj][1];
                            u32x4 ww; ww.x = cvt_pk_bf16(v0[0], v0[1]); ww.y = cvt_pk_bf16(v0[2], v0[3]); ww.z = cvt_pk_bf16(v1[0], v1[1]); ww.w = cvt_pk_bf16(v1[2], v1[3]);
                            *(u32x4*)(rowp + 32 * bj) = ww; } }
            } else {
                bf16_t* ob = o0 + (size_t)seg * OSTR; const int col0 = colt + wc * 32 + 8 * fq;
#pragma unroll
                for (int ai = 0; ai < 2; ++ai)
#pragma unroll
                    for (int m = 0; m < 4; ++m) { bf16_t* rowp = ob + (size_t)(row0 + ai * HALF + m * 16) * 1024 + col0;
#pragma unroll
                        for (int bj = 0; bj < 2; ++bj) { f32x4 v0 = acc[ai][bj][m][0], v1 = acc[ai][bj][m][1];
                            if (seg == 3) {
#pragma unroll
                                for (int e = 0; e < 4; ++e) { v0[e] = sigmoid_f(v0[e]); v1[e] = sigmoid_f(v1[e]); } }
                            u32x4 w; w.x = cvt_pk_bf16(v0[0], v0[1]); w.y = cvt_pk_bf16(v0[2], v0[3]); w.z = cvt_pk_bf16(v1[0], v1[1]); w.w = cvt_pk_bf16(v1[2], v1[3]);
                            *(u32x4*)(rowp + bj * HALF) = w; } }
            }
        } else if constexpr (MODE == EPI_RES) {
            const int col0 = u.pn * BM + wc * 32 + 8 * fq; const float* gp = p0 + (size_t)(u.pm >> 5) * 6144 + col0;
            f32x4 gv[2][2];
#pragma unroll
            for (int bj = 0; bj < 2; ++bj)
#pragma unroll
                for (int n = 0; n < 2; ++n) gv[bj][n] = *(const f32x4*)(gp + bj * HALF + 4 * n);
#pragma unroll
            for (int ai = 0; ai < 2; ++ai)
#pragma unroll
                for (int m = 0; m < 4; ++m) { const size_t off = (size_t)(row0 + ai * HALF + m * 16) * 1024 + col0;
#pragma unroll
                    for (int bj = 0; bj < 2; ++bj)
#pragma unroll
                        for (int n = 0; n < 2; ++n) { const f32x4 bs = *(const f32x4*)(base + off + bj * HALF + 4 * n);
                            *(f32x4*)(f0 + off + bj * HALF + 4 * n) = bs + gv[bj][n] * acc[ai][bj][m][n]; } }
        } else {
            const int col0 = u.pn * BM + wc * 32 + 8 * fq;
#pragma unroll
            for (int ai = 0; ai < 2; ++ai)
#pragma unroll
                for (int m = 0; m < 4; ++m) { bf16_t* rowp = o0 + (size_t)(row0 + ai * HALF + m * 16) * 4096 + col0;
#pragma unroll
                    for (int bj = 0; bj < 2; ++bj) { f32x4 v0 = acc[ai][bj][m][0], v1 = acc[ai][bj][m][1];
#pragma unroll
                        for (int e = 0; e < 4; ++e) { const float a = fmaxf(v0[e], 0.f), b = fmaxf(v1[e], 0.f); v0[e] = a * a; v1[e] = b * b; }
                        u32x4 w; w.x = cvt_pk_bf16(v0[0], v0[1]); w.y = cvt_pk_bf16(v0[2], v0[3]); w.z = cvt_pk_bf16(v1[0], v1[1]); w.w = cvt_pk_bf16(v1[2], v1[3]);
                        *(u32x4*)(rowp + bj * HALF) = w; } }
        }
    }
};
template <class Epi, class Sched, bool ALIGN_EPI = false, bool SP2 = false>
__device__ __forceinline__ void gemm_phase(PG8_LAS unsigned char* lds, const Gemm g, const Sched& S, const Epi& E) {
    int tid_ = threadIdx.x; asm volatile("" : "+v"(tid_));
    const int tid = tid_, wid = __builtin_amdgcn_readfirstlane(tid >> 6), lane = tid & 63, wr = wid >> 2, wc = wid & 3, fr = lane & 15, fq = lane >> 4;
    const int K = g.K, nt = K / BK;
    unsigned voffA[2], voffB[2];
#pragma unroll
    for (int i = 0; i < 2; ++i) { int R, C; stage_rc(tid * 16 + i * 8192, R, C); const int Rb = Epi::PERM ? ((R & ~31) + perm32(R & 31)) : R;
        voffA[i] = (unsigned)(R * K + C) * 2u; voffB[i] = (unsigned)(Rb * K + C) * 2u; }
    const size_t kstep = (size_t)(BK * 2);
    const size_t hstep = (size_t)HALF * K * 2;
    const size_t tstep = 2 * hstep;
    const unsigned ldsw = (unsigned)wid * 1024u;
    const int aoff = lds_byte(wr * 64 + fr, fq * 8), boff = lds_byte(wc * 32 + fr, fq * 8);
#define PG8_SA(b, h) (((b) * 2 + (h)) * HTB)
#define PG8_SB(b, h) ((4 + (b) * 2 + (h)) * HTB)
#define PG8_STAGE(bufoff, gbase, voff) do { _Pragma("unroll") for (int _i = 0; _i < 2; ++_i) \
        __builtin_amdgcn_global_load_lds((const unsigned*)((const char*)(gbase) + (voff)[_i]), (PG8_LAS unsigned*)(lds + (bufoff) + ldsw + _i * 8192), 16, 0, 0); } while (0)
#define PG8_LDA(dst, b, h) do { _Pragma("unroll") for (int m = 0; m < 4; ++m) _Pragma("unroll") for (int k = 0; k < 2; ++k) dst[m][k] = *(const PG8_LAS bf16x8*)(lds + PG8_SA(b, h) + aoff + m * 2048 + k * 1024); } while (0)
#define PG8_LDB(dst, b, h) do { _Pragma("unroll") for (int n = 0; n < 2; ++n) _Pragma("unroll") for (int k = 0; k < 2; ++k) dst[n][k] = *(const PG8_LAS bf16x8*)(lds + PG8_SB(b, h) + boff + n * 2048 + k * 1024); } while (0)
#define PG8_MMA(ai, bj, At, Bt) do { __builtin_amdgcn_s_setprio(1); _Pragma("unroll") for (int m = 0; m < 4; ++m) _Pragma("unroll") for (int n = 0; n < 2; ++n) _Pragma("unroll") for (int k = 0; k < 2; ++k) \
        acc[ai][bj][m][n] = __builtin_amdgcn_mfma_f32_16x16x32_bf16(Bt[n][k], At[m][k], acc[ai][bj][m][n], 0, 0, 0); __builtin_amdgcn_s_setprio(0); } while (0)
#define PG8_WAIT_V(n) asm volatile("s_waitcnt vmcnt(" #n ")" ::: "memory")
#define PG8_WAIT_L(n) asm volatile("s_waitcnt lgkmcnt(" #n ")" ::: "memory")
#define PG8_BAR __builtin_amdgcn_s_barrier()
#define PG8_SCHED __builtin_amdgcn_sched_barrier(0)
    Unit cur, nxt; int ui = 0;
    if (!S.next(0, cur)) return;
    f32x4 acc[2][2][4][2];
#pragma unroll
    for (int a = 0; a < 2; ++a)
#pragma unroll
        for (int b = 0; b < 2; ++b)
#pragma unroll
            for (int m = 0; m < 4; ++m)
#pragma unroll
                for (int n = 0; n < 2; ++n) acc[a][b][m][n] = (f32x4){0.f, 0.f, 0.f, 0.f};
    bf16x8 At[4][2], B0[2][2], B1[2][2];
    const char* cA = (const char*)g.A + (size_t)cur.pm * tstep; const char* cB = (const char*)g.Bt + (size_t)cur.pn * tstep;
    S.a_ready(cur);
    if constexpr (SP2) {
        PG8_STAGE(PG8_SB(0, 0), cB, voffB); PG8_STAGE(PG8_SB(0, 1), cB + hstep, voffB); PG8_STAGE(PG8_SA(0, 0), cA, voffA); PG8_STAGE(PG8_SA(0, 1), cA + hstep, voffA);
        if (wr == 1) PG8_BAR;
        PG8_WAIT_V(2); PG8_BAR;
        PG8_STAGE(PG8_SB(1, 0), cB + kstep, voffB); PG8_STAGE(PG8_SA(1, 0), cA + kstep, voffA); PG8_STAGE(PG8_SB(1, 1), cB + hstep + kstep, voffB);
        PG8_WAIT_V(6); PG8_BAR;
    } else {
        PG8_STAGE(PG8_SB(0, 0), cB, voffB); PG8_STAGE(PG8_SA(0, 0), cA, voffA); PG8_STAGE(PG8_SB(0, 1), cB + hstep, voffB); PG8_STAGE(PG8_SA(0, 1), cA + hstep, voffA);
        if (wr == 1) PG8_BAR;
        PG8_WAIT_V(4); PG8_BAR;
        PG8_STAGE(PG8_SB(1, 0), cB + kstep, voffB); PG8_STAGE(PG8_SA(1, 0), cA + kstep, voffA); PG8_STAGE(PG8_SB(1, 1), cB + hstep + kstep, voffB);
        PG8_WAIT_V(6); PG8_BAR;
    }
    for (;;) {
        const bool has_next = S.next(ui + 1, nxt);
        const char* nA = has_next ? (const char*)g.A + (size_t)nxt.pm * tstep : cA; const char* nB = has_next ? (const char*)g.Bt + (size_t)nxt.pn * tstep : cB;
        for (int t = 0; t < nt; t += 2) {
            const bool last = (t == nt - 2);
            const char* a1 = cA + (size_t)(t + 1) * kstep;
            const char* a2 = last ? nA : cA + (size_t)(t + 2) * kstep; const char* b2 = last ? nB : cB + (size_t)(t + 2) * kstep;
            const char* a3 = a2 + kstep; const char* b3 = b2 + kstep;
            if (last && has_next) S.a_ready(nxt);
            if constexpr (SP2) {
            PG8_LDB(B0, 0, 0); PG8_LDB(B1, 0, 1); PG8_SCHED; PG8_LDA(At, 0, 0); PG8_STAGE(PG8_SA(1, 1), a1 + hstep, voffA);
            PG8_WAIT_V(8); PG8_WAIT_L(0); PG8_BAR; PG8_MMA(0, 0, At, B0); PG8_MMA(0, 1, At, B1); PG8_BAR; PG8_SCHED;
            PG8_LDA(At, 0, 1); PG8_STAGE(PG8_SB(0, 0), b2, voffB); PG8_STAGE(PG8_SB(0, 1), b2 + hstep, voffB); PG8_STAGE(PG8_SA(0, 0), a2, voffA);
            PG8_WAIT_V(8); PG8_WAIT_L(0); PG8_BAR; PG8_MMA(1, 0, At, B0); PG8_MMA(1, 1, At, B1); PG8_BAR; PG8_SCHED;
            PG8_LDB(B0, 1, 0); PG8_LDB(B1, 1, 1); PG8_SCHED; PG8_LDA(At, 1, 0); PG8_STAGE(PG8_SA(0, 1), a2 + hstep, voffA);
            PG8_WAIT_V(8); PG8_WAIT_L(0); PG8_BAR; PG8_MMA(0, 0, At, B0); PG8_MMA(0, 1, At, B1); PG8_BAR; PG8_SCHED;
            PG8_LDA(At, 1, 1); PG8_STAGE(PG8_SB(1, 0), b3, voffB); PG8_STAGE(PG8_SB(1, 1), b3 + hstep, voffB); PG8_STAGE(PG8_SA(1, 0), a3, voffA);
            PG8_WAIT_V(8); PG8_WAIT_L(0); PG8_BAR; PG8_MMA(1, 0, At, B0); PG8_MMA(1, 1, At, B1); PG8_BAR; PG8_SCHED;
            } else {
            PG8_LDB(B0, 0, 0); PG8_SCHED; PG8_LDA(At, 0, 0); PG8_STAGE(PG8_SA(1, 1), a1 + hstep, voffA);
            PG8_WAIT_L(8); PG8_BAR; PG8_WAIT_L(0); PG8_MMA(0, 0, At, B0); PG8_BAR; PG8_SCHED;
            PG8_LDB(B1, 0, 1); PG8_STAGE(PG8_SB(0, 0), b2, voffB);
            PG8_BAR; PG8_WAIT_L(0); PG8_MMA(0, 1, At, B1); PG8_BAR;
            PG8_LDA(At, 0, 1); PG8_STAGE(PG8_SA(0, 0), a2, voffA);
            PG8_BAR; PG8_WAIT_L(0); PG8_MMA(1, 0, At, B0); PG8_BAR; PG8_SCHED;
            PG8_STAGE(PG8_SB(0, 1), b2 + hstep, voffB);
            PG8_WAIT_V(6); PG8_BAR; PG8_MMA(1, 1, At, B1); PG8_BAR;
            PG8_LDB(B0, 1, 0); PG8_SCHED; PG8_LDA(At, 1, 0); PG8_STAGE(PG8_SA(0, 1), a2 + hstep, voffA);
            PG8_WAIT_L(8); PG8_BAR; PG8_WAIT_L(0); PG8_MMA(0, 0, At, B0); PG8_BAR; PG8_SCHED;
            PG8_LDB(B1, 1, 1); PG8_STAGE(PG8_SB(1, 0), b3, voffB);
            PG8_BAR; PG8_WAIT_L(0); PG8_MMA(0, 1, At, B1); PG8_BAR;
            PG8_LDA(At, 1, 1); PG8_STAGE(PG8_SA(1, 0), a3, voffA);
            PG8_BAR; PG8_WAIT_L(0); PG8_MMA(1, 0, At, B0); PG8_BAR; PG8_SCHED;
            PG8_STAGE(PG8_SB(1, 1), b3 + hstep, voffB);
            PG8_WAIT_V(6); PG8_BAR; PG8_MMA(1, 1, At, B1); PG8_BAR;
            }
        }
        if constexpr (ALIGN_EPI) { if (wr == 0) PG8_BAR; }
        if constexpr (!Epi::AFTER_DRAIN) { E(acc, cur, wr, wc, fr, fq); S.done(cur); }
        if (!has_next) break;
#pragma unroll
        for (int a = 0; a < 2; ++a)
#pragma unroll
            for (int b = 0; b < 2; ++b)
#pragma unroll
                for (int m = 0; m < 4; ++m)
#pragma unroll
                    for (int n = 0; n < 2; ++n) acc[a][b][m][n] = (f32x4){0.f, 0.f, 0.f, 0.f};
        cur = nxt; cA = nA; cB = nB; ++ui;
        if constexpr (ALIGN_EPI) { if (wr == 1) PG8_BAR; }
    }
    PG8_WAIT_V(0);
    if constexpr (!ALIGN_EPI) { if (wr == 0) PG8_BAR; }
    PG8_BAR;
    if constexpr (Epi::AFTER_DRAIN) { E.fused(acc, cur, wr, wc, fr, fq, lds, wid, lane); S.done(cur); }
#undef PG8_SA
#undef PG8_SB
#undef PG8_STAGE
#undef PG8_LDA
#undef PG8_LDB
#undef PG8_MMA
#undef PG8_WAIT_V
#undef PG8_WAIT_L
#undef PG8_BAR
#undef PG8_SCHED
}
}
#include <hip/hip_bf16.h>
#include <cmath>
namespace attn_body {
using bf16=__hip_bfloat16;
using bf16x8=__attribute__((ext_vector_type(8)))short;
using s16x4=__attribute__((ext_vector_type(4)))short;
using f32x16=__attribute__((ext_vector_type(16)))float;
using u32x4=__attribute__((ext_vector_type(4)))unsigned;
constexpr int BATCH=2,NHEAD=16,SEQ=8192,D=64,DM=NHEAD*D;
constexpr int NW=8,QBLK=32,QB=QBLK*NW,KVBLK=64,NQB=SEQ/QB;
constexpr int ATTN_PITCH=DM, ATTN_UNIT_ROWS=QB;
__device__ __forceinline__ int crow(int r,int hi){return (r&3)+8*(r>>2)+4*hi;}
#define SBAR() __builtin_amdgcn_sched_barrier(0)
__device__ __forceinline__ void cmask(f32x16&p0,f32x16&p1,int jb,int qrel,int hi){
  const float NEG=-INFINITY; int qd=qrel-64*jb-4*hi; asm volatile("":"+v"(qd));
  #pragma unroll
  for(int r=0;r<16;++r){ if((r&3)+8*(r>>2)>qd)p0[r]=NEG; if((r&3)+8*(r>>2)+32>qd)p1[r]=NEG;}
}

constexpr int NSLOT=3, SLOTB=8192;
constexpr int LDS_K=0, LDS_V=NSLOT*SLOTB, LDS_WS=2*NSLOT*SLOTB, LDS_OST=LDS_WS+NW*64*4, LDS_NF=LDS_OST+NW*4096, LDS_BYTES=LDS_NF+SEQ*4;
constexpr float C2=0.125f*1.4426950408889634f;
__device__ __forceinline__ void glds16(const void*gsrc,unsigned lds_dst){unsigned keep;
  asm volatile("s_mov_b32 %0, m0\n\ts_mov_b32 m0, %2\n\ts_nop 0\n\tglobal_load_lds_dwordx4 %1, off\n\ts_mov_b32 m0, %0":"=&s"(keep):"v"(gsrc),"s"(lds_dst):"memory");}
__device__ __forceinline__ float max3f(float a,float b,float c){float r;asm("v_max3_f32 %0, %1, %2, %3":"=v"(r):"v"(a),"v"(b),"v"(c));return r;}
__device__ __forceinline__ float max2f(float a,float b){float r;asm("v_max_f32_e32 %0, %1, %2":"=v"(r):"v"(a),"v"(b));return r;}
__device__ __forceinline__ float fadd_s(float a,float b){float r;asm("v_add_f32_e32 %0, %1, %2":"=v"(r):"v"(a),"v"(b));return r;}
__device__ __forceinline__ float fsub_s(float a,float b){float r;asm("v_sub_f32_e32 %0, %1, %2":"=v"(r):"v"(a),"v"(b));return r;}
typedef float f32x2_t __attribute__((ext_vector_type(2))); typedef __bf16 bf16x2_t __attribute__((ext_vector_type(2)));
__device__ __forceinline__ unsigned cvtpk_s(float lo,float hi){f32x2_t v={lo,hi};bf16x2_t b=__builtin_convertvector(v,bf16x2_t);return __builtin_bit_cast(unsigned,b);}
#define WAIT_BAR(N) asm volatile("s_waitcnt vmcnt(" #N ") lgkmcnt(0)\n\ts_barrier":::"memory")

__device__ __forceinline__ void qkt(f32x16&p0,f32x16&p1,const char*Kslot,const bf16x8*qr,int r32,int hi){ const f32x16 negm=f32x16{};
  const char*kb=Kslot+hi*1024+r32*16;
  #pragma unroll
  for(int d0=0;d0<4;++d0){
    const bf16x8 b0=*reinterpret_cast<const bf16x8*>(kb+d0*2048);
    const bf16x8 b1=*reinterpret_cast<const bf16x8*>(kb+d0*2048+512);
    if(d0==0){p0=__builtin_amdgcn_mfma_f32_32x32x16_bf16(b0,qr[0],negm,0,0,0);p1=__builtin_amdgcn_mfma_f32_32x32x16_bf16(b1,qr[0],negm,0,0,0);}
    else{p0=__builtin_amdgcn_mfma_f32_32x32x16_bf16(b0,qr[d0],p0,0,0,0);p1=__builtin_amdgcn_mfma_f32_32x32x16_bf16(b1,qr[d0],p1,0,0,0);}}
}
typedef __attribute__((address_space(3))) const char* lds_cptr;
typedef short v4i16_t __attribute__((ext_vector_type(4)));
__device__ __forceinline__ void kload8(bf16x8*kf,lds_cptr kp){
  kf[0]=*(const __attribute__((address_space(3))) bf16x8*)(kp);      kf[1]=*(const __attribute__((address_space(3))) bf16x8*)(kp+512);
  kf[2]=*(const __attribute__((address_space(3))) bf16x8*)(kp+2048); kf[3]=*(const __attribute__((address_space(3))) bf16x8*)(kp+2560);
  kf[4]=*(const __attribute__((address_space(3))) bf16x8*)(kp+4096); kf[5]=*(const __attribute__((address_space(3))) bf16x8*)(kp+4608);
  kf[6]=*(const __attribute__((address_space(3))) bf16x8*)(kp+6144); kf[7]=*(const __attribute__((address_space(3))) bf16x8*)(kp+6656);
}
__device__ __forceinline__ void kload2(bf16x8*kf,lds_cptr kp,int j){ kf[2*j]=*(const __attribute__((address_space(3))) bf16x8*)(kp+j*2048); kf[2*j+1]=*(const __attribute__((address_space(3))) bf16x8*)(kp+j*2048+512); }
__device__ __forceinline__ s16x4 vtr(lds_cptr p){ return __builtin_bit_cast(s16x4,__builtin_amdgcn_ds_read_tr16_b64_v4i16((__attribute__((address_space(3))) v4i16_t*)p)); }
__device__ __forceinline__ float rowmax(const f32x16&p0,const f32x16&p1){
  float a=max3f(p0[0],p0[1],p1[0]),b=max3f(p0[2],p0[3],p1[1]);a=max3f(a,p1[2],p1[3]);
  #pragma unroll
  for(int r=4;r<16;r+=4){a=max3f(a,p0[r],p0[r+1]);b=max3f(b,p0[r+2],p0[r+3]);a=max3f(a,p1[r],p1[r+1]);b=max3f(b,p1[r+2],p1[r+3]);}
  const float m=max2f(a,b);
  auto rr=__builtin_amdgcn_permlane32_swap(__float_as_uint(m),__float_as_uint(m),false,false);
  return max2f(__uint_as_float(rr[0]),__uint_as_float(rr[1]));
}
__device__ __forceinline__ void pv(f32x16*o,int vb,bf16x8 pa0,bf16x8 pa1,bf16x8 pa2,bf16x8 pa3){
  #pragma unroll
  for(int d0=0;d0<2;++d0){s16x4 lo[4],hi[4];
    #pragma unroll
    for(int ks=0;ks<4;++ks){
      asm volatile("ds_read_b64_tr_b16 %0,%1 offset:%c2":"=&v"(lo[ks]):"v"(vb),"i"(d0*4096+ks*1024):"memory");
      asm volatile("ds_read_b64_tr_b16 %0,%1 offset:%c2":"=&v"(hi[ks]):"v"(vb),"i"(d0*4096+ks*1024+512):"memory");}
    asm volatile("s_waitcnt lgkmcnt(0)":::"memory");SBAR();
    #define PK(k) (bf16x8){lo[k][0],lo[k][1],lo[k][2],lo[k][3],hi[k][0],hi[k][1],hi[k][2],hi[k][3]}
    o[d0]=__builtin_amdgcn_mfma_f32_32x32x16_bf16(pa0,PK(0),o[d0],0,0,0);
    o[d0]=__builtin_amdgcn_mfma_f32_32x32x16_bf16(pa1,PK(1),o[d0],0,0,0);
    o[d0]=__builtin_amdgcn_mfma_f32_32x32x16_bf16(pa2,PK(2),o[d0],0,0,0);
    o[d0]=__builtin_amdgcn_mfma_f32_32x32x16_bf16(pa3,PK(3),o[d0],0,0,0);
    #undef PK
  }
}

#ifndef ATTN_STORE16
#define ATTN_STORE16(p,v) (*(u32x4*)(p)=(v))
#endif
typedef float f32x4_t __attribute__((ext_vector_type(4)));
template<int THRL> __device__ __forceinline__ void attn_unit(int b,int h,int qb,const bf16*Q,const bf16*__restrict__ K,const bf16*__restrict__ V,bf16*O,const float*__restrict__ NFg,const bf16*__restrict__ SG,char*shm){
  int tid_=threadIdx.x; asm volatile("":"+v"(tid_)); const int tid=tid_,lane=tid&63,r32=lane&31,hi=lane>>5; const int wid=__builtin_amdgcn_readfirstlane(tid>>6);
  const long rowbase=(long)b*SEQ; const int q0=qb*QB;
  const bf16*Qw=Q+(rowbase+q0+wid*QBLK)*DM+h*D;
  const bf16*Kh=K+rowbase*DM+h*D,*Vh=V+rowbase*DM+h*D;
  const unsigned lds0=(unsigned)(uintptr_t)shm;
  float*wsf=(float*)(shm+LDS_WS)+wid*64;
  const bf16*ksrc=Kh+(long)lane*DM+wid*8;
  const bf16*vsrc=Vh+(long)(16*(wid&3)+(lane>>2))*DM+(wid>>2)*32+(lane&3)*8;
  const unsigned kdst=lds0+LDS_K+wid*1024, vdst=lds0+LDS_V+wid*1024;
  #define DMA_K(t,slot) glds16(ksrc+(long)(t)*KVBLK*DM,(unsigned)__builtin_amdgcn_readfirstlane(kdst+(slot)))
  #define DMA_V(t,slot) glds16(vsrc+(long)(t)*KVBLK*DM,(unsigned)__builtin_amdgcn_readfirstlane(vdst+(slot)))
  const int vb0=(int)(lds0+LDS_V)+((lane>>4)&1)*32+(lane&3)*8+(4*hi+((lane&15)>>2))*64;
  const char*Kbase=shm+LDS_K; bf16x8 kf[8];
  const lds_cptr shm3=(lds_cptr)shm; const lds_cptr kp0=shm3+LDS_K+hi*1024+r32*16; const lds_cptr vp0=shm3+LDS_V+((lane>>4)&1)*32+(lane&3)*8+(4*hi+((lane&15)>>2))*64;
  const int NT=(q0+QB)/KVBLK;
  { const f32x4_t*nsrc=(const f32x4_t*)(NFg+(long)(b*NHEAD+h)*SEQ); __attribute__((address_space(3))) f32x4_t*ndst=(__attribute__((address_space(3))) f32x4_t*)(shm3+LDS_NF);
    for(int i_=tid;i_<NT*16;i_+=NW*64)ndst[i_]=nsrc[i_]; }
  #define BIAS(P0,P1,t) do{ const __attribute__((address_space(3))) f32x4_t*nb_=(const __attribute__((address_space(3))) f32x4_t*)(shm3+LDS_NF+(t)*256+hi*16); \
    _Pragma("unroll") for(int j_=0;j_<4;++j_){ const f32x4_t a_=nb_[2*j_]; const f32x4_t b_=nb_[2*j_+8]; \
      P0[4*j_]+=a_[0];P0[4*j_+1]+=a_[1];P0[4*j_+2]+=a_[2];P0[4*j_+3]+=a_[3]; P1[4*j_]+=b_[0];P1[4*j_+1]+=b_[1];P1[4*j_+2]+=b_[2];P1[4*j_+3]+=b_[3]; } }while(0)
  DMA_K(0,0);DMA_V(0,0);DMA_K(1,SLOTB);
  bf16x8 qr[4];
  #pragma unroll
  for(int d0=0;d0<4;++d0)qr[d0]=*reinterpret_cast<const bf16x8*>(&Qw[(long)r32*DM+d0*16+hi*8]);
  float mhat=0.f,l_reg=0.f;f32x16 o[2];o[0]=f32x16{};o[1]=f32x16{};const f32x16 negm=f32x16{};
  const int qrel=wid*QBLK+r32;
  #define CMASK(P0,P1,t) do{int jb_=(t)-(NT-4); if(jb_>=0)cmask(P0,P1,jb_,qrel,hi);}while(0)
  bool resc=false;
  #define START(P0,P1) do{ const float rm=rowmax(P0,P1); resc=false; mhat=rm; \
    _Pragma("unroll") for(int r=0;r<16;++r)P0[r]=__builtin_amdgcn_exp2f(fsub_s(P0[r],mhat)); }while(0)
  #define RESC() do{ if(resc){ asm volatile("s_waitcnt lgkmcnt(0)":::"memory"); \
      _Pragma("unroll") for(int d_=0;d_<2;++d_) _Pragma("unroll") for(int r=0;r<16;++r)o[d_][r]*=wsf[crow(r,hi)]; } }while(0)
  f32x16 pA0,pA1,pB0,pB1;
  int sl_prev=0,sl_cur=0,sl_next=SLOTB;
  #define ROT() do{sl_prev=sl_cur;sl_cur=sl_next;sl_next=(sl_next==(NSLOT-1)*SLOTB)?0:sl_next+SLOTB;}while(0)
  DMA_K(2,2*SLOTB);
  WAIT_BAR(3);
  qkt(pA0,pA1,Kbase,qr,r32,hi);asm volatile("s_nop 15\n\ts_nop 7":"+v"(pA0),"+v"(pA1));BIAS(pA0,pA1,0);CMASK(pA0,pA1,0);
  START(pA0,pA1);
  _Pragma("unroll") for(int r=0;r<16;++r)pA1[r]=__builtin_amdgcn_exp2f(fsub_s(pA1[r],mhat));
  WAIT_BAR(0);
  DMA_K(3,0);DMA_V(1,SLOTB);
  ROT();
  kload8(kf,kp0+sl_cur);
  WAIT_BAR(2);
  s16x4 vlo[8],vhi[8]; u32x4 pw0,pw1,pw2,pw3;
  #define PKW(P,B) cvtpk_s(P[B],P[B+1])
  #define PAF(k) __builtin_bit_cast(bf16x8,pw##k)
  #define VFR(i) (bf16x8){vlo[i][0],vlo[i][1],vlo[i][2],vlo[i][3],vhi[i][0],vhi[i][1],vhi[i][2],vhi[i][3]}
  #define PIN(x) asm volatile("":"+v"(x))
  #define MX3(a,b,c) __builtin_fmaxf(__builtin_fmaxf((a),(b)),(c))
  #define GAPA(MF,A0,A1,A2,A3,W0,W1,PW) do{ MF; sacc+=A0; sacc+=A1; sacc+=A2; sacc+=A3; PIN(sacc); W0; W1; PIN(PW); SBAR(); }while(0)
  #define EX(v) __builtin_amdgcn_exp2f(v)
  #define GAPB(MF,X,B) do{ MF; X[B]=EX(X[B]-mhat); X[B+1]=EX(X[B+1]-mhat); X[B+2]=EX(X[B+2]-mhat); X[B+3]=EX(X[B+3]-mhat); PIN(X); SBAR(); }while(0)
  #define VRD(i) do{ vlo[i]=vtr(vp_+(((i)>>2)*4096+((i)&3)*1024)); vhi[i]=vtr(vp_+(((i)>>2)*4096+((i)&3)*1024+512)); }while(0)
  #define KRD(G,j) do{ if(G){ kload2(kf,kp0+sl_next,j); SBAR(); } }while(0)
  #define STEP(C0,C1,P0,P1,t,GK,GV,GL) do{ SBAR(); \
    const lds_cptr vp_=vp0+sl_prev; \
    VRD(0); SBAR(); float sacc=(P0[0]+P0[1]); \
    GAPA(C0=__builtin_amdgcn_mfma_f32_32x32x16_bf16(kf[0],qr[0],negm,0,0,0), P0[2],P0[3],P0[4],P0[5],     pw0[0]=PKW(P0,0), pw0[1]=PKW(P0,2), pw0); \
    VRD(4); SBAR(); GAPA(C1=__builtin_amdgcn_mfma_f32_32x32x16_bf16(kf[1],qr[0],negm,0,0,0), P0[6],P0[7],P0[8],P0[9],     pw0[2]=PKW(P0,4), pw0[3]=PKW(P0,6), pw0); \
    VRD(1); SBAR(); GAPA(C0=__builtin_amdgcn_mfma_f32_32x32x16_bf16(kf[2],qr[1],C0,0,0,0),   P0[10],P0[11],P0[12],P0[13], pw1[0]=PKW(P0,8), pw1[1]=PKW(P0,10), pw1); \
    VRD(5); SBAR(); GAPA(C1=__builtin_amdgcn_mfma_f32_32x32x16_bf16(kf[3],qr[1],C1,0,0,0),   P0[14],P0[15],P1[0],P1[1],   pw1[2]=PKW(P0,12),pw1[3]=PKW(P0,14), pw1); \
    VRD(2); SBAR(); GAPA(C0=__builtin_amdgcn_mfma_f32_32x32x16_bf16(kf[4],qr[2],C0,0,0,0),   P1[2],P1[3],P1[4],P1[5],     pw2[0]=PKW(P1,0), pw2[1]=PKW(P1,2), pw2); \
    VRD(6); SBAR(); GAPA(C1=__builtin_amdgcn_mfma_f32_32x32x16_bf16(kf[5],qr[2],C1,0,0,0),   P1[6],P1[7],P1[8],P1[9],     pw2[2]=PKW(P1,4), pw2[3]=PKW(P1,6), pw2); \
    VRD(3); SBAR(); GAPA(C0=__builtin_amdgcn_mfma_f32_32x32x16_bf16(kf[6],qr[3],C0,0,0,0),   P1[10],P1[11],P1[12],P1[13], pw3[0]=PKW(P1,8), pw3[1]=PKW(P1,10), pw3); \
    VRD(7); SBAR(); GAPA(C1=__builtin_amdgcn_mfma_f32_32x32x16_bf16(kf[7],qr[3],C1,0,0,0),   P1[14],P1[15],0.f,0.f,       pw3[2]=PKW(P1,12),pw3[3]=PKW(P1,14), pw3); \
    l_reg+=sacc; \
    if(GK){DMA_K((t)+3,sl_cur);} if(GV){DMA_V((t)+1,sl_next);} \
    BIAS(C0,C1,t); CMASK(C0,C1,t); \
    { float a=MX3(C0[0],C0[1],C1[0]),b=MX3(C0[2],C0[3],C1[1]); a=MX3(a,C1[2],C1[3]); \
      _Pragma("unroll") for(int r=4;r<16;r+=4){a=MX3(a,C0[r],C0[r+1]);b=MX3(b,C0[r+2],C0[r+3]);a=MX3(a,C1[r],C1[r+1]);b=MX3(b,C1[r+2],C1[r+3]);} \
      float rm=__builtin_fmaxf(a,b); { auto rr=__builtin_amdgcn_permlane32_swap(__float_as_uint(rm),__float_as_uint(rm),false,false); rm=__builtin_fmaxf(__uint_as_float(rr[0]),__uint_as_float(rr[1])); } \
      resc=false; \
      if(__builtin_expect(__any(rm-mhat>(float)THRL),0)){ const float dl=__builtin_fmaxf(rm-mhat,0.f); mhat+=dl; \
        const float f=__builtin_amdgcn_exp2f(-dl); l_reg*=f; if(hi==0)wsf[r32]=f; resc=true; } } \
    SBAR(); \
    GAPB(o[0]=__builtin_amdgcn_mfma_f32_32x32x16_bf16(PAF(0),VFR(0),o[0],0,0,0), C0,0); \
    GAPB(o[1]=__builtin_amdgcn_mfma_f32_32x32x16_bf16(PAF(0),VFR(4),o[1],0,0,0), C0,4); \
    KRD(GL,0); GAPB(o[0]=__builtin_amdgcn_mfma_f32_32x32x16_bf16(PAF(1),VFR(1),o[0],0,0,0), C0,8); \
    KRD(GL,1); GAPB(o[1]=__builtin_amdgcn_mfma_f32_32x32x16_bf16(PAF(1),VFR(5),o[1],0,0,0), C0,12); \
    KRD(GL,2); GAPB(o[0]=__builtin_amdgcn_mfma_f32_32x32x16_bf16(PAF(2),VFR(2),o[0],0,0,0), C1,0); \
    KRD(GL,3); GAPB(o[1]=__builtin_amdgcn_mfma_f32_32x32x16_bf16(PAF(2),VFR(6),o[1],0,0,0), C1,4); \
    GAPB(o[0]=__builtin_amdgcn_mfma_f32_32x32x16_bf16(PAF(3),VFR(3),o[0],0,0,0), C1,8); \
    GAPB(o[1]=__builtin_amdgcn_mfma_f32_32x32x16_bf16(PAF(3),VFR(7),o[1],0,0,0), C1,12); \
    }while(0)
  int t=1;
  #undef CMASK
  #define CMASK(P0,P1,t) do{}while(0)
  for(;t+5<NT;t+=2){
    STEP(pB0,pB1,pA0,pA1,t,true,true,true);     WAIT_BAR(2); RESC(); ROT();
    STEP(pA0,pA1,pB0,pB1,t+1,true,true,true);   WAIT_BAR(2); RESC(); ROT();
  }
  #undef CMASK
  #define CMASK(P0,P1,t) do{int jb_=(t)-(NT-4); if(jb_>=0)cmask(P0,P1,jb_,qrel,hi);}while(0)
  #define ENDW(tt) do{ if((tt)+3<NT){WAIT_BAR(2);} else if((tt)+2<NT){WAIT_BAR(1);} else {WAIT_BAR(0);} }while(0)
  for(;t+1<NT;t+=2){
    STEP(pB0,pB1,pA0,pA1,t,(t+3<NT),(t+1<NT),(t+1<NT));       ENDW(t);   RESC(); ROT();
    STEP(pA0,pA1,pB0,pB1,t+1,(t+4<NT),(t+2<NT),(t+2<NT));     ENDW(t+1); RESC(); ROT();
  }
  STEP(pB0,pB1,pA0,pA1,NT-1,false,false,false); RESC();
  { float sacc=pB0[0]+pB0[1]; _Pragma("unroll") for(int r=2;r<16;++r)sacc+=pB0[r]; _Pragma("unroll") for(int r=0;r<16;++r)sacc+=pB1[r]; l_reg+=sacc;
    pw0=(u32x4){PKW(pB0,0),PKW(pB0,2),PKW(pB0,4),PKW(pB0,6)};pw1=(u32x4){PKW(pB0,8),PKW(pB0,10),PKW(pB0,12),PKW(pB0,14)};pw2=(u32x4){PKW(pB1,0),PKW(pB1,2),PKW(pB1,4),PKW(pB1,6)};pw3=(u32x4){PKW(pB1,8),PKW(pB1,10),PKW(pB1,12),PKW(pB1,14)};
    SBAR(); pv(o,vb0+sl_cur,PAF(0),PAF(1),PAF(2),PAF(3)); }
  #undef PKW
  #undef PAF
  #undef VFR
  #undef PIN
  #undef MX3
  #undef GAPA
  #undef GAPB
  #undef EX
  #undef VRD
  #undef KRD
  #undef STEP
  #undef ENDW
  {auto rr=__builtin_amdgcn_permlane32_swap(__float_as_uint(l_reg),__float_as_uint(l_reg),false,false);l_reg=__uint_as_float(rr[0])+__uint_as_float(rr[1]);}
  if(hi==0)wsf[32+r32]=l_reg;asm volatile("s_waitcnt lgkmcnt(0)":::"memory");
  float rli[16];
  #pragma unroll
  for(int r=0;r<16;++r)rli[r]=__builtin_amdgcn_rcpf(wsf[32+crow(r,hi)]);
  bf16*Ow=O+(rowbase+q0+wid*QBLK)*DM+h*D; const bf16*SGw=SG+(rowbase+q0+wid*QBLK)*DM+h*D;
  { bf16*stg=(bf16*)(shm+LDS_OST)+wid*2048;
    #pragma unroll
    for(int r=0;r<16;++r){const int orow=crow(r,hi);
      #pragma unroll
      for(int d0=0;d0<2;++d0)stg[orow*64+d0*32+r32]=__float2bfloat16(o[d0][r]*rli[r]);}
    asm volatile("s_waitcnt lgkmcnt(0)":::"memory");
    #pragma unroll
    for(int i=0;i<4;++i){const int row=i*8+(lane>>3),ch=lane&7; u32x4 v=*(const u32x4*)(stg+row*64+ch*8); const u32x4 gq=*(const u32x4*)(SGw+(long)row*DM+ch*8);
      _Pragma("unroll") for(int e_=0;e_<4;++e_){ const float lo_=__uint_as_float(v[e_]<<16)*__uint_as_float(gq[e_]<<16), hi_=__uint_as_float(v[e_]&0xffff0000u)*__uint_as_float(gq[e_]&0xffff0000u); v[e_]=cvtpk_s(lo_,hi_); }
      ATTN_STORE16(Ow+(long)row*DM+ch*8,v);} }
  asm volatile("s_waitcnt lgkmcnt(0)\n\ts_barrier":::"memory");
  #undef DMA_K
  #undef BIAS
  #undef DMA_V
  #undef CMASK
  #undef START
  #undef RESC
  #undef ROT
}
constexpr int ATTN_LDS_BYTES=LDS_BYTES;
struct AttnTensors { const bf16* Q; const bf16* K; const bf16* V; bf16* O; const float* NF; const bf16* SG; };
struct AttnUnit { int bh; int qb; };
struct StaticOrder {
  int vcu;
  __device__ __forceinline__ explicit StaticOrder(int grid,int block):vcu((block%8)*(grid/8)+block/8){}
  __device__ __forceinline__ bool next(int i,AttnUnit&u)const{ if(i>=4)return false; const int s=vcu&7; u.bh=vcu>>3; u.qb=(i==0)?s:(i==1)?15-s:(i==2)?16+s:31-s; return true; }
  __device__ __forceinline__ void a_ready(const AttnUnit&)const{}
  __device__ __forceinline__ void done(const AttnUnit&)const{}
};
template<class Sched,int THRL=8> __device__ __forceinline__ void attn_phase(char*lds,const AttnTensors&T,const Sched&S){
  AttnUnit u;
  for(int i=0;S.next(i,u);++i){ S.a_ready(u); attn_unit<THRL>(u.bh/NHEAD,u.bh%NHEAD,u.qb,T.Q,T.K,T.V,T.O,T.NF,T.SG,lds); S.done(u); }
}
#undef SBAR
#undef WAIT_BAR
}
constexpr int NWAVES = 8, NTHR = 512;
constexpr int BATCH = 2, T = 8192, D = 1024, FF = 4096, M = BATCH * T;
constexpr int NIN_FOX = 4 * D + 16;
constexpr float EPS = 1e-6f;
constexpr size_t MiB = 1u << 20;
constexpr size_t WS_MOD = 0;
constexpr size_t WS_LB = 128 * 1024;
constexpr size_t WS_QKNW = 160 * 1024;
constexpr size_t WS_WFZ = 192 * 1024;
constexpr size_t WS_DN = 256 * 1024;
constexpr size_t WS_LFS = 1536 * 1024;
constexpr size_t WS_NF = 2560 * 1024;
constexpr size_t WS_BAR = 3584 * 1024, BAR_BYTES = 16384;
constexpr size_t WS_W_HGIN = 4 * MiB, WS_W_HGOUT = 12 * MiB, WS_W_FOXIN = 14 * MiB, WS_W_FOXOUT = 22 * MiB;
constexpr size_t WS_W1_0 = 24 * MiB, WS_W2_0 = 32 * MiB, WS_W1_1 = 40 * MiB, WS_W2_1 = 48 * MiB;
constexpr size_t WS_XN = 56 * MiB;
constexpr size_t WS_R = 88 * MiB;
constexpr size_t WS_QO = WS_R, WS_B1 = WS_R + 32 * MiB, WS_B2 = WS_R + 64 * MiB, WS_B3 = WS_R + 96 * MiB;
constexpr size_t WS_ST = WS_R + 96 * MiB;
constexpr size_t WS_H = WS_R;
constexpr size_t WS_END = 256 * MiB;
static_assert(WS_ST + 64 * MiB <= WS_END && WS_H + 128 * MiB <= WS_END && WS_B1 - WS_QO == 32 * MiB, "ws map");
constexpr int LDS_BYTES = 147456;

#define GAS __attribute__((address_space(1)))
#define LAS __attribute__((address_space(3)))
typedef unsigned short bf16;
typedef unsigned v4u __attribute__((ext_vector_type(4)));
typedef unsigned v2u __attribute__((ext_vector_type(2)));
typedef float f32x4 __attribute__((ext_vector_type(4)));
typedef short bf16x8 __attribute__((ext_vector_type(8)));
typedef short s16x4v __attribute__((ext_vector_type(4)));
#define LDS_WAIT() asm volatile("s_waitcnt lgkmcnt(0)" ::: "memory")
__device__ __forceinline__ unsigned f2bf(float f) { unsigned u = __builtin_bit_cast(unsigned, f); return (u + 0x7fffu + ((u >> 16) & 1u)) >> 16; }
__device__ __forceinline__ unsigned pk2(float lo, float hi) { return pg8::cvt_pk_bf16(lo, hi); }
__device__ __forceinline__ float bf2f(unsigned short h) { return __uint_as_float((unsigned)h << 16); }
__device__ __forceinline__ float wave_sum(float v) {
#pragma unroll
    for (int o = 1; o < 64; o <<= 1) v += __shfl_xor(v, o);
    return v;
}

struct Args { const float* in[18]; float* out; unsigned char* ws; };

template <bool HEADPERM>
__device__ __forceinline__ void transpose_item(const float* W, int K, int ldw, int Ncols, bf16* WT, LAS float* scr, int item, int lane) {
    const int nblk = Ncols / 32, kb = item / nblk, nb = item % nblk, k0 = 64 * kb, n0 = 32 * nb;
#pragma unroll 8
    for (int i = 0; i < 32; ++i) { const int kk = 2 * i + (lane >> 5); scr[kk * 33 + (lane & 31)] = W[(size_t)(k0 + kk) * ldw + n0 + (lane & 31)]; }
    LDS_WAIT(); asm volatile("" ::: "memory");
    const int c = lane & 7;
#pragma unroll
    for (int j = 0; j < 4; ++j) { const int n = (lane >> 3) + 8 * j; const LAS float* s = scr + (8 * c) * 33 + n;
        v4u o; o.x = pk2(s[0 * 33], s[1 * 33]); o.y = pk2(s[2 * 33], s[3 * 33]); o.z = pk2(s[4 * 33], s[5 * 33]); o.w = pk2(s[6 * 33], s[7 * 33]);
        int col = n0 + n;
        if (HEADPERM && col < 2048) { const int nl = col & 255; col = (col & ~255) + 128 * ((nl >> 5) & 1) + 32 * (nl >> 6) + (nl & 31); }
        *(GAS v4u*)(WT + (size_t)col * K + k0 + 8 * c) = o; }
    LDS_WAIT(); asm volatile("" ::: "memory");
}

__device__ __forceinline__ void norm_rows(int gw, int NGW, int lane, const float* xin, const float* w, const float* modsh, const float* modsc, bf16* outb, float* outf) {
    for (int m = gw; m < M; m += NGW) {
        const GAS f32x4* xr = (const GAS f32x4*)(xin + (size_t)m * D) + lane;
        f32x4 v[4]; float s = 0.f;
#pragma unroll
        for (int j = 0; j < 4; ++j) { v[j] = xr[64 * j]; s += (v[j].x * v[j].x + v[j].y * v[j].y) + (v[j].z * v[j].z + v[j].w * v[j].w); }
        const float rstd = __builtin_amdgcn_rsqf(wave_sum(s) * (1.f / D) + EPS);
        const int b = m >> 13;
#pragma unroll
        for (int j = 0; j < 4; ++j) {
            const f32x4 wv = *((const f32x4*)w + lane + 64 * j);
            f32x4 y = v[j] * rstd * wv;
            if (modsc) { const f32x4 sc = *((const f32x4*)(modsc + b * 6144) + lane + 64 * j), sh = *((const f32x4*)(modsh + b * 6144) + lane + 64 * j); y = y * (1.0f + sc) + sh; }
            if (outf) *((GAS f32x4*)(outf + (size_t)m * D) + lane + 64 * j) = y;
            else { v2u o; o.x = pk2(y.x, y.y); o.y = pk2(y.z, y.w); *((GAS v2u*)(outb + (size_t)m * D) + lane + 64 * j) = o; }
        }
    }
}

constexpr int HG_QM = 0, HG_KM = 17408, HG_Q0 = 34816, HG_KT = 52224, HG_VT = 70656, HG_STL = 89088, HG_PART = 123904, HG_RED = 125952;
constexpr int PQ = 136, PT = 72;
#define MFMA16(a, b, c) __builtin_amdgcn_mfma_f32_16x16x32_bf16((a), (b), (c), 0, 0, 0)

__device__ __forceinline__ void hg_pass_a(LAS unsigned char* lds, int tid, int lane, int wave, const float* LF, const bf16* V, bf16* ST, float* DN) {
    const int p = tid >> 7, kk = tid & 127, g = lane >> 4, l15 = lane & 15;
    LAS float* part = (LAS float*)(lds + HG_PART);
    LAS bf16* KT = (LAS bf16*)(lds + HG_KT); LAS bf16* VT = (LAS bf16*)(lds + HG_VT);
    for (int u = blockIdx.x; u < 2048; u += gridDim.x) {
        const int bh = u >> 7, n = u & 127, b = bh >> 3, h = bh & 7;
        const size_t row0 = (size_t)b * T + n * 64 + 16 * p;
        float G[16], kv[16]; unsigned short vv[16];
        const float* lfp = LF + row0 * D + h * 128 + kk; const bf16* vp = V + row0 * D + h * 128 + kk;
#pragma unroll
        for (int j = 0; j < 16; ++j) { G[j] = lfp[(size_t)j * D]; vv[j] = vp[(size_t)j * D]; }
#pragma unroll
        for (int j = 0; j < 16; ++j) { kv[j] = 1.0f - __expf(G[j]); if (j) G[j] += G[j - 1]; }
        part[p * 128 + kk] = G[15];
        __syncthreads();
        const float t0 = part[kk], t1 = part[128 + kk], t2 = part[256 + kk], t3 = part[384 + kk];
        const float off = (p > 0 ? t0 : 0.f) + (p > 1 ? t1 : 0.f) + (p > 2 ? t2 : 0.f), glast = (t0 + t1) + (t2 + t3);
        unsigned kw[8], vw[8];
#pragma unroll
        for (int j = 0; j < 8; ++j) {
            const float a0 = kv[2 * j] * __expf(glast - (G[2 * j] + off)), a1 = kv[2 * j + 1] * __expf(glast - (G[2 * j + 1] + off));
            kw[j] = pk2(a0, a1); vw[j] = (unsigned)vv[2 * j] | ((unsigned)vv[2 * j + 1] << 16); }
        *(LAS v4u*)(KT + kk * PT + 16 * p) = (v4u){kw[0], kw[1], kw[2], kw[3]}; *(LAS v4u*)(KT + kk * PT + 16 * p + 8) = (v4u){kw[4], kw[5], kw[6], kw[7]};
        *(LAS v4u*)(VT + kk * PT + 16 * p) = (v4u){vw[0], vw[1], vw[2], vw[3]}; *(LAS v4u*)(VT + kk * PT + 16 * p + 8) = (v4u){vw[4], vw[5], vw[6], vw[7]};
        if (p == 0) DN[(size_t)u * 128 + kk] = __expf(glast);
        __syncthreads();
        bf16x8 bfr[2];
#pragma unroll
        for (int ss = 0; ss < 2; ++ss) bfr[ss] = *(const LAS bf16x8*)(VT + (16 * wave + l15) * PT + 32 * ss + 8 * g);
        bf16* stp = ST + ((size_t)u * 128 + 16 * wave + l15) * 128 + 4 * g;
#pragma unroll
        for (int kt = 0; kt < 8; ++kt) {
            f32x4 acc = (f32x4){0.f, 0.f, 0.f, 0.f};
#pragma unroll
            for (int ss = 0; ss < 2; ++ss) { const bf16x8 a = *(const LAS bf16x8*)(KT + (16 * kt + l15) * PT + 32 * ss + 8 * g); acc = MFMA16(a, bfr[ss], acc); }
            v2u o; o.x = pk2(acc[0], acc[1]); o.y = pk2(acc[2], acc[3]); *(GAS v2u*)(stp + 16 * kt) = o;
        }
        __syncthreads();
    }
}
__device__ __forceinline__ void hg_pass_b(int tid, bf16* ST, const float* DN) {
    const int gt = blockIdx.x * NTHR + tid;
    for (int e2 = gt; e2 < 16 * 8192; e2 += gridDim.x * NTHR) {
        const int bh = e2 >> 13, pe = e2 & 8191, k = (2 * pe) & 127;
        unsigned* sp = (unsigned*)ST + (size_t)bh * 128 * 8192 + pe; const float* dp = DN + (size_t)bh * 128 * 128 + k;
        float s0 = 0.f, s1 = 0.f;
        for (int n0 = 0; n0 < 128; n0 += 8) {
            unsigned dv[8]; float d0[8], d1[8];
#pragma unroll
            for (int j = 0; j < 8; ++j) { dv[j] = sp[(size_t)(n0 + j) * 8192]; const float2 dd = *(const float2*)(dp + (size_t)(n0 + j) * 128); d0[j] = dd.x; d1[j] = dd.y; }
#pragma unroll
            for (int j = 0; j < 8; ++j) { sp[(size_t)(n0 + j) * 8192] = pk2(s0, s1);
                s0 = d0[j] * s0 + __uint_as_float(dv[j] << 16); s1 = d1[j] * s1 + __uint_as_float(dv[j] & 0xffff0000u); }
        }
    }
}
__device__ __forceinline__ void hg_pass_c(LAS unsigned char* lds, int tid, int lane, int wave, const float* LF, bf16* QO, const bf16* V, const bf16* GS, const bf16* ST, const float* gnw) {
    const int p = tid >> 7, kk = tid & 127, g = lane >> 4, l15 = lane & 15, tt = wave & 3, vh = wave >> 2;
    LAS float* part = (LAS float*)(lds + HG_PART); LAS float* red = (LAS float*)(lds + HG_RED);
    LAS bf16* QM = (LAS bf16*)(lds + HG_QM); LAS bf16* KM = (LAS bf16*)(lds + HG_KM); LAS bf16* Q0 = (LAS bf16*)(lds + HG_Q0);
    LAS bf16* VT = (LAS bf16*)(lds + HG_VT); LAS bf16* STL = (LAS bf16*)(lds + HG_STL);
    for (int u = blockIdx.x; u < 2048; u += gridDim.x) {
        const int bh = u >> 7, n = u & 127, b = bh >> 3, h = bh & 7;
        const size_t rowu = (size_t)b * T + n * 64, row0 = rowu + 16 * p;
        { const v4u* src = (const v4u*)(ST + (size_t)u * 16384);
#pragma unroll
          for (int i = 0; i < 4; ++i) { const int q = tid + 512 * i; const v4u x = src[q]; *(LAS v4u*)(STL + (q >> 4) * PQ + (q & 15) * 8) = x; } }
        float G[16], lf[16]; unsigned short vv[16], qq[16];
        const float* lfp = LF + row0 * D + h * 128 + kk; const bf16* vp = V + row0 * D + h * 128 + kk; const bf16* qp = QO + row0 * D + h * 128 + kk;
#pragma unroll
        for (int j = 0; j < 16; ++j) { lf[j] = lfp[(size_t)j * D]; vv[j] = vp[(size_t)j * D]; qq[j] = qp[(size_t)j * D]; }
#pragma unroll
        for (int j = 0; j < 16; ++j) { G[j] = lf[j] + (j ? G[j - 1] : 0.f); }
        part[p * 128 + kk] = G[15];
        __syncthreads();
        const float t0 = part[kk], t1 = part[128 + kk], t2 = part[256 + kk];
        const float off = (p > 0 ? t0 : 0.f) + (p > 1 ? t1 : 0.f) + (p > 2 ? t2 : 0.f), gm = t0 + t1;
        unsigned vw[8];
#pragma unroll
        for (int j = 0; j < 16; ++j) {
            const float Gt = G[j] + off, qv = bf2f(qq[j]), kf = 1.0f - __expf(lf[j]);
            const int t = 16 * p + j;
            QM[t * PQ + kk] = (bf16)f2bf(qv * __expf(Gt - gm));
            KM[t * PQ + kk] = (bf16)f2bf(kf * __expf(gm - Gt));
            Q0[t * PQ + kk] = (bf16)f2bf(qv * __expf(Gt));
        }
#pragma unroll
        for (int j = 0; j < 8; ++j) vw[j] = (unsigned)vv[2 * j] | ((unsigned)vv[2 * j + 1] << 16);
        *(LAS v4u*)(VT + kk * PT + 16 * p) = (v4u){vw[0], vw[1], vw[2], vw[3]}; *(LAS v4u*)(VT + kk * PT + 16 * p + 8) = (v4u){vw[4], vw[5], vw[6], vw[7]};
        __syncthreads();
        f32x4 P[4];
        bf16x8 qf[4];
#pragma unroll
        for (int kc = 0; kc < 4; ++kc) qf[kc] = *(const LAS bf16x8*)(QM + (16 * tt + l15) * PQ + 32 * kc + 8 * g);
#pragma unroll
        for (int st = 0; st < 4; ++st) {
            P[st] = (f32x4){0.f, 0.f, 0.f, 0.f};
            if (st <= tt) {
#pragma unroll
                for (int kc = 0; kc < 4; ++kc) { const bf16x8 a = *(const LAS bf16x8*)(KM + (16 * st + l15) * PQ + 32 * kc + 8 * g); P[st] = MFMA16(a, qf[kc], P[st]); }
                if (st == tt) {
#pragma unroll
                    for (int i = 0; i < 4; ++i) if (4 * g + i > l15) P[st][i] = 0.f; }
            }
        }
        f32x4 O[4];
        bf16x8 pf[2];
#pragma unroll
        for (int sp = 0; sp < 2; ++sp) { v4u w; w.x = pk2(P[2 * sp][0], P[2 * sp][1]); w.y = pk2(P[2 * sp][2], P[2 * sp][3]); w.z = pk2(P[2 * sp + 1][0], P[2 * sp + 1][1]); w.w = pk2(P[2 * sp + 1][2], P[2 * sp + 1][3]);
            pf[sp] = __builtin_bit_cast(bf16x8, w); }
#pragma unroll
        for (int kc = 0; kc < 4; ++kc) qf[kc] = *(const LAS bf16x8*)(Q0 + (16 * tt + l15) * PQ + 32 * kc + 8 * g);
#pragma unroll
        for (int j = 0; j < 4; ++j) {
            const int vrow = 64 * vh + 16 * j + l15;
            O[j] = (f32x4){0.f, 0.f, 0.f, 0.f};
#pragma unroll
            for (int sp = 0; sp < 2; ++sp) {
                if (2 * sp <= tt) {
                    const v2u lo = *(const LAS v2u*)(VT + vrow * PT + 32 * sp + 4 * g), hi = *(const LAS v2u*)(VT + vrow * PT + 32 * sp + 16 + 4 * g);
                    const bf16x8 a = __builtin_bit_cast(bf16x8, (v4u){lo.x, lo.y, hi.x, hi.y});
                    O[j] = MFMA16(a, pf[sp], O[j]);
                }
            }
#pragma unroll
            for (int kc = 0; kc < 4; ++kc) { const bf16x8 a = *(const LAS bf16x8*)(STL + vrow * PQ + 32 * kc + 8 * g); O[j] = MFMA16(a, qf[kc], O[j]); }
        }
        float ss = 0.f;
#pragma unroll
        for (int j = 0; j < 4; ++j) ss += (O[j][0] * O[j][0] + O[j][1] * O[j][1]) + (O[j][2] * O[j][2] + O[j][3] * O[j][3]);
        ss += __shfl_xor(ss, 16); ss += __shfl_xor(ss, 32);
        if (g == 0) red[vh * 64 + 16 * tt + l15] = ss;
        __syncthreads();
        const float tot = red[16 * tt + l15] + red[64 + 16 * tt + l15];
        const float rstd = __builtin_amdgcn_rsqf(tot * (1.0f / 128.0f) + EPS);
        const size_t orow = (rowu + 16 * tt + l15) * D + h * 128;
#pragma unroll
        for (int j = 0; j < 4; ++j) {
            const int v0 = 64 * vh + 16 * j + 4 * g;
            const f32x4 gw = *(const f32x4*)(gnw + v0); const v2u gs = *(const GAS v2u*)(GS + orow + v0);
            const float o0 = O[j][0] * rstd * gw[0] * __uint_as_float(gs.x << 16), o1 = O[j][1] * rstd * gw[1] * __uint_as_float(gs.x & 0xffff0000u);
            const float o2 = O[j][2] * rstd * gw[2] * __uint_as_float(gs.y << 16), o3 = O[j][3] * rstd * gw[3] * __uint_as_float(gs.y & 0xffff0000u);
            v2u o; o.x = pk2(o0, o1); o.y = pk2(o2, o3); *(GAS v2u*)(QO + orow + v0) = o;
        }
        __syncthreads();
    }
}
__device__ __forceinline__ void fox_fz_tail(int lane, int wave, const bf16* XN, const bf16* WfzT, const float* bf, float* LFS) {
    if (wave < 4) {
        const int g = lane >> 4, l15 = lane & 15; const int rbase = 64 * blockIdx.x + 16 * wave;
        for (int rb = rbase; rb < M; rb += 64 * gridDim.x) {
            f32x4 acc = (f32x4){0.f, 0.f, 0.f, 0.f};
            const bf16* ap = WfzT + l15 * D + 8 * g; const bf16* bp = XN + (size_t)(rb + l15) * D + 8 * g;
#pragma unroll 8
            for (int kc = 0; kc < 32; ++kc) { const bf16x8 a = *(const GAS bf16x8*)(ap + 32 * kc), bb = *(const GAS bf16x8*)(bp + 32 * kc); acc = MFMA16(a, bb, acc); }
            const int row = rb + l15, b = row >> 13, s = row & 8191;
#pragma unroll
            for (int i = 0; i < 4; ++i) { const int hh = 4 * g + i; const float z = acc[i] + bf[hh];
                const float lfv = z >= 0.f ? -log1pf(__expf(-z)) : z - log1pf(__expf(z));
                LFS[(size_t)(b * 16 + hh) * T + s] = lfv; }
        }
    }
}
__device__ __forceinline__ void fox_scan(LAS unsigned char* lds, int tid, int lane, int wave, const float* LFS, float* NF) {
    LAS float* wtot = (LAS float*)lds;
    for (int bh = blockIdx.x; bh < 32; bh += gridDim.x) {
        const f32x4* src = (const f32x4*)(LFS + (size_t)bh * T) + tid * 4;
        f32x4 v[4]; float run = 0.f;
#pragma unroll
        for (int j = 0; j < 4; ++j) { v[j] = src[j]; v[j].x += run; v[j].y += v[j].x; v[j].z += v[j].y; v[j].w += v[j].z; run = v[j].w; }
        float inc = run;
#pragma unroll
        for (int o = 1; o < 64; o <<= 1) { const float t = __shfl_up(inc, o); if (lane >= o) inc += t; }
        if (lane == 63) wtot[wave] = inc;
        __syncthreads();
        float off = inc - run;
        for (int w = 0; w < wave; ++w) off += wtot[w];
        const float c = -1.4426950408889634f;
        f32x4* dst = (f32x4*)(NF + (size_t)bh * T) + tid * 4;
#pragma unroll
        for (int j = 0; j < 4; ++j) dst[j] = (v[j] + off) * c;
        __syncthreads();
    }
}


#ifdef DIAG_HG
__device__ __forceinline__ void diag_hg_naive(LAS unsigned char* lds, int tid, const float* LF, const bf16* QOq, const bf16* V, const bf16* GS, const float* gnw, float* DB) {
    LAS float* fl = (LAS float*)lds; LAS float* kl = fl + 128; LAS float* ql = fl + 256; LAS float* ps = fl + 384; LAS float* os = fl + 896;
    const int v = tid & 127, kq = tid >> 7;
    float S[32];
#pragma unroll
    for (int i = 0; i < 32; ++i) S[i] = 0.f;
    for (int t = 0; t < 192; ++t) {
        if (tid < 128) { const float lf = LF[(size_t)t * 1024 + tid]; const float ff = __expf(lf); fl[tid] = ff; kl[tid] = 1.0f - ff; ql[tid] = bf2f(QOq[(size_t)t * 1024 + tid]); }
        __syncthreads();
        const float vt = bf2f(V[(size_t)t * 1024 + v]); float acc = 0.f;
#pragma unroll
        for (int i = 0; i < 32; ++i) { const int k_ = 32 * kq + i; S[i] = fl[k_] * S[i] + kl[k_] * vt; acc += S[i] * ql[k_]; }
        ps[kq * 128 + v] = acc;
        __syncthreads();
        if (tid < 128) os[tid] = ps[tid] + ps[128 + tid] + ps[256 + tid] + ps[384 + tid];
        __syncthreads();
        if (tid < 128) { float ss = 0.f; for (int i = 0; i < 128; ++i) ss += os[i] * os[i];
            DB[t * 128 + tid] = os[tid] * __builtin_amdgcn_rsqf(ss * (1.0f / 128.0f) + EPS) * gnw[tid] * bf2f(GS[(size_t)t * 1024 + tid]); }
        __syncthreads();
    }
}
__device__ __forceinline__ void diag_hg_cmp(LAS unsigned char* lds, int tid, const bf16* O, const float* DB, float* DG) {
    LAS float* r = (LAS float*)lds; float sd = 0.f, ss = 0.f;
    for (int idx = tid + DIAG_T0 * 128; idx < DIAG_T1 * 128; idx += NTHR) { const int t = idx >> 7, v = idx & 127; const float a = DB[idx], b = bf2f(O[(size_t)t * 1024 + v]); sd += (a - b) * (a - b); ss += a * a; }
    sd = wave_sum(sd); ss = wave_sum(ss);
    if ((tid & 63) == 0) { r[(tid >> 6) * 2] = sd; r[(tid >> 6) * 2 + 1] = ss; }
    __syncthreads();
    if (tid == 0) { float a = 0.f, b = 0.f; for (int w = 0; w < 8; ++w) { a += r[2 * w]; b += r[2 * w + 1]; } DG[0] = sqrtf(a / b); }
    __syncthreads();
}
#endif
#ifndef NO_GEMM
#define NO_GEMM 0
#endif
#ifndef REP_SYNC
#define REP_SYNC 1
#endif
#ifndef REP_NORM
#define REP_NORM 1
#endif
#ifndef REP_HGAB
#define REP_HGAB 1
#endif
#ifndef REP_GEMM
#define REP_GEMM 1
#endif
#ifndef REP_P0
#define REP_P0 1
#endif
#ifndef REP_SCAN
#define REP_SCAN 1
#endif
#define RLX_AGENT __ATOMIC_RELAXED, __HIP_MEMORY_SCOPE_AGENT
#define XB_TMO      128
#define XB_XCNT(j)  (256  + 64 * (j))
#define XB_XSUB(j)  (1280 + 64 * (j))
#define XB_XGEN(j)  (2304 + 64 * (j))
#define XB_TOP      3328
#define XB_TOPGEN   3392
#define XCD_BAR_WORDS 3456
#define XB_SPIN_CAP (1u << 18)

__device__ __forceinline__ unsigned xb_ld(unsigned* p)              { return __hip_atomic_load(p, __ATOMIC_RELAXED, __HIP_MEMORY_SCOPE_AGENT); }
__device__ __forceinline__ unsigned xb_add(unsigned* p, unsigned v) { return __hip_atomic_fetch_add(p, v, __ATOMIC_RELAXED, __HIP_MEMORY_SCOPE_AGENT); }
__device__ __forceinline__ unsigned xb_xcc_id() { return (unsigned)__builtin_amdgcn_s_getreg((3 << 11) | 20) & 0xFu; }
#define XB_SPIN(cond, bar) do { unsigned _sp = 0; while (cond) { __builtin_amdgcn_s_sleep(1); \
    if ((++_sp & 255u) == 0u) { if (xb_ld(&(bar)[XB_TMO])) break; if (_sp > XB_SPIN_CAP) { atomicAdd(&(bar)[XB_TMO], 1u); break; } } } } while (0)

struct XcdBarrier {
    unsigned* bar; unsigned x;
    volatile LAS unsigned* st;
};

__device__ __forceinline__ XcdBarrier xcd_barrier_post(unsigned* bar, volatile LAS unsigned* st) {
    XcdBarrier b; b.bar = bar; b.x = xb_xcc_id(); b.st = st;
    if (threadIdx.x == 0) (void)xb_add(&bar[XB_XCNT(b.x)], 1u);
    return b;
}
__device__ __forceinline__ void xcd_barrier_complete(unsigned* bar, unsigned x, unsigned& nloc, unsigned& nx) {
    const unsigned G = gridDim.x * gridDim.y * gridDim.z;
    unsigned sum, cnt, mine, sp = 0u;
    for (;;) {
        sum = 0u; cnt = 0u; mine = 0u;
#pragma unroll
        for (unsigned j = 0; j < 16; ++j) { const unsigned c = xb_ld(&bar[XB_XCNT(j)]); sum += c; cnt += (c > 0u) ? 1u : 0u; mine = (j == x) ? c : mine; }
        if (sum == G) break;
        __builtin_amdgcn_s_sleep(1);
        if ((++sp & 255u) == 0u) { if (xb_ld(&bar[XB_TMO])) break; if (sp > XB_SPIN_CAP) { atomicAdd(&bar[XB_TMO], 1u); break; } }
    }
    nloc = mine > 0u ? mine : 1u; nx = cnt > 0u ? cnt : 1u;
}

__device__ __forceinline__ void xcd_barrier(const XcdBarrier& b) {
    asm volatile("s_waitcnt vmcnt(0)" ::: "memory");
    __syncthreads();
    if (threadIdx.x == 0) {
        unsigned* bar = b.bar;
        __builtin_amdgcn_s_waitcnt(0);
        unsigned nloc = b.st[0], nx = b.st[1];
        if (nloc == 0u) { xcd_barrier_complete(bar, b.x, nloc, nx); b.st[0] = nloc; b.st[1] = nx; }
        const unsigned old = xb_add(&bar[XB_XSUB(b.x)], 1u);
        const unsigned gen = old / nloc;
        if (old + 1u == (gen + 1u) * nloc) {
            __builtin_amdgcn_fence(__ATOMIC_RELEASE, "agent");
            asm volatile("s_waitcnt vmcnt(0)" ::: "memory");
            const unsigned og = xb_add(&bar[XB_TOP], 1u);
            const unsigned tg = og / nx;
            if (og + 1u == (tg + 1u) * nx) xb_add(&bar[XB_TOPGEN], 1u);
            else XB_SPIN(xb_ld(&bar[XB_TOPGEN]) == tg, bar);
            __builtin_amdgcn_fence(__ATOMIC_ACQUIRE, "agent");
            xb_add(&bar[XB_XGEN(b.x)], 1u);
            asm volatile("s_waitcnt vmcnt(0)" ::: "memory");
        } else {
            XB_SPIN(xb_ld(&bar[XB_XGEN(b.x)]) == gen, bar);
            __builtin_amdgcn_fence(__ATOMIC_ACQUIRE, "agent");
            asm volatile("s_waitcnt vmcnt(0)" ::: "memory");
        }
    }
    __syncthreads();
}

__global__ void __launch_bounds__(NTHR, 2) fwd_megakernel(Args args) {
    extern __shared__ __attribute__((aligned(16))) unsigned char lds_raw[];
    cg::grid_group grid = cg::this_grid();
    LAS unsigned char* lds = (LAS unsigned char*)lds_raw;
    const int tid = threadIdx.x, lane = tid & 63, wave = __builtin_amdgcn_readfirstlane(tid >> 6);
    const int G = gridDim.x, gw = blockIdx.x * NWAVES + wave, NGW = G * NWAVES;
    volatile LAS unsigned* MISC = (volatile LAS unsigned*)(lds + 131072 + 320);
    if (tid < 32) MISC[tid] = 0u;
    __syncthreads();
    XcdBarrier bar = xcd_barrier_post((unsigned*)(args.ws + WS_BAR), MISC + 8);
#define A_ws (args.ws)
#define A_x (args.in[0])
#define A_c (args.in[1])
#define A_w_mod (args.in[2])
#define A_b_mod (args.in[3])
#define A_norm1_w (args.in[4])
#define A_norm2_w (args.in[5])
#define A_hg_w_in (args.in[6])
#define A_hg_w_out (args.in[7])
#define A_hg_lb (args.in[8])
#define A_hg_gn_w (args.in[9])
#define A_fox_w_in (args.in[10])
#define A_fox_b_f (args.in[11])
#define A_fox_qn_w (args.in[12])
#define A_fox_kn_w (args.in[13])
#define A_fox_w_out (args.in[14])
#define A_mlp_w1 (args.in[15])
#define A_mlp_w2 (args.in[16])
#define A_final_w (args.in[17])
#define A_out (args.out)
#define MOD ((float*)(A_ws + WS_MOD))
#define LB ((float*)(A_ws + WS_LB))
#define WFZ ((bf16*)(A_ws + WS_WFZ))
#define DN ((float*)(A_ws + WS_DN))
#define LFS ((float*)(A_ws + WS_LFS))
#define NF ((float*)(A_ws + WS_NF))
#define QKNW ((float*)(A_ws + WS_QKNW))
#define W_HGIN ((bf16*)(A_ws + WS_W_HGIN))
#define W_HGOUT ((bf16*)(A_ws + WS_W_HGOUT))
#define W_FOXIN ((bf16*)(A_ws + WS_W_FOXIN))
#define W_FOXOUT ((bf16*)(A_ws + WS_W_FOXOUT))
#define W1_0 ((bf16*)(A_ws + WS_W1_0))
#define W2_0 ((bf16*)(A_ws + WS_W2_0))
#define W1_1 ((bf16*)(A_ws + WS_W1_1))
#define W2_1 ((bf16*)(A_ws + WS_W2_1))
#define XN ((bf16*)(A_ws + WS_XN))
#define QO ((bf16*)(A_ws + WS_QO))
#define B1 ((bf16*)(A_ws + WS_B1))
#define B2 ((bf16*)(A_ws + WS_B2))
#define B3 ((bf16*)(A_ws + WS_B3))
#define ST ((bf16*)(A_ws + WS_ST))
#define HB ((bf16*)(A_ws + WS_H))
#define GSYNC() do { for (int rs_ = 0; rs_ < REP_SYNC; ++rs_) xcd_barrier(bar); } while (0)
#define GSYNC_CG() do { asm volatile("s_waitcnt vmcnt(0) lgkmcnt(0)" ::: "memory"); grid.sync(); } while (0)
    for (int rp_ = 0; rp_ < REP_P0; ++rp_) {
        __syncthreads();
        LAS float* sc = (LAS float*)lds;
        LAS float* red = (LAS float*)(lds + 8192);
        for (int it = blockIdx.x; it < 192; it += G) {
            for (int i = tid; i < 2048; i += NTHR) { const float cv = A_c[i]; sc[i] = cv * pg8::sigmoid_f(cv); }
            __syncthreads();
            const int li = it / 96, cgp = it % 96, col = 64 * cgp + lane;
            const float* wp = A_w_mod + ((size_t)li * D + 128 * wave) * 6144 + col;
            float a0 = 0.f, a1 = 0.f;
            for (int k0 = 0; k0 < 128; k0 += 8) {
                float wv[8];
#pragma unroll
                for (int j = 0; j < 8; ++j) wv[j] = wp[(size_t)(k0 + j) * 6144];
#pragma unroll
                for (int j = 0; j < 8; ++j) { a0 += sc[128 * wave + k0 + j] * wv[j]; a1 += sc[1024 + 128 * wave + k0 + j] * wv[j]; }
            }
            red[wave * 128 + lane] = a0; red[wave * 128 + 64 + lane] = a1;
            __syncthreads();
            if (wave == 0) { float s0 = 0.f, s1 = 0.f;
#pragma unroll
                for (int w = 0; w < 8; ++w) { s0 += red[w * 128 + lane]; s1 += red[w * 128 + 64 + lane]; }
                const float bb = A_b_mod[li * 6144 + col];
                MOD[(li * 2 + 0) * 6144 + col] = s0 + bb; MOD[(li * 2 + 1) * 6144 + col] = s1 + bb; }
            __syncthreads();
        }
        if (blockIdx.x == G - 1) {
            for (int i = tid; i < 1024; i += NTHR) { const float a0 = A_hg_lb[i], a1 = A_hg_lb[1024 + i], a2 = A_hg_lb[2048 + i]; const float mx = fmaxf(a0, fmaxf(a1, a2));
                const float e0 = __expf(a0 - mx), e1 = __expf(a1 - mx), e2 = __expf(a2 - mx); LB[i] = e0 / (e0 + e1 + e2); }
        }
        if (blockIdx.x == G - 2) {
            for (int i = tid; i < 16 * 1024; i += NTHR) { const int hh = i >> 10, k = i & 1023; WFZ[i] = (bf16)f2bf(A_fox_w_in[(size_t)k * NIN_FOX + 4096 + hh]); }
            if (tid < 64) { QKNW[tid] = A_fox_qn_w[tid]; QKNW[64 + tid] = A_fox_kn_w[tid]; }
        }
        LAS float* scr = (LAS float*)(lds + wave * 16384);
        constexpr int I_A = 16 * 128, I_B = 16 * 32, I_W2 = 64 * 32;
        constexpr int NITEMS = 2 * I_A + 2 * I_B + 2 * I_A + 2 * I_W2;
        for (int it = gw; it < NITEMS; it += NGW) {
            int r = it;
            if (r < I_A) { transpose_item<false>(A_hg_w_in, D, 4096, 4096, W_HGIN, scr, r, lane); continue; } r -= I_A;
            if (r < I_A) { transpose_item<true>(A_fox_w_in, D, NIN_FOX, 4096, W_FOXIN, scr, r, lane); continue; } r -= I_A;
            if (r < I_B) { transpose_item<false>(A_hg_w_out, D, D, D, W_HGOUT, scr, r, lane); continue; } r -= I_B;
            if (r < I_B) { transpose_item<false>(A_fox_w_out, D, D, D, W_FOXOUT, scr, r, lane); continue; } r -= I_B;
            if (r < I_A) { transpose_item<false>(A_mlp_w1, D, FF, FF, W1_0, scr, r, lane); continue; } r -= I_A;
            if (r < I_A) { transpose_item<false>(A_mlp_w1 + (size_t)D * FF, D, FF, FF, W1_1, scr, r, lane); continue; } r -= I_A;
            if (r < I_W2) { transpose_item<false>(A_mlp_w2, FF, D, D, W2_0, scr, r, lane); continue; } r -= I_W2;
            transpose_item<false>(A_mlp_w2 + (size_t)FF * D, FF, D, D, W2_1, scr, r, lane);
        }
    }
    GSYNC_CG();
#define GEMM_PHASE(MODE, Aptr, Bptr, Nn, Kk, EE) GEMM_PHASE_R(1, MODE, Aptr, Bptr, Nn, Kk, EE)
#define GEMM_PHASE_R(RR, MODE, Aptr, Bptr, Nn, Kk, EE) do { for (int rg_ = 0; rg_ < (RR); ++rg_) { pg8::Gemm g_{(const pg8::bf16_t*)(Aptr), (const pg8::bf16_t*)(Bptr), M, (Nn), (Kk)}; pg8::StaticOrder S_; S_.init(M, (Nn), G, (int)blockIdx.x); \
        if (!NO_GEMM) pg8::gemm_phase<pg8::Epi<MODE>, pg8::StaticOrder, true, true>(lds, g_, S_, EE); } } while (0)
    {
        const float* mod = MOD;
        for (int rn_ = 0; rn_ < REP_NORM; ++rn_) norm_rows(gw, NGW, lane, A_x, A_norm1_w, mod + 0, mod + 1024, XN, nullptr);
        GSYNC();
        { pg8::Epi<pg8::EPI_HG_IN> E{QO, A_out  , nullptr, LB, 1.f};
          GEMM_PHASE_R(REP_GEMM, pg8::EPI_HG_IN, XN, W_HGIN, 4096, D, E); }
        GSYNC();
        for (int rh_ = 0; rh_ < REP_HGAB; ++rh_) {
        if (rh_) GSYNC();
        hg_pass_a(lds, tid, lane, wave, A_out, B1, ST, DN);
        GSYNC();
        hg_pass_b(tid, ST, DN);
        }
#ifdef DIAG_HG
        if (blockIdx.x == 0) diag_hg_naive(lds, tid, A_out, QO, B1, B2, A_hg_gn_w, (float*)(A_ws + WS_XN));
#endif
        GSYNC();
#ifndef NO_HGC
        hg_pass_c(lds, tid, lane, wave, A_out, QO, B1, B2, ST, A_hg_gn_w);
#endif
        GSYNC();
#ifdef DIAG_HG
        if (blockIdx.x == 0) diag_hg_cmp(lds, tid, QO, (const float*)(A_ws + WS_XN), (float*)(A_ws + WS_QKNW + 1024));
#endif
        { pg8::Epi<pg8::EPI_RES> E{nullptr, A_out, A_x, mod + 2048, 1.f};
          GEMM_PHASE_R(REP_GEMM, pg8::EPI_RES, QO, W_HGOUT, D, D, E); }
        GSYNC();
        for (int rn_ = 0; rn_ < REP_NORM; ++rn_) norm_rows(gw, NGW, lane, A_out, A_norm2_w, mod + 3072, mod + 4096, XN, nullptr);
        GSYNC();
        { pg8::Epi<pg8::EPI_RELU2> E{HB, nullptr, nullptr, nullptr, 1.f};
          GEMM_PHASE_R(REP_GEMM, pg8::EPI_RELU2, XN, W1_0, FF, D, E); }
        GSYNC();
        { pg8::Epi<pg8::EPI_RES> E{nullptr, A_out, A_out, mod + 5120, 1.f};
          GEMM_PHASE(pg8::EPI_RES, HB, W2_0, D, FF, E); }
        GSYNC();
    }
    {
        const float* mod = MOD + 2 * 6144;
        for (int rn_ = 0; rn_ < REP_NORM; ++rn_) norm_rows(gw, NGW, lane, A_out, A_norm1_w + D, mod + 0, mod + 1024, XN, nullptr);
        GSYNC();
        { pg8::Epi<pg8::EPI_FOX_IN> E{QO, nullptr, nullptr, QKNW, attn_body::C2};
          GEMM_PHASE_R(REP_GEMM, pg8::EPI_FOX_IN, XN, W_FOXIN, 4096, D, E); }
        for (int rz_ = 0; rz_ < REP_SCAN; ++rz_) fox_fz_tail(lane, wave, XN, WFZ, A_fox_b_f, LFS);
        GSYNC();
        for (int rz_ = 0; rz_ < REP_SCAN; ++rz_) fox_scan(lds, tid, lane, wave, LFS, NF);
        GSYNC();
        { const attn_body::AttnTensors AT{(const attn_body::bf16*)QO, (const attn_body::bf16*)B1, (const attn_body::bf16*)B2, (attn_body::bf16*)QO, NF, (const attn_body::bf16*)B3};
          const attn_body::StaticOrder S((int)G, (int)blockIdx.x);
#ifndef NO_ATTN
          attn_body::attn_phase<attn_body::StaticOrder>((char*)lds_raw, AT, S);
#endif
        }
        GSYNC();
        { pg8::Epi<pg8::EPI_RES> E{nullptr, A_out, A_out, mod + 2048, 1.f};
          GEMM_PHASE(pg8::EPI_RES, QO, W_FOXOUT, D, D, E); }
        GSYNC();
        for (int rn_ = 0; rn_ < REP_NORM; ++rn_) norm_rows(gw, NGW, lane, A_out, A_norm2_w + D, mod + 3072, mod + 4096, XN, nullptr);
        GSYNC();
        { pg8::Epi<pg8::EPI_RELU2> E{HB, nullptr, nullptr, nullptr, 1.f};
          GEMM_PHASE_R(REP_GEMM, pg8::EPI_RELU2, XN, W1_1, FF, D, E); }
        GSYNC();
        { pg8::Epi<pg8::EPI_RES> E{nullptr, A_out, A_out, mod + 5120, 1.f};
          GEMM_PHASE(pg8::EPI_RES, HB, W2_1, D, FF, E); }
        GSYNC();
    }
    norm_rows(gw, NGW, lane, A_out, A_final_w, nullptr, nullptr, nullptr, A_out);
#if defined(DIAG_HG) || defined(DIAG_ATT)
    GSYNC();
    if (blockIdx.x == 0 && tid == 0) A_out[0] = 1000.0f * (20.0f + log2f(*(const float*)(A_ws + WS_QKNW + 1024) + 1e-9f));
#endif
}

#undef A_ws
#undef A_x
#undef A_c
#undef A_w_mod
#undef A_b_mod
#undef A_norm1_w
#undef A_norm2_w
#undef A_hg_w_in
#undef A_hg_w_out
#undef A_hg_lb
#undef A_hg_gn_w
#undef A_fox_w_in
#undef A_fox_b_f
#undef A_fox_qn_w
#undef A_fox_kn_w
#undef A_fox_w_out
#undef A_mlp_w1
#undef A_mlp_w2
#undef A_final_w
#undef A_out
extern "C" void kernel_launch(void* const* d_in, const int* in_sizes, int n_in, void* d_out, int out_size, void* d_ws, size_t ws_size, hipStream_t stream) {
    static int grid = 0;
    if (grid == 0) {
        if (n_in != 18 || out_size != M * D || ws_size < WS_END) { fprintf(stderr, "kernel_launch: unexpected shapes (n_in %d, out %d, ws %zu)\n", n_in, out_size, ws_size); grid = -1; return; }
        int dev = 0, cus = 0, per_cu = 0;
        hipGetDevice(&dev); hipDeviceGetAttribute(&cus, hipDeviceAttributeMultiprocessorCount, dev);
        if (hipFuncSetAttribute((const void*)fwd_megakernel, hipFuncAttributeMaxDynamicSharedMemorySize, LDS_BYTES) != hipSuccess) { fprintf(stderr, "kernel_launch: hipFuncSetAttribute failed\n"); grid = -1; return; }
        if (hipOccupancyMaxActiveBlocksPerMultiprocessor(&per_cu, (const void*)fwd_megakernel, NTHR, LDS_BYTES) != hipSuccess || per_cu < 1) { fprintf(stderr, "kernel_launch: occupancy query says %d\n", per_cu); per_cu = 1; }
        (void)hipGetLastError();
        grid = cus * 1;
        if (grid != 256) fprintf(stderr, "kernel_launch: %d CUs; built for 256\n", grid);
    }
    if (grid < 0) return;
    if (hipMemsetAsync((char*)d_ws + WS_BAR, 0, BAR_BYTES, stream) != hipSuccess) { fprintf(stderr, "kernel_launch: memset of the barrier words failed\n"); return; }
    Args a{};
    for (int i = 0; i < 18; ++i) a.in[i] = (const float*)d_in[i];
    a.out = (float*)d_out; a.ws = (unsigned char*)d_ws;
    void* kargs[] = {&a};
    hipError_t e = hipLaunchCooperativeKernel((const void*)fwd_megakernel, dim3(grid), dim3(NTHR), kargs, LDS_BYTES, stream);
    if (e != hipSuccess) fprintf(stderr, "cooperative launch failed: %s (grid %d)\n", hipGetErrorString(e), grid);
}
```

```cpp
#include <hip/hip_runtime.h>
#include <hip/hip_cooperative_groups.h>
#include <cstdio>
#include <cstdint>
namespace cg = cooperative_groups;
namespace pg8 {
#define PG8_LAS __attribute__((address_space(3)))
typedef unsigned short bf16_t;
typedef short bf16x8 __attribute__((ext_vector_type(8)));
typedef float f32x4 __attribute__((ext_vector_type(4)));
typedef unsigned u32x4 __attribute__((ext_vector_type(4)));
constexpr int BM = 256, BK = 64, HALF = 128, HTB = HALF * BK * 2  , STAGE_BYTES = 8 * HTB, NXCD = 8, WGM = 8;

__host__ __device__ __forceinline__ int lds_byte(int r, int c) { const int st = (r >> 4) * 2 + (c >> 5), rr = r & 15, cc = c & 31, ob = rr * 64 + cc * 2; return st * 1024 + (ob ^ (((ob >> 9) & 1) << 5)); }
__host__ __device__ __forceinline__ void stage_rc(int b, int& R, int& C) { const int st = b / 1024, sb = b % 1024, swz = sb ^ (((sb >> 9) & 1) << 5); R = (st >> 1) * 16 + swz / 64; C = (st & 1) * 32 + (swz % 64) / 2; }
__host__ __device__ __forceinline__ int perm32(int rho) { const int n = rho >> 4, i = rho & 15; return 8 * (i >> 2) + 4 * n + (i & 3); }

struct Unit { int pm, pn; };
struct Gemm { const bf16_t* A; const bf16_t* Bt; int M, N, K; };

struct StaticOrder {
    int nM, nN, nwg, G, c;
    __host__ __device__ void init(int M, int N, int G_, int c_) { nM = M / BM; nN = N / BM; nwg = nM * nN; G = G_; c = c_; }
    __host__ __device__ bool next(int i, Unit& u) const {
        const long L = (long)i * G + c; if (L >= nwg) return false;
        int wgid = (int)L; { const int q = nwg / NXCD, r = nwg % NXCD, xcd = wgid % NXCD, off = wgid / NXCD; wgid = (xcd < r ? xcd * (q + 1) : r * (q + 1) + (xcd - r) * q) + off; }
        const int nig = WGM * nN, gid = wgid / nig, fm = gid * WGM, gsz = (nM - fm) < WGM ? (nM - fm) : WGM;
        u.pm = fm + ((wgid % nig) % gsz); u.pn = (wgid % nig) / gsz; return true;
    }
    __device__ __forceinline__ void a_ready(const Unit&) const {}
    __device__ __forceinline__ void done(const Unit&) const {}
};

typedef float f32x2_cv __attribute__((ext_vector_type(2))); typedef __bf16 bf16x2_cv __attribute__((ext_vector_type(2)));
__device__ __forceinline__ unsigned cvt_pk_bf16(float lo, float hi) { f32x2_cv v = {lo, hi}; bf16x2_cv b = __builtin_convertvector(v, bf16x2_cv); return __builtin_bit_cast(unsigned, b); }
typedef float f32x2 __attribute__((ext_vector_type(2)));
enum { EPI_HG_IN = 0, EPI_FOX_IN = 1, EPI_RES = 2, EPI_RELU2 = 3 };
__device__ __forceinline__ float sigmoid_f(float z) { return __builtin_amdgcn_rcpf(1.0f + __expf(-z)); }
template <int MODE> struct Epi {
    static constexpr bool PERM = true, AFTER_DRAIN = false;
    bf16_t* o0;
    static constexpr size_t OSTR = (size_t)16 * 1024 * 1024;
    float* f0;
    const float* base;
    const float* p0;
    float qscale;
    __device__ __forceinline__ void operator()(const f32x4 (&acc)[2][2][4][2], const Unit& u, int wr, int wc, int fr, int fq) const {
        const int row0 = u.pm * BM + wr * 64 + fr;
        if constexpr (MODE == EPI_HG_IN) {
            const int seg = u.pn >> 2, col0 = (u.pn & 3) * BM + wc * 32 + 8 * fq;
            if (seg == 1) {
                f32x4 lbv[2][2];
#pragma unroll
                for (int bj = 0; bj < 2; ++bj)
#pragma unroll
                    for (int n = 0; n < 2; ++n) lbv[bj][n] = *(const f32x4*)(p0 + col0 + bj * HALF + 4 * n);
#pragma unroll
                for (int ai = 0; ai < 2; ++ai)
#pragma unroll
                    for (int m = 0; m < 4; ++m) { float* rowp = f0 + (size_t)(row0 + ai * HALF + m * 16) * 1024 + col0;
#pragma unroll
                        for (int bj = 0; bj < 2; ++bj)
#pragma unroll
                            for (int n = 0; n < 2; ++n) { const f32x4 z = acc[ai][bj][m][n], lb = lbv[bj][n]; f32x4 o;
#pragma unroll
                                for (int e = 0; e < 4; ++e) o[e] = __logf(lb[e] + (1.0f - lb[e]) * sigmoid_f(z[e]));
                                *(f32x4*)(rowp + bj * HALF + 4 * n) = o; } }
            } else {
                bf16_t* ob = o0 + (size_t)(seg == 0 ? 0 : seg - 1) * OSTR;
#pragma unroll
                for (int ai = 0; ai < 2; ++ai)
#pragma unroll
                    for (int m = 0; m < 4; ++m) { bf16_t* rowp = ob + (size_t)(row0 + ai * HALF + m * 16) * 1024 + col0;
#pragma unroll
                        for (int bj = 0; bj < 2; ++bj) { f32x4 v0 = acc[ai][bj][m][0], v1 = acc[ai][bj][m][1];
                            if (seg != 2) {
#pragma unroll
                                for (int e = 0; e < 4; ++e) { v0[e] = v0[e] * sigmoid_f(v0[e]); v1[e] = v1[e] * sigmoid_f(v1[e]); } }
                            u32x4 w; w.x = cvt_pk_bf16(v0[0], v0[1]); w.y = cvt_pk_bf16(v0[2], v0[3]); w.z = cvt_pk_bf16(v1[0], v1[1]); w.w = cvt_pk_bf16(v1[2], v1[3]);
                            *(u32x4*)(rowp + bj * HALF) = w; } }
            }
        } else if constexpr (MODE == EPI_FOX_IN) {
            const int seg = u.pn >> 2, colt = (u.pn & 3) * BM;
            if (seg <= 1) {
                const float* w = p0 + 64 * seg; const float sc = seg == 0 ? qscale : 1.0f; bf16_t* ob = o0 + (size_t)seg * OSTR;
                f32x4 wv[2][2];
#pragma unroll
                for (int bj = 0; bj < 2; ++bj)
#pragma unroll
                    for (int n = 0; n < 2; ++n) wv[bj][n] = *(const f32x4*)(w + 32 * bj + 8 * fq + 4 * n);
#pragma unroll
                for (int ai = 0; ai < 2; ++ai)
#pragma unroll
                    for (int m = 0; m < 4; ++m) { float ss = 0.f;
#pragma unroll
                        for (int bj = 0; bj < 2; ++bj)
#pragma unroll
                            for (int n = 0; n < 2; ++n) { const f32x4 x = acc[ai][bj][m][n]; ss += (x[0] * x[0] + x[1] * x[1]) + (x[2] * x[2] + x[3] * x[3]); }
                        ss += __shfl_xor(ss, 16); ss += __shfl_xor(ss, 32);
                        const float rs = __builtin_amdgcn_rsqf(ss * (1.0f / 64.0f) + 1e-6f) * sc;
                        bf16_t* rowp = ob + (size_t)(row0 + ai * HALF + m * 16) * 1024 + colt + 64 * wc + 8 * fq;
#pragma unroll
                        for (int bj = 0; bj < 2; ++bj) { const f32x4 v0 = acc[ai][bj][m][0] * rs * wv[bj][0], v1 = acc[ai][bj][m][1] * rs * wv[bj][1];
                            u32x4 ww; ww.x = cvt_pk_bf16(v0[0], v0[1]); ww.y = cvt_pk_bf16(v0[2], v0[3]); ww.z = cvt_pk_bf16(v1[0], v1[1]); ww.w = cvt_pk_bf16(v1[2], v1[3]);
                            *(u32x4*)(rowp + 32 * bj) = ww; } }
            } else {
                bf16_t* ob = o0 + (size_t)seg * OSTR; const int col0 = colt + wc * 32 + 8 * fq;
#pragma unroll
                for (int ai = 0; ai < 2; ++ai)
#pragma unroll
                    for (int m = 0; m < 4; ++m) { bf16_t* rowp = ob + (size_t)(row0 + ai * HALF + m * 16) * 1024 + col0;
#pragma unroll
                        for (int bj = 0; bj < 2; ++bj) { f32x4 v0 = acc[ai][bj][m][0], v1 = acc[ai][bj][m][1];
                            if (seg == 3) {
#pragma unroll
                                for (int e = 0; e < 4; ++e) { v0[e] = sigmoid_f(v0[e]); v1[e] = sigmoid_f(v1[e]); } }
                            u32x4 w; w.x = cvt_pk_bf16(v0[0], v0[1]); w.y = cvt_pk_bf16(v0[2], v0[3]); w.z = cvt_pk_bf16(v1[0], v1[1]); w.w = cvt_pk_bf16(v1[2], v1[3]);
                            *(u32x4*)(rowp + bj * HALF) = w; } }
            }
        } else if constexpr (MODE == EPI_RES) {
            const int col0 = u.pn * BM + wc * 32 + 8 * fq; const float* gp = p0 + (size_t)(u.pm >> 5) * 6144 + col0;
            f32x4 gv[2][2];
#pragma unroll
            for (int bj = 0; bj < 2; ++bj)
#pragma unroll
                for (int n = 0; n < 2; ++n) gv[bj][n] = *(const f32x4*)(gp + bj * HALF + 4 * n);
#pragma unroll
            for (int ai = 0; ai < 2; ++ai)
#pragma unroll
                for (int m = 0; m < 4; ++m) { const size_t off = (size_t)(row0 + ai * HALF + m * 16) * 1024 + col0;
#pragma unroll
                    for (int bj = 0; bj < 2; ++bj)
#pragma unroll
                        for (int n = 0; n < 2; ++n) { const f32x4 bs = *(const f32x4*)(base + off + bj * HALF + 4 * n);
                            *(f32x4*)(f0 + off + bj * HALF + 4 * n) = bs + gv[bj][n] * acc[ai][bj][m][n]; } }
        } else {
            const int col0 = u.pn * BM + wc * 32 + 8 * fq;
#pragma unroll
            for (int ai = 0; ai < 2; ++ai)
#pragma unroll
                for (int m = 0; m < 4; ++m) { bf16_t* rowp = o0 + (size_t)(row0 + ai * HALF + m * 16) * 4096 + col0;
#pragma unroll
                    for (int bj = 0; bj < 2; ++bj) { f32x4 v0 = acc[ai][bj][m][0], v1 = acc[ai][bj][m][1];
#pragma unroll
                        for (int e = 0; e < 4; ++e) { const float a = fmaxf(v0[e], 0.f), b = fmaxf(v1[e], 0.f); v0[e] = a * a; v1[e] = b * b; }
                        u32x4 w; w.x = cvt_pk_bf16(v0[0], v0[1]); w.y = cvt_pk_bf16(v0[2], v0[3]); w.z = cvt_pk_bf16(v1[0], v1[1]); w.w = cvt_pk_bf16(v1[2], v1[3]);
                        *(u32x4*)(rowp + bj * HALF) = w; } }
        }
    }
};
template <class Epi, class Sched, bool ALIGN_EPI = false, bool SP2 = false>
__device__ __forceinline__ void gemm_phase(PG8_LAS unsigned char* lds, const Gemm g, const Sched& S, const Epi& E) {
    int tid_ = threadIdx.x; asm volatile("" : "+v"(tid_));
    const int tid = tid_, wid = __builtin_amdgcn_readfirstlane(tid >> 6), lane = tid & 63, wr = wid >> 2, wc = wid & 3, fr = lane & 15, fq = lane >> 4;
    const int K = g.K, nt = K / BK;
    unsigned voffA[2], voffB[2];
#pragma unroll
    for (int i = 0; i < 2; ++i) { int R, C; stage_rc(tid * 16 + i * 8192, R, C); const int Rb = Epi::PERM ? ((R & ~31) + perm32(R & 31)) : R;
        voffA[i] = (unsigned)(R * K + C) * 2u; voffB[i] = (unsigned)(Rb * K + C) * 2u; }
    const size_t kstep = (size_t)(BK * 2);
    const size_t hstep = (size_t)HALF * K * 2;
    const size_t tstep = 2 * hstep;
    const unsigned ldsw = (unsigned)wid * 1024u;
    const int aoff = lds_byte(wr * 64 + fr, fq * 8), boff = lds_byte(wc * 32 + fr, fq * 8);
#define PG8_SA(b, h) (((b) * 2 + (h)) * HTB)
#define PG8_SB(b, h) ((4 + (b) * 2 + (h)) * HTB)
#define PG8_STAGE(bufoff, gbase, voff) do { _Pragma("unroll") for (int _i = 0; _i < 2; ++_i) \
        __builtin_amdgcn_global_load_lds((const unsigned*)((const char*)(gbase) + (voff)[_i]), (PG8_LAS unsigned*)(lds + (bufoff) + ldsw + _i * 8192), 16, 0, 0); } while (0)
#define PG8_LDA(dst, b, h) do { _Pragma("unroll") for (int m = 0; m < 4; ++m) _Pragma("unroll") for (int k = 0; k < 2; ++k) dst[m][k] = *(const PG8_LAS bf16x8*)(lds + PG8_SA(b, h) + aoff + m * 2048 + k * 1024); } while (0)
#define PG8_LDB(dst, b, h) do { _Pragma("unroll") for (int n = 0; n < 2; ++n) _Pragma("unroll") for (int k = 0; k < 2; ++k) dst[n][k] = *(const PG8_LAS bf16x8*)(lds + PG8_SB(b, h) + boff + n * 2048 + k * 1024); } while (0)
#define PG8_MMA(ai, bj, At, Bt) do { __builtin_amdgcn_s_setprio(1); _Pragma("unroll") for (int m = 0; m < 4; ++m) _Pragma("unroll") for (int n = 0; n < 2; ++n) _Pragma("unroll") for (int k = 0; k < 2; ++k) \
        acc[ai][bj][m][n] = __builtin_amdgcn_mfma_f32_16x16x32_bf16(Bt[n][k], At[m][k], acc[ai][bj][m][n], 0, 0, 0); __builtin_amdgcn_s_setprio(0); } while (0)
#define PG8_WAIT_V(n) asm volatile("s_waitcnt vmcnt(" #n ")" ::: "memory")
#define PG8_WAIT_L(n) asm volatile("s_waitcnt lgkmcnt(" #n ")" ::: "memory")
#define PG8_BAR __builtin_amdgcn_s_barrier()
#define PG8_SCHED __builtin_amdgcn_sched_barrier(0)
    Unit cur, nxt; int ui = 0;
    if (!S.next(0, cur)) return;
    f32x4 acc[2][2][4][2];
#pragma unroll
    for (int a = 0; a < 2; ++a)
#pragma unroll
        for (int b = 0; b < 2; ++b)
#pragma unroll
            for (int m = 0; m < 4; ++m)
#pragma unroll
                for (int n = 0; n < 2; ++n) acc[a][b][m][n] = (f32x4){0.f, 0.f, 0.f, 0.f};
    bf16x8 At[4][2], B0[2][2], B1[2][2];
    const char* cA = (const char*)g.A + (size_t)cur.pm * tstep; const char* cB = (const char*)g.Bt + (size_t)cur.pn * tstep;
    S.a_ready(cur);
    if constexpr (SP2) {
        PG8_STAGE(PG8_SB(0, 0), cB, voffB); PG8_STAGE(PG8_SB(0, 1), cB + hstep, voffB); PG8_STAGE(PG8_SA(0, 0), cA, voffA); PG8_STAGE(PG8_SA(0, 1), cA + hstep, voffA);
        if (wr == 1) PG8_BAR;
        PG8_WAIT_V(2); PG8_BAR;
        PG8_STAGE(PG8_SB(1, 0), cB + kstep, voffB); PG8_STAGE(PG8_SA(1, 0), cA + kstep, voffA); PG8_STAGE(PG8_SB(1, 1), cB + hstep + kstep, voffB);
        PG8_WAIT_V(6); PG8_BAR;
    } else {
        PG8_STAGE(PG8_SB(0, 0), cB, voffB); PG8_STAGE(PG8_SA(0, 0), cA, voffA); PG8_STAGE(PG8_SB(0, 1), cB + hstep, voffB); PG8_STAGE(PG8_SA(0, 1), cA + hstep, voffA);
        if (wr == 1) PG8_BAR;
        PG8_WAIT_V(4); PG8_BAR;
        PG8_STAGE(PG8_SB(1, 0), cB + kstep, voffB); PG8_STAGE(PG8_SA(1, 0), cA + kstep, voffA); PG8_STAGE(PG8_SB(1, 1), cB + hstep + kstep, voffB);
        PG8_WAIT_V(6); PG8_BAR;
    }
    for (;;) {
        const bool has_next = S.next(ui + 1, nxt);
        const char* nA = has_next ? (const char*)g.A + (size_t)nxt.pm * tstep : cA; const char* nB = has_next ? (const char*)g.Bt + (size_t)nxt.pn * tstep : cB;
        for (int t = 0; t < nt; t += 2) {
            const bool last = (t == nt - 2);
            const char* a1 = cA + (size_t)(t + 1) * kstep;
            const char* a2 = last ? nA : cA + (size_t)(t + 2) * kstep; const char* b2 = last ? nB : cB + (size_t)(t + 2) * kstep;
            const char* a3 = a2 + kstep; const char* b3 = b2 + kstep;
            if (last && has_next) S.a_ready(nxt);
            if constexpr (SP2) {
            PG8_LDB(B0, 0, 0); PG8_LDB(B1, 0, 1); PG8_SCHED; PG8_LDA(At, 0, 0); PG8_STAGE(PG8_SA(1, 1), a1 + hstep, voffA);
            PG8_WAIT_V(8); PG8_WAIT_L(0); PG8_BAR; PG8_MMA(0, 0, At, B0); PG8_MMA(0, 1, At, B1); PG8_BAR; PG8_SCHED;
            PG8_LDA(At, 0, 1); PG8_STAGE(PG8_SB(0, 0), b2, voffB); PG8_STAGE(PG8_SB(0, 1), b2 + hstep, voffB); PG8_STAGE(PG8_SA(0, 0), a2, voffA);
            PG8_WAIT_V(8); PG8_WAIT_L(0); PG8_BAR; PG8_MMA(1, 0, At, B0); PG8_MMA(1, 1, At, B1); PG8_BAR; PG8_SCHED;
            PG8_LDB(B0, 1, 0); PG8_LDB(B1, 1, 1); PG8_SCHED; PG8_LDA(At, 1, 0); PG8_STAGE(PG8_SA(0, 1), a2 + hstep, voffA);
            PG8_WAIT_V(8); PG8_WAIT_L(0); PG8_BAR; PG8_MMA(0, 0, At, B0); PG8_MMA(0, 1, At, B1); PG8_BAR; PG8_SCHED;
            PG8_LDA(At, 1, 1); PG8_STAGE(PG8_SB(1, 0), b3, voffB); PG8_STAGE(PG8_SB(1, 1), b3 + hstep, voffB); PG8_STAGE(PG8_SA(1, 0), a3, voffA);
            PG8_WAIT_V(8); PG8_WAIT_L(0); PG8_BAR; PG8_MMA(1, 0, At, B0); PG8_MMA(1, 1, At, B1); PG8_BAR; PG8_SCHED;
            } else {
            PG8_LDB(B0, 0, 0); PG8_SCHED; PG8_LDA(At, 0, 0); PG8_STAGE(PG8_SA(1, 1), a1 + hstep, voffA);
            PG8_WAIT_L(8); PG8_BAR; PG8_WAIT_L(0); PG8_MMA(0, 0, At, B0); PG8_BAR; PG8_SCHED;
            PG8_LDB(B1, 0, 1); PG8_STAGE(PG8_SB(0, 0), b2, voffB);
            PG8_BAR; PG8_WAIT_L(0); PG8_MMA(0, 1, At, B1); PG8_BAR;
            PG8_LDA(At, 0, 1); PG8_STAGE(PG8_SA(0, 0), a2, voffA);
            PG8_BAR; PG8_WAIT_L(0); PG8_MMA(1, 0, At, B0); PG8_BAR; PG8_SCHED;
            PG8_STAGE(PG8_SB(0, 1), b2 + hstep, voffB);
            PG8_WAIT_V(6); PG8_BAR; PG8_MMA(1, 1, At, B1); PG8_BAR;
            PG8_LDB(B0, 1, 0); PG8_SCHED; PG8_LDA(At, 1, 0); PG8_STAGE(PG8_SA(0, 1), a2 + hstep, voffA);
            PG8_WAIT_L(8); PG8_BAR; PG8_WAIT_L(0); PG8_MMA(0, 0, At, B0); PG8_BAR; PG8_SCHED;
            PG8_LDB(B1, 1, 1); PG8_STAGE(PG8_SB(1, 0), b3, voffB);
            PG8_BAR; PG8_WAIT_L(0); PG8_MMA(0, 1, At, B1); PG8_BAR;
            PG8_LDA(At, 1, 1); PG8_STAGE(PG8_SA(1, 0), a3, voffA);
            PG8_BAR; PG8_WAIT_L(0); PG8_MMA(1, 0, At, B0); PG8_BAR; PG8_SCHED;
            PG8_STAGE(PG8_SB(1, 1), b3 + hstep, voffB);
            PG8_WAIT_V(6); PG8_BAR; PG8_MMA(1, 1, At, B1); PG8_BAR;
            }
        }
        if constexpr (ALIGN_EPI) { if (wr == 0) PG8_BAR; }
        if constexpr (!Epi::AFTER_DRAIN) { E(acc, cur, wr, wc, fr, fq); S.done(cur); }
        if (!has_next) break;
#pragma unroll
        for (int a = 0; a < 2; ++a)
#pragma unroll
            for (int b = 0; b < 2; ++b)
#pragma unroll
                for (int m = 0; m < 4; ++m)
#pragma unroll
                    for (int n = 0; n < 2; ++n) acc[a][b][m][n] = (f32x4){0.f, 0.f, 0.f, 0.f};
        cur = nxt; cA = nA; cB = nB; ++ui;
        if constexpr (ALIGN_EPI) { if (wr == 1) PG8_BAR; }
    }
    PG8_WAIT_V(0);
    if constexpr (!ALIGN_EPI) { if (wr == 0) PG8_BAR; }
    PG8_BAR;
    if constexpr (Epi::AFTER_DRAIN) { E.fused(acc, cur, wr, wc, fr, fq, lds, wid, lane); S.done(cur); }
#undef PG8_SA
#undef PG8_SB
#undef PG8_STAGE
#undef PG8_LDA
#undef PG8_LDB
#undef PG8_MMA
#undef PG8_WAIT_V
#undef PG8_WAIT_L
#undef PG8_BAR
#undef PG8_SCHED
}
}
#include <hip/hip_bf16.h>
#include <cmath>
namespace attn_body {
using bf16=__hip_bfloat16;
using bf16x8=__attribute__((ext_vector_type(8)))short;
using s16x4=__attribute__((ext_vector_type(4)))short;
using f32x16=__attribute__((ext_vector_type(16)))float;
using u32x4=__attribute__((ext_vector_type(4)))unsigned;
constexpr int BATCH=2,NHEAD=16,SEQ=8192,D=64,DM=NHEAD*D;
constexpr int NW=8,QBLK=32,QB=QBLK*NW,KVBLK=64,NQB=SEQ/QB;
constexpr int ATTN_PITCH=DM, ATTN_UNIT_ROWS=QB;
__device__ __forceinline__ int crow(int r,int hi){return (r&3)+8*(r>>2)+4*hi;}
#define SBAR() __builtin_amdgcn_sched_barrier(0)
__device__ __forceinline__ void cmask(f32x16&p0,f32x16&p1,int jb,int qrel,int hi){
  const float NEG=-INFINITY; int qd=qrel-64*jb-4*hi; asm volatile("":"+v"(qd));
  #pragma unroll
  for(int r=0;r<16;++r){ if((r&3)+8*(r>>2)>qd)p0[r]=NEG; if((r&3)+8*(r>>2)+32>qd)p1[r]=NEG;}
}

constexpr int NSLOT=3, SLOTB=8192;
constexpr int LDS_K=0, LDS_V=NSLOT*SLOTB, LDS_WS=2*NSLOT*SLOTB, LDS_OST=LDS_WS+NW*64*4, LDS_NF=LDS_OST+NW*4096, LDS_BYTES=LDS_NF+SEQ*4;
constexpr float C2=0.125f*1.4426950408889634f;
__device__ __forceinline__ void glds16(const void*gsrc,unsigned lds_dst){unsigned keep;
  asm volatile("s_mov_b32 %0, m0\n\ts_mov_b32 m0, %2\n\ts_nop 0\n\tglobal_load_lds_dwordx4 %1, off\n\ts_mov_b32 m0, %0":"=&s"(keep):"v"(gsrc),"s"(lds_dst):"memory");}
__device__ __forceinline__ float max3f(float a,float b,float c){float r;asm("v_max3_f32 %0, %1, %2, %3":"=v"(r):"v"(a),"v"(b),"v"(c));return r;}
__device__ __forceinline__ float max2f(float a,float b){float r;asm("v_max_f32_e32 %0, %1, %2":"=v"(r):"v"(a),"v"(b));return r;}
__device__ __forceinline__ float fadd_s(float a,float b){float r;asm("v_add_f32_e32 %0, %1, %2":"=v"(r):"v"(a),"v"(b));return r;}
__device__ __forceinline__ float fsub_s(float a,float b){float r;asm("v_sub_f32_e32 %0, %1, %2":"=v"(r):"v"(a),"v"(b));return r;}
typedef float f32x2_t __attribute__((ext_vector_type(2))); typedef __bf16 bf16x2_t __attribute__((ext_vector_type(2)));
__device__ __forceinline__ unsigned cvtpk_s(float lo,float hi){f32x2_t v={lo,hi};bf16x2_t b=__builtin_convertvector(v,bf16x2_t);return __builtin_bit_cast(unsigned,b);}
#define WAIT_BAR(N) asm volatile("s_waitcnt vmcnt(" #N ") lgkmcnt(0)\n\ts_barrier":::"memory")

__device__ __forceinline__ void qkt(f32x16&p0,f32x16&p1,const char*Kslot,const bf16x8*qr,const f32x16&negm,int r32,int hi){
  const char*kb=Kslot+hi*1024+r32*16;
  #pragma unroll
  for(int d0=0;d0<4;++d0){
    const bf16x8 b0=*reinterpret_cast<const bf16x8*>(kb+d0*2048);
    const bf16x8 b1=*reinterpret_cast<const bf16x8*>(kb+d0*2048+512);
    if(d0==0){p0=__builtin_amdgcn_mfma_f32_32x32x16_bf16(b0,qr[0],negm,0,0,0);p1=__builtin_amdgcn_mfma_f32_32x32x16_bf16(b1,qr[0],negm,0,0,0);}
    else{p0=__builtin_amdgcn_mfma_f32_32x32x16_bf16(b0,qr[d0],p0,0,0,0);p1=__builtin_amdgcn_mfma_f32_32x32x16_bf16(b1,qr[d0],p1,0,0,0);}}
}
typedef __attribute__((address_space(3))) const char* lds_cptr;
typedef short v4i16_t __attribute__((ext_vector_type(4)));
__device__ __forceinline__ void kload8(bf16x8*kf,lds_cptr kp){
  kf[0]=*(const __attribute__((address_space(3))) bf16x8*)(kp);      kf[1]=*(const __attribute__((address_space(3))) bf16x8*)(kp+512);
  kf[2]=*(const __attribute__((address_space(3))) bf16x8*)(kp+2048); kf[3]=*(const __attribute__((address_space(3))) bf16x8*)(kp+2560);
  kf[4]=*(const __attribute__((address_space(3))) bf16x8*)(kp+4096); kf[5]=*(const __attribute__((address_space(3))) bf16x8*)(kp+4608);
  kf[6]=*(const __attribute__((address_space(3))) bf16x8*)(kp+6144); kf[7]=*(const __attribute__((address_space(3))) bf16x8*)(kp+6656);
}
__device__ __forceinline__ void kload2(bf16x8*kf,lds_cptr kp,int j){ kf[2*j]=*(const __attribute__((address_space(3))) bf16x8*)(kp+j*2048); kf[2*j+1]=*(const __attribute__((address_space(3))) bf16x8*)(kp+j*2048+512); }
__device__ __forceinline__ s16x4 vtr(lds_cptr p){ return __builtin_bit_cast(s16x4,__builtin_amdgcn_ds_read_tr16_b64_v4i16((__attribute__((address_space(3))) v4i16_t*)p)); }
__device__ __forceinline__ float rowmax(const f32x16&p0,const f32x16&p1){
  float a=max3f(p0[0],p0[1],p1[0]),b=max3f(p0[2],p0[3],p1[1]);a=max3f(a,p1[2],p1[3]);
  #pragma unroll
  for(int r=4;r<16;r+=4){a=max3f(a,p0[r],p0[r+1]);b=max3f(b,p0[r+2],p0[r+3]);a=max3f(a,p1[r],p1[r+1]);b=max3f(b,p1[r+2],p1[r+3]);}
  const float m=max2f(a,b);
  auto rr=__builtin_amdgcn_permlane32_swap(__float_as_uint(m),__float_as_uint(m),false,false);
  return max2f(__uint_as_float(rr[0]),__uint_as_float(rr[1]));
}
__device__ __forceinline__ void pv(f32x16*o,int vb,bf16x8 pa0,bf16x8 pa1,bf16x8 pa2,bf16x8 pa3){
  #pragma unroll
  for(int d0=0;d0<2;++d0){s16x4 lo[4],hi[4];
    #pragma unroll
    for(int ks=0;ks<4;++ks){
      asm volatile("ds_read_b64_tr_b16 %0,%1 offset:%c2":"=&v"(lo[ks]):"v"(vb),"i"(d0*4096+ks*1024):"memory");
      asm volatile("ds_read_b64_tr_b16 %0,%1 offset:%c2":"=&v"(hi[ks]):"v"(vb),"i"(d0*4096+ks*1024+512):"memory");}
    asm volatile("s_waitcnt lgkmcnt(0)":::"memory");SBAR();
    #define PK(k) (bf16x8){lo[k][0],lo[k][1],lo[k][2],lo[k][3],hi[k][0],hi[k][1],hi[k][2],hi[k][3]}
    o[d0]=__builtin_amdgcn_mfma_f32_32x32x16_bf16(pa0,PK(0),o[d0],0,0,0);
    o[d0]=__builtin_amdgcn_mfma_f32_32x32x16_bf16(pa1,PK(1),o[d0],0,0,0);
    o[d0]=__builtin_amdgcn_mfma_f32_32x32x16_bf16(pa2,PK(2),o[d0],0,0,0);
    o[d0]=__builtin_amdgcn_mfma_f32_32x32x16_bf16(pa3,PK(3),o[d0],0,0,0);
    #undef PK
  }
}

#ifndef ATTN_STORE16
#define ATTN_STORE16(p,v) (*(u32x4*)(p)=(v))
#endif
typedef float f32x4_t __attribute__((ext_vector_type(4))); typedef float f32x2_p __attribute__((ext_vector_type(2)));
template<int THRL> __device__ __forceinline__ void attn_unit(int b,int h,int qb,const bf16*Q,const bf16*__restrict__ K,const bf16*__restrict__ V,bf16*O,const float*__restrict__ NFg,const bf16*__restrict__ SG,char*shm){
  int tid_=threadIdx.x; asm volatile("":"+v"(tid_)); const int tid=tid_,lane=tid&63,r32=lane&31,hi=lane>>5; const int wid=__builtin_amdgcn_readfirstlane(tid>>6);
  const long rowbase=(long)b*SEQ; const int q0=qb*QB;
  const bf16*Qw=Q+(rowbase+q0+wid*QBLK)*DM+h*D;
  const bf16*Kh=K+rowbase*DM+h*D,*Vh=V+rowbase*DM+h*D;
  const unsigned lds0=(unsigned)(uintptr_t)shm;
  float*wsf=(float*)(shm+LDS_WS)+wid*64;
  const bf16*ksrc=Kh+(long)lane*DM+wid*8;
  const bf16*vsrc=Vh+(long)(16*(wid&3)+(lane>>2))*DM+(wid>>2)*32+(lane&3)*8;
  const unsigned kdst=lds0+LDS_K+wid*1024, vdst=lds0+LDS_V+wid*1024;
  #define DMA_K(t,slot) glds16(ksrc+(long)(t)*KVBLK*DM,(unsigned)__builtin_amdgcn_readfirstlane(kdst+(slot)))
  #define DMA_V(t,slot) glds16(vsrc+(long)(t)*KVBLK*DM,(unsigned)__builtin_amdgcn_readfirstlane(vdst+(slot)))
  const int vb0=(int)(lds0+LDS_V)+((lane>>4)&1)*32+(lane&3)*8+(4*hi+((lane&15)>>2))*64;
  const char*Kbase=shm+LDS_K; bf16x8 kf[8];
  const lds_cptr shm3=(lds_cptr)shm; const lds_cptr kp0=shm3+LDS_K+hi*1024+r32*16; const lds_cptr vp0=shm3+LDS_V+((lane>>4)&1)*32+(lane&3)*8+(4*hi+((lane&15)>>2))*64;
  const int NT=(q0+QB)/KVBLK;
  { const f32x4_t*nsrc=(const f32x4_t*)(NFg+(long)(b*NHEAD+h)*SEQ); __attribute__((address_space(3))) f32x4_t*ndst=(__attribute__((address_space(3))) f32x4_t*)(shm3+LDS_NF);
    for(int i_=tid;i_<NT*16;i_+=NW*64)ndst[i_]=nsrc[i_]; }
  #define PKADD(P,B,x,y) do{ f32x2_p t_={P[B],P[(B)+1]}; t_+=(f32x2_p){x,y}; P[B]=t_[0]; P[(B)+1]=t_[1]; }while(0)
  #define BIAS(P0,P1,t) do{ const __attribute__((address_space(3))) f32x4_t*nb_=(const __attribute__((address_space(3))) f32x4_t*)(shm3+LDS_NF+(t)*256+hi*16); \
    _Pragma("unroll") for(int j_=0;j_<4;++j_){ const f32x4_t a_=nb_[2*j_]; PKADD(P0,4*j_,a_[0],a_[1]); PKADD(P0,4*j_+2,a_[2],a_[3]); } SBAR(); \
    _Pragma("unroll") for(int j_=0;j_<4;++j_){ const f32x4_t b_=nb_[2*j_+8]; PKADD(P1,4*j_,b_[0],b_[1]); PKADD(P1,4*j_+2,b_[2],b_[3]); } SBAR(); }while(0)
  DMA_K(0,0);DMA_V(0,0);DMA_K(1,SLOTB);
  bf16x8 qr[4];
  #pragma unroll
  for(int d0=0;d0<4;++d0)qr[d0]=*reinterpret_cast<const bf16x8*>(&Qw[(long)r32*DM+d0*16+hi*8]);
  float mhat=0.f,l_reg=0.f;f32x16 o[2];o[0]=f32x16{};o[1]=f32x16{};f32x16 negm=f32x16{};asm volatile("":"+v"(negm));
  const int qrel=wid*QBLK+r32;
  #define CMASK(P0,P1,t) do{int jb_=(t)-(NT-4); if(jb_>=0)cmask(P0,P1,jb_,qrel,hi);}while(0)
  bool resc=false;
  #define START(P0,P1) do{ const float rm=rowmax(P0,P1); resc=false; \
    { const float dl=rm; mhat=fadd_s(mhat,dl); \
      _Pragma("unroll") for(int r=0;r<16;++r){P0[r]=fsub_s(P0[r],dl);P1[r]=fsub_s(P1[r],dl);} \
      _Pragma("unroll") for(int r=0;r<16;++r)negm[r]=-mhat; asm volatile("":"+v"(negm)); } \
    _Pragma("unroll") for(int r=0;r<16;++r)P0[r]=__builtin_amdgcn_exp2f(P0[r]); }while(0)
  #define RESC() do{ if(resc){ asm volatile("s_waitcnt lgkmcnt(0)":::"memory"); \
      _Pragma("unroll") for(int d_=0;d_<2;++d_) _Pragma("unroll") for(int r=0;r<16;++r)o[d_][r]*=wsf[crow(r,hi)]; } }while(0)
  f32x16 pA0,pA1,pB0,pB1;
  int sl_prev=0,sl_cur=0,sl_next=SLOTB;
  #define ROT() do{sl_prev=sl_cur;sl_cur=sl_next;sl_next=(sl_next==(NSLOT-1)*SLOTB)?0:sl_next+SLOTB;}while(0)
  DMA_K(2,2*SLOTB);
  WAIT_BAR(3);
  qkt(pA0,pA1,Kbase,qr,negm,r32,hi);asm volatile("s_nop 15\n\ts_nop 7":"+v"(pA0),"+v"(pA1));BIAS(pA0,pA1,0);CMASK(pA0,pA1,0);
  START(pA0,pA1);
  _Pragma("unroll") for(int r=0;r<16;++r)pA1[r]=__builtin_amdgcn_exp2f(pA1[r]);
  WAIT_BAR(0);
  DMA_K(3,0);DMA_V(1,SLOTB);
  ROT();
  kload8(kf,kp0+sl_cur);
  WAIT_BAR(2);
  s16x4 vlo[8],vhi[8]; u32x4 pw0,pw1,pw2,pw3;
  #define PKW(P,B) cvtpk_s(P[B],P[B+1])
  #define PAF(k) __builtin_bit_cast(bf16x8,pw##k)
  #define VFR(i) (bf16x8){vlo[i][0],vlo[i][1],vlo[i][2],vlo[i][3],vhi[i][0],vhi[i][1],vhi[i][2],vhi[i][3]}
  #define PIN(x) asm volatile("":"+v"(x))
  #define MX3(a,b,c) __builtin_fmaxf(__builtin_fmaxf((a),(b)),(c))
  #define GAPA(MF,A0,A1,A2,A3,W0,W1,PW) do{ MF; sacc+=A0; sacc+=A1; sacc+=A2; sacc+=A3; PIN(sacc); W0; W1; PIN(PW); SBAR(); }while(0)
  #define EX(v) __builtin_amdgcn_exp2f(v)
  #define GAPB(MF,X,B) do{ MF; X[B]=EX(X[B]); X[B+1]=EX(X[B+1]); X[B+2]=EX(X[B+2]); X[B+3]=EX(X[B+3]); PIN(X); SBAR(); }while(0)
  #define VRD(i) do{ vlo[i]=vtr(vp_+(((i)>>2)*4096+((i)&3)*1024)); vhi[i]=vtr(vp_+(((i)>>2)*4096+((i)&3)*1024+512)); }while(0)
  #define KRD(G,j) do{ if(G){ kload2(kf,kp0+sl_next,j); SBAR(); } }while(0)
  #define STEP(C0,C1,P0,P1,t,GK,GV,GL) do{ SBAR(); \
    const lds_cptr vp_=vp0+sl_prev; \
    VRD(0); SBAR(); float sacc=(P0[0]+P0[1]); \
    GAPA(C0=__builtin_amdgcn_mfma_f32_32x32x16_bf16(kf[0],qr[0],negm,0,0,0), P0[2],P0[3],P0[4],P0[5],     pw0[0]=PKW(P0,0), pw0[1]=PKW(P0,2), pw0); \
    VRD(4); SBAR(); GAPA(C1=__builtin_amdgcn_mfma_f32_32x32x16_bf16(kf[1],qr[0],negm,0,0,0), P0[6],P0[7],P0[8],P0[9],     pw0[2]=PKW(P0,4), pw0[3]=PKW(P0,6), pw0); \
    VRD(1); SBAR(); GAPA(C0=__builtin_amdgcn_mfma_f32_32x32x16_bf16(kf[2],qr[1],C0,0,0,0),   P0[10],P0[11],P0[12],P0[13], pw1[0]=PKW(P0,8), pw1[1]=PKW(P0,10), pw1); \
    VRD(5); SBAR(); GAPA(C1=__builtin_amdgcn_mfma_f32_32x32x16_bf16(kf[3],qr[1],C1,0,0,0),   P0[14],P0[15],P1[0],P1[1],   pw1[2]=PKW(P0,12),pw1[3]=PKW(P0,14), pw1); \
    VRD(2); SBAR(); GAPA(C0=__builtin_amdgcn_mfma_f32_32x32x16_bf16(kf[4],qr[2],C0,0,0,0),   P1[2],P1[3],P1[4],P1[5],     pw2[0]=PKW(P1,0), pw2[1]=PKW(P1,2), pw2); \
    VRD(6); SBAR(); GAPA(C1=__builtin_amdgcn_mfma_f32_32x32x16_bf16(kf[5],qr[2],C1,0,0,0),   P1[6],P1[7],P1[8],P1[9],     pw2[2]=PKW(P1,4), pw2[3]=PKW(P1,6), pw2); \
    VRD(3); SBAR(); GAPA(C0=__builtin_amdgcn_mfma_f32_32x32x16_bf16(kf[6],qr[3],C0,0,0,0),   P1[10],P1[11],P1[12],P1[13], pw3[0]=PKW(P1,8), pw3[1]=PKW(P1,10), pw3); \
    VRD(7); SBAR(); GAPA(C1=__builtin_amdgcn_mfma_f32_32x32x16_bf16(kf[7],qr[3],C1,0,0,0),   P1[14],P1[15],0.f,0.f,       pw3[2]=PKW(P1,12),pw3[3]=PKW(P1,14), pw3); \
    l_reg+=sacc; \
    if(GK){DMA_K((t)+3,sl_cur);} if(GV){DMA_V((t)+1,sl_next);} \
    BIAS(C0,C1,t); CMASK(C0,C1,t); \
    { float a=MX3(C0[0],C0[1],C1[0]),b=MX3(C0[2],C0[3],C1[1]); a=MX3(a,C1[2],C1[3]); \
      _Pragma("unroll") for(int r=4;r<16;r+=4){a=MX3(a,C0[r],C0[r+1]);b=MX3(b,C0[r+2],C0[r+3]);a=MX3(a,C1[r],C1[r+1]);b=MX3(b,C1[r+2],C1[r+3]);} \
      float rm=__builtin_fmaxf(a,b); { auto rr=__builtin_amdgcn_permlane32_swap(__float_as_uint(rm),__float_as_uint(rm),false,false); rm=__builtin_fmaxf(__uint_as_float(rr[0]),__uint_as_float(rr[1])); } \
      resc=false; \
      if(__builtin_expect(__any(rm>(float)THRL),0)){ const float dl=__builtin_fmaxf(rm,0.f); mhat+=dl; \
        _Pragma("unroll") for(int r=0;r<16;++r){C0[r]-=dl;C1[r]-=dl;} \
        _Pragma("unroll") for(int r=0;r<16;++r)negm[r]=-mhat; asm volatile("":"+v"(negm)); \
        const float f=__builtin_amdgcn_exp2f(-dl); l_reg*=f; if(hi==0)wsf[r32]=f; resc=true; } } \
    SBAR(); \
    GAPB(o[0]=__builtin_amdgcn_mfma_f32_32x32x16_bf16(PAF(0),VFR(0),o[0],0,0,0), C0,0); \
    GAPB(o[1]=__builtin_amdgcn_mfma_f32_32x32x16_bf16(PAF(0),VFR(4),o[1],0,0,0), C0,4); \
    KRD(GL,0); GAPB(o[0]=__builtin_amdgcn_mfma_f32_32x32x16_bf16(PAF(1),VFR(1),o[0],0,0,0), C0,8); \
    KRD(GL,1); GAPB(o[1]=__builtin_amdgcn_mfma_f32_32x32x16_bf16(PAF(1),VFR(5),o[1],0,0,0), C0,12); \
    KRD(GL,2); GAPB(o[0]=__builtin_amdgcn_mfma_f32_32x32x16_bf16(PAF(2),VFR(2),o[0],0,0,0), C1,0); \
    KRD(GL,3); GAPB(o[1]=__builtin_amdgcn_mfma_f32_32x32x16_bf16(PAF(2),VFR(6),o[1],0,0,0), C1,4); \
    GAPB(o[0]=__builtin_amdgcn_mfma_f32_32x32x16_bf16(PAF(3),VFR(3),o[0],0,0,0), C1,8); \
    GAPB(o[1]=__builtin_amdgcn_mfma_f32_32x32x16_bf16(PAF(3),VFR(7),o[1],0,0,0), C1,12); \
    }while(0)
  int t=1;
  #undef CMASK
  #define CMASK(P0,P1,t) do{}while(0)
  for(;t+5<NT;t+=2){
    STEP(pB0,pB1,pA0,pA1,t,true,true,true);     WAIT_BAR(2); RESC(); ROT();
    STEP(pA0,pA1,pB0,pB1,t+1,true,true,true);   WAIT_BAR(2); RESC(); ROT();
  }
  #undef CMASK
  #define CMASK(P0,P1,t) do{int jb_=(t)-(NT-4); if(jb_>=0)cmask(P0,P1,jb_,qrel,hi);}while(0)
  #define ENDW(tt) do{ if((tt)+3<NT){WAIT_BAR(2);} else if((tt)+2<NT){WAIT_BAR(1);} else {WAIT_BAR(0);} }while(0)
  for(;t+1<NT;t+=2){
    STEP(pB0,pB1,pA0,pA1,t,(t+3<NT),(t+1<NT),(t+1<NT));       ENDW(t);   RESC(); ROT();
    STEP(pA0,pA1,pB0,pB1,t+1,(t+4<NT),(t+2<NT),(t+2<NT));     ENDW(t+1); RESC(); ROT();
  }
  STEP(pB0,pB1,pA0,pA1,NT-1,false,false,false); RESC();
  { float sacc=pB0[0]+pB0[1]; _Pragma("unroll") for(int r=2;r<16;++r)sacc+=pB0[r]; _Pragma("unroll") for(int r=0;r<16;++r)sacc+=pB1[r]; l_reg+=sacc;
    pw0=(u32x4){PKW(pB0,0),PKW(pB0,2),PKW(pB0,4),PKW(pB0,6)};pw1=(u32x4){PKW(pB0,8),PKW(pB0,10),PKW(pB0,12),PKW(pB0,14)};pw2=(u32x4){PKW(pB1,0),PKW(pB1,2),PKW(pB1,4),PKW(pB1,6)};pw3=(u32x4){PKW(pB1,8),PKW(pB1,10),PKW(pB1,12),PKW(pB1,14)};
    SBAR(); pv(o,vb0+sl_cur,PAF(0),PAF(1),PAF(2),PAF(3)); }
  #undef PKW
  #undef PAF
  #undef VFR
  #undef PIN
  #undef MX3
  #undef GAPA
  #undef GAPB
  #undef EX
  #undef VRD
  #undef KRD
  #undef STEP
  #undef ENDW
  {auto rr=__builtin_amdgcn_permlane32_swap(__float_as_uint(l_reg),__float_as_uint(l_reg),false,false);l_reg=__uint_as_float(rr[0])+__uint_as_float(rr[1]);}
  if(hi==0)wsf[32+r32]=l_reg;asm volatile("s_waitcnt lgkmcnt(0)":::"memory");
  float rli[16];
  #pragma unroll
  for(int r=0;r<16;++r)rli[r]=__builtin_amdgcn_rcpf(wsf[32+crow(r,hi)]);
  bf16*Ow=O+(rowbase+q0+wid*QBLK)*DM+h*D; const bf16*SGw=SG+(rowbase+q0+wid*QBLK)*DM+h*D;
  { bf16*stg=(bf16*)(shm+LDS_OST)+wid*2048;
    #pragma unroll
    for(int r=0;r<16;++r){const int orow=crow(r,hi);
      #pragma unroll
      for(int d0=0;d0<2;++d0)stg[orow*64+d0*32+r32]=__float2bfloat16(o[d0][r]*rli[r]);}
    asm volatile("s_waitcnt lgkmcnt(0)":::"memory");
    #pragma unroll
    for(int i=0;i<4;++i){const int row=i*8+(lane>>3),ch=lane&7; u32x4 v=*(const u32x4*)(stg+row*64+ch*8); const u32x4 gq=*(const u32x4*)(SGw+(long)row*DM+ch*8);
      _Pragma("unroll") for(int e_=0;e_<4;++e_){ const float lo_=__uint_as_float(v[e_]<<16)*__uint_as_float(gq[e_]<<16), hi_=__uint_as_float(v[e_]&0xffff0000u)*__uint_as_float(gq[e_]&0xffff0000u); v[e_]=cvtpk_s(lo_,hi_); }
      ATTN_STORE16(Ow+(long)row*DM+ch*8,v);} }
  asm volatile("s_waitcnt lgkmcnt(0)\n\ts_barrier":::"memory");
  #undef DMA_K
  #undef BIAS
  #undef PKADD
  #undef DMA_V
  #undef CMASK
  #undef START
  #undef RESC
  #undef ROT
}
constexpr int ATTN_LDS_BYTES=LDS_BYTES;
struct AttnTensors { const bf16* Q; const bf16* K; const bf16* V; bf16* O; const float* NF; const bf16* SG; };
struct AttnUnit { int bh; int qb; };
struct StaticOrder {
  int vcu;
  __device__ __forceinline__ explicit StaticOrder(int grid,int block):vcu((block%8)*(grid/8)+block/8){}
  __device__ __forceinline__ bool next(int i,AttnUnit&u)const{ if(i>=4)return false; const int s=vcu&7; u.bh=vcu>>3; u.qb=(i==0)?s:(i==1)?15-s:(i==2)?16+s:31-s; return true; }
  __device__ __forceinline__ void a_ready(const AttnUnit&)const{}
  __device__ __forceinline__ void done(const AttnUnit&)const{}
};
template<class Sched,int THRL=8> __device__ __forceinline__ void attn_phase(char*lds,const AttnTensors&T,const Sched&S){
  AttnUnit u;
  for(int i=0;S.next(i,u);++i){ S.a_ready(u); attn_unit<THRL>(u.bh/NHEAD,u.bh%NHEAD,u.qb,T.Q,T.K,T.V,T.O,T.NF,T.SG,lds); S.done(u); }
}
#undef SBAR
#undef WAIT_BAR
}
constexpr int NWAVES = 8, NTHR = 512;
constexpr int BATCH = 2, T = 8192, D = 1024, FF = 4096, M = BATCH * T;
constexpr int NIN_FOX = 4 * D + 16;
constexpr float EPS = 1e-6f;
constexpr size_t MiB = 1u << 20;
constexpr size_t WS_MOD = 0;
constexpr size_t WS_LB = 128 * 1024;
constexpr size_t WS_QKNW = 160 * 1024;
constexpr size_t WS_WFZ = 192 * 1024;
constexpr size_t WS_DN = 256 * 1024;
constexpr size_t WS_LFS = 1536 * 1024;
constexpr size_t WS_NF = 2560 * 1024;
constexpr size_t WS_BAR = 3584 * 1024, BAR_BYTES = 16384;
constexpr size_t WS_W_HGIN = 4 * MiB, WS_W_HGOUT = 12 * MiB, WS_W_FOXIN = 14 * MiB, WS_W_FOXOUT = 22 * MiB;
constexpr size_t WS_W1_0 = 24 * MiB, WS_W2_0 = 32 * MiB, WS_W1_1 = 40 * MiB, WS_W2_1 = 48 * MiB;
constexpr size_t WS_XN = 56 * MiB;
constexpr size_t WS_R = 88 * MiB;
constexpr size_t WS_QO = WS_R, WS_B1 = WS_R + 32 * MiB, WS_B2 = WS_R + 64 * MiB, WS_B3 = WS_R + 96 * MiB;
constexpr size_t WS_ST = WS_R + 96 * MiB;
constexpr size_t WS_H = WS_R;
constexpr size_t WS_END = 256 * MiB;
static_assert(WS_ST + 64 * MiB <= WS_END && WS_H + 128 * MiB <= WS_END && WS_B1 - WS_QO == 32 * MiB, "ws map");
constexpr int LDS_BYTES = 147456;

#define GAS __attribute__((address_space(1)))
#define LAS __attribute__((address_space(3)))
typedef unsigned short bf16;
typedef unsigned v4u __attribute__((ext_vector_type(4)));
typedef unsigned v2u __attribute__((ext_vector_type(2)));
typedef float f32x4 __attribute__((ext_vector_type(4)));
typedef short bf16x8 __attribute__((ext_vector_type(8)));
typedef short s16x4v __attribute__((ext_vector_type(4)));
#define LDS_WAIT() asm volatile("s_waitcnt lgkmcnt(0)" ::: "memory")
__device__ __forceinline__ unsigned f2bf(float f) { unsigned u = __builtin_bit_cast(unsigned, f); return (u + 0x7fffu + ((u >> 16) & 1u)) >> 16; }
__device__ __forceinline__ unsigned pk2(float lo, float hi) { return pg8::cvt_pk_bf16(lo, hi); }
__device__ __forceinline__ float bf2f(unsigned short h) { return __uint_as_float((unsigned)h << 16); }
__device__ __forceinline__ float wave_sum(float v) {
#pragma unroll
    for (int o = 1; o < 64; o <<= 1) v += __shfl_xor(v, o);
    return v;
}

struct Args { const float* in[18]; float* out; unsigned char* ws; };

template <bool HEADPERM>
__device__ __forceinline__ void transpose_item(const float* W, int K, int ldw, int Ncols, bf16* WT, LAS float* scr, int item, int lane) {
    const int nblk = Ncols / 32, kb = item / nblk, nb = item % nblk, k0 = 64 * kb, n0 = 32 * nb;
#pragma unroll 8
    for (int i = 0; i < 32; ++i) { const int kk = 2 * i + (lane >> 5); scr[kk * 33 + (lane & 31)] = W[(size_t)(k0 + kk) * ldw + n0 + (lane & 31)]; }
    LDS_WAIT(); asm volatile("" ::: "memory");
    const int c = lane & 7;
#pragma unroll
    for (int j = 0; j < 4; ++j) { const int n = (lane >> 3) + 8 * j; const LAS float* s = scr + (8 * c) * 33 + n;
        v4u o; o.x = pk2(s[0 * 33], s[1 * 33]); o.y = pk2(s[2 * 33], s[3 * 33]); o.z = pk2(s[4 * 33], s[5 * 33]); o.w = pk2(s[6 * 33], s[7 * 33]);
        int col = n0 + n;
        if (HEADPERM && col < 2048) { const int nl = col & 255; col = (col & ~255) + 128 * ((nl >> 5) & 1) + 32 * (nl >> 6) + (nl & 31); }
        *(GAS v4u*)(WT + (size_t)col * K + k0 + 8 * c) = o; }
    LDS_WAIT(); asm volatile("" ::: "memory");
}

__device__ __forceinline__ void norm_rows(int gw, int NGW, int lane, const float* xin, const float* w, const float* modsh, const float* modsc, bf16* outb, float* outf) {
    for (int m = gw; m < M; m += NGW) {
        const GAS f32x4* xr = (const GAS f32x4*)(xin + (size_t)m * D) + lane;
        f32x4 v[4]; float s = 0.f;
#pragma unroll
        for (int j = 0; j < 4; ++j) { v[j] = xr[64 * j]; s += (v[j].x * v[j].x + v[j].y * v[j].y) + (v[j].z * v[j].z + v[j].w * v[j].w); }
        const float rstd = __builtin_amdgcn_rsqf(wave_sum(s) * (1.f / D) + EPS);
        const int b = m >> 13;
#pragma unroll
        for (int j = 0; j < 4; ++j) {
            const f32x4 wv = *((const f32x4*)w + lane + 64 * j);
            f32x4 y = v[j] * rstd * wv;
            if (modsc) { const f32x4 sc = *((const f32x4*)(modsc + b * 6144) + lane + 64 * j), sh = *((const f32x4*)(modsh + b * 6144) + lane + 64 * j); y = y * (1.0f + sc) + sh; }
            if (outf) *((GAS f32x4*)(outf + (size_t)m * D) + lane + 64 * j) = y;
            else { v2u o; o.x = pk2(y.x, y.y); o.y = pk2(y.z, y.w); *((GAS v2u*)(outb + (size_t)m * D) + lane + 64 * j) = o; }
        }
    }
}

constexpr int HG_QM = 0, HG_KM = 17408, HG_Q0 = 34816, HG_KT = 52224, HG_VT = 70656, HG_STL = 89088, HG_PART = 123904, HG_RED = 125952;
constexpr int PQ = 136, PT = 72;
#define MFMA16(a, b, c) __builtin_amdgcn_mfma_f32_16x16x32_bf16((a), (b), (c), 0, 0, 0)

__device__ __forceinline__ void hg_pass_a(LAS unsigned char* lds, int tid, int lane, int wave, const float* LF, const bf16* V, bf16* ST, float* DN) {
    const int p = tid >> 7, kk = tid & 127, g = lane >> 4, l15 = lane & 15;
    LAS float* part = (LAS float*)(lds + HG_PART);
    LAS bf16* KT = (LAS bf16*)(lds + HG_KT); LAS bf16* VT = (LAS bf16*)(lds + HG_VT);
    for (int u = blockIdx.x; u < 2048; u += gridDim.x) {
        const int bh = u >> 7, n = u & 127, b = bh >> 3, h = bh & 7;
        const size_t row0 = (size_t)b * T + n * 64 + 16 * p;
        float G[16], kv[16]; unsigned short vv[16];
        const float* lfp = LF + row0 * D + h * 128 + kk; const bf16* vp = V + row0 * D + h * 128 + kk;
#pragma unroll
        for (int j = 0; j < 16; ++j) { G[j] = lfp[(size_t)j * D]; vv[j] = vp[(size_t)j * D]; }
#pragma unroll
        for (int j = 0; j < 16; ++j) { kv[j] = 1.0f - __expf(G[j]); if (j) G[j] += G[j - 1]; }
        part[p * 128 + kk] = G[15];
        __syncthreads();
        const float t0 = part[kk], t1 = part[128 + kk], t2 = part[256 + kk], t3 = part[384 + kk];
        const float off = (p > 0 ? t0 : 0.f) + (p > 1 ? t1 : 0.f) + (p > 2 ? t2 : 0.f), glast = (t0 + t1) + (t2 + t3);
        unsigned kw[8], vw[8];
#pragma unroll
        for (int j = 0; j < 8; ++j) {
            const float a0 = kv[2 * j] * __expf(glast - (G[2 * j] + off)), a1 = kv[2 * j + 1] * __expf(glast - (G[2 * j + 1] + off));
            kw[j] = pk2(a0, a1); vw[j] = (unsigned)vv[2 * j] | ((unsigned)vv[2 * j + 1] << 16); }
        *(LAS v4u*)(KT + kk * PT + 16 * p) = (v4u){kw[0], kw[1], kw[2], kw[3]}; *(LAS v4u*)(KT + kk * PT + 16 * p + 8) = (v4u){kw[4], kw[5], kw[6], kw[7]};
        *(LAS v4u*)(VT + kk * PT + 16 * p) = (v4u){vw[0], vw[1], vw[2], vw[3]}; *(LAS v4u*)(VT + kk * PT + 16 * p + 8) = (v4u){vw[4], vw[5], vw[6], vw[7]};
        if (p == 0) DN[(size_t)u * 128 + kk] = __expf(glast);
        __syncthreads();
        bf16x8 bfr[2];
#pragma unroll
        for (int ss = 0; ss < 2; ++ss) bfr[ss] = *(const LAS bf16x8*)(VT + (16 * wave + l15) * PT + 32 * ss + 8 * g);
        bf16* stp = ST + ((size_t)u * 128 + 16 * wave + l15) * 128 + 4 * g;
#pragma unroll
        for (int kt = 0; kt < 8; ++kt) {
            f32x4 acc = (f32x4){0.f, 0.f, 0.f, 0.f};
#pragma unroll
            for (int ss = 0; ss < 2; ++ss) { const bf16x8 a = *(const LAS bf16x8*)(KT + (16 * kt + l15) * PT + 32 * ss + 8 * g); acc = MFMA16(a, bfr[ss], acc); }
            v2u o; o.x = pk2(acc[0], acc[1]); o.y = pk2(acc[2], acc[3]); *(GAS v2u*)(stp + 16 * kt) = o;
        }
        __syncthreads();
    }
}
__device__ __forceinline__ void hg_pass_b(int tid, bf16* ST, const float* DN) {
    const int gt = blockIdx.x * NTHR + tid;
    for (int e2 = gt; e2 < 16 * 8192; e2 += gridDim.x * NTHR) {
        const int bh = e2 >> 13, pe = e2 & 8191, k = (2 * pe) & 127;
        unsigned* sp = (unsigned*)ST + (size_t)bh * 128 * 8192 + pe; const float* dp = DN + (size_t)bh * 128 * 128 + k;
        float s0 = 0.f, s1 = 0.f;
        for (int n0 = 0; n0 < 128; n0 += 8) {
            unsigned dv[8]; float d0[8], d1[8];
#pragma unroll
            for (int j = 0; j < 8; ++j) { dv[j] = sp[(size_t)(n0 + j) * 8192]; const float2 dd = *(const float2*)(dp + (size_t)(n0 + j) * 128); d0[j] = dd.x; d1[j] = dd.y; }
#pragma unroll
            for (int j = 0; j < 8; ++j) { sp[(size_t)(n0 + j) * 8192] = pk2(s0, s1);
                s0 = d0[j] * s0 + __uint_as_float(dv[j] << 16); s1 = d1[j] * s1 + __uint_as_float(dv[j] & 0xffff0000u); }
        }
    }
}
__device__ __forceinline__ void hg_pass_c(LAS unsigned char* lds, int tid, int lane, int wave, const float* LF, const bf16* QO, bf16* OUTB, const bf16* V, const bf16* GS, const bf16* ST, const float* gnw) {
    const int p = tid >> 7, kk = tid & 127, g = lane >> 4, l15 = lane & 15, tt = wave & 3, vh = wave >> 2;
    LAS float* part = (LAS float*)(lds + HG_PART); LAS float* red = (LAS float*)(lds + HG_RED);
    LAS bf16* QM = (LAS bf16*)(lds + HG_QM); LAS bf16* KM = (LAS bf16*)(lds + HG_KM); LAS bf16* Q0 = (LAS bf16*)(lds + HG_Q0);
    LAS bf16* VT = (LAS bf16*)(lds + HG_VT); LAS bf16* STL = (LAS bf16*)(lds + HG_STL);
    for (int u = blockIdx.x; u < 2048; u += gridDim.x) {
        const int bh = u >> 7, n = u & 127, b = bh >> 3, h = bh & 7;
        const size_t rowu = (size_t)b * T + n * 64, row0 = rowu + 16 * p;
        { const v4u* src = (const v4u*)(ST + (size_t)u * 16384);
#pragma unroll
          for (int i = 0; i < 4; ++i) { const int q = tid + 512 * i; const v4u x = src[q]; *(LAS v4u*)(STL + (q >> 4) * PQ + (q & 15) * 8) = x; } }
        float G[16], lf[16]; unsigned short vv[16], qq[16];
        const float* lfp = LF + row0 * D + h * 128 + kk; const bf16* vp = V + row0 * D + h * 128 + kk; const bf16* qp = QO + row0 * D + h * 128 + kk;
#pragma unroll
        for (int j = 0; j < 16; ++j) { lf[j] = lfp[(size_t)j * D]; vv[j] = vp[(size_t)j * D]; qq[j] = qp[(size_t)j * D]; }
#pragma unroll
        for (int j = 0; j < 16; ++j) { G[j] = lf[j] + (j ? G[j - 1] : 0.f); }
        part[p * 128 + kk] = G[15];
        __syncthreads();
        const float t0 = part[kk], t1 = part[128 + kk], t2 = part[256 + kk];
        const float off = (p > 0 ? t0 : 0.f) + (p > 1 ? t1 : 0.f) + (p > 2 ? t2 : 0.f), gm = t0 + t1;
        unsigned vw[8];
#pragma unroll
        for (int j = 0; j < 16; ++j) {
            const float Gt = G[j] + off, qv = bf2f(qq[j]), kf = 1.0f - __expf(lf[j]);
            const int t = 16 * p + j;
            QM[t * PQ + kk] = (bf16)f2bf(qv * __expf(Gt - gm));
            KM[t * PQ + kk] = (bf16)f2bf(kf * __expf(gm - Gt));
            Q0[t * PQ + kk] = (bf16)f2bf(qv * __expf(Gt));
        }
#pragma unroll
        for (int j = 0; j < 8; ++j) vw[j] = (unsigned)vv[2 * j] | ((unsigned)vv[2 * j + 1] << 16);
        *(LAS v4u*)(VT + kk * PT + 16 * p) = (v4u){vw[0], vw[1], vw[2], vw[3]}; *(LAS v4u*)(VT + kk * PT + 16 * p + 8) = (v4u){vw[4], vw[5], vw[6], vw[7]};
        __syncthreads();
        f32x4 P[4];
        bf16x8 qf[4];
#pragma unroll
        for (int kc = 0; kc < 4; ++kc) qf[kc] = *(const LAS bf16x8*)(QM + (16 * tt + l15) * PQ + 32 * kc + 8 * g);
#pragma unroll
        for (int st = 0; st < 4; ++st) {
            P[st] = (f32x4){0.f, 0.f, 0.f, 0.f};
            if (st <= tt) {
#pragma unroll
                for (int kc = 0; kc < 4; ++kc) { const bf16x8 a = *(const LAS bf16x8*)(KM + (16 * st + l15) * PQ + 32 * kc + 8 * g); P[st] = MFMA16(a, qf[kc], P[st]); }
                if (st == tt) {
#pragma unroll
                    for (int i = 0; i < 4; ++i) if (4 * g + i > l15) P[st][i] = 0.f; }
            }
        }
        f32x4 O[4];
        bf16x8 pf[2];
#pragma unroll
        for (int sp = 0; sp < 2; ++sp) { v4u w; w.x = pk2(P[2 * sp][0], P[2 * sp][1]); w.y = pk2(P[2 * sp][2], P[2 * sp][3]); w.z = pk2(P[2 * sp + 1][0], P[2 * sp + 1][1]); w.w = pk2(P[2 * sp + 1][2], P[2 * sp + 1][3]);
            pf[sp] = __builtin_bit_cast(bf16x8, w); }
#pragma unroll
        for (int kc = 0; kc < 4; ++kc) qf[kc] = *(const LAS bf16x8*)(Q0 + (16 * tt + l15) * PQ + 32 * kc + 8 * g);
#pragma unroll
        for (int j = 0; j < 4; ++j) {
            const int vrow = 64 * vh + 16 * j + l15;
            O[j] = (f32x4){0.f, 0.f, 0.f, 0.f};
#pragma unroll
            for (int sp = 0; sp < 2; ++sp) {
                if (2 * sp <= tt) {
                    const v2u lo = *(const LAS v2u*)(VT + vrow * PT + 32 * sp + 4 * g), hi = *(const LAS v2u*)(VT + vrow * PT + 32 * sp + 16 + 4 * g);
                    const bf16x8 a = __builtin_bit_cast(bf16x8, (v4u){lo.x, lo.y, hi.x, hi.y});
                    O[j] = MFMA16(a, pf[sp], O[j]);
                }
            }
#pragma unroll
            for (int kc = 0; kc < 4; ++kc) { const bf16x8 a = *(const LAS bf16x8*)(STL + vrow * PQ + 32 * kc + 8 * g); O[j] = MFMA16(a, qf[kc], O[j]); }
        }
        float ss = 0.f;
#pragma unroll
        for (int j = 0; j < 4; ++j) ss += (O[j][0] * O[j][0] + O[j][1] * O[j][1]) + (O[j][2] * O[j][2] + O[j][3] * O[j][3]);
        ss += __shfl_xor(ss, 16); ss += __shfl_xor(ss, 32);
        if (g == 0) red[vh * 64 + 16 * tt + l15] = ss;
        __syncthreads();
        const float tot = red[16 * tt + l15] + red[64 + 16 * tt + l15];
        const float rstd = __builtin_amdgcn_rsqf(tot * (1.0f / 128.0f) + EPS);
        const size_t orow = (rowu + 16 * tt + l15) * D + h * 128;
#pragma unroll
        for (int j = 0; j < 4; ++j) {
            const int v0 = 64 * vh + 16 * j + 4 * g;
            const f32x4 gw = *(const f32x4*)(gnw + v0); const v2u gs = *(const GAS v2u*)(GS + orow + v0);
            const float o0 = O[j][0] * rstd * gw[0] * __uint_as_float(gs.x << 16), o1 = O[j][1] * rstd * gw[1] * __uint_as_float(gs.x & 0xffff0000u);
            const float o2 = O[j][2] * rstd * gw[2] * __uint_as_float(gs.y << 16), o3 = O[j][3] * rstd * gw[3] * __uint_as_float(gs.y & 0xffff0000u);
            v2u o; o.x = pk2(o0, o1); o.y = pk2(o2, o3); *(GAS v2u*)(OUTB + orow + v0) = o;
        }
        __syncthreads();
    }
}
__device__ __forceinline__ void fox_fz_tail(int lane, int wave, const bf16* XN, const bf16* WfzT, const float* bf, float* LFS) {
    if (wave < 4) {
        const int g = lane >> 4, l15 = lane & 15; const int rbase = 64 * blockIdx.x + 16 * wave;
        for (int rb = rbase; rb < M; rb += 64 * gridDim.x) {
            f32x4 acc = (f32x4){0.f, 0.f, 0.f, 0.f};
            const bf16* ap = WfzT + l15 * D + 8 * g; const bf16* bp = XN + (size_t)(rb + l15) * D + 8 * g;
#pragma unroll 8
            for (int kc = 0; kc < 32; ++kc) { const bf16x8 a = *(const GAS bf16x8*)(ap + 32 * kc), bb = *(const GAS bf16x8*)(bp + 32 * kc); acc = MFMA16(a, bb, acc); }
            const int row = rb + l15, b = row >> 13, s = row & 8191;
#pragma unroll
            for (int i = 0; i < 4; ++i) { const int hh = 4 * g + i; const float z = acc[i] + bf[hh];
                const float lfv = z >= 0.f ? -log1pf(__expf(-z)) : z - log1pf(__expf(z));
                LFS[(size_t)(b * 16 + hh) * T + s] = lfv; }
        }
    }
}
__device__ __forceinline__ void fox_scan(LAS unsigned char* lds, int tid, int lane, int wave, const float* LFS, float* NF) {
    LAS float* wtot = (LAS float*)lds;
    for (int bh = blockIdx.x; bh < 32; bh += gridDim.x) {
        const f32x4* src = (const f32x4*)(LFS + (size_t)bh * T) + tid * 4;
        f32x4 v[4]; float run = 0.f;
#pragma unroll
        for (int j = 0; j < 4; ++j) { v[j] = src[j]; v[j].x += run; v[j].y += v[j].x; v[j].z += v[j].y; v[j].w += v[j].z; run = v[j].w; }
        float inc = run;
#pragma unroll
        for (int o = 1; o < 64; o <<= 1) { const float t = __shfl_up(inc, o); if (lane >= o) inc += t; }
        if (lane == 63) wtot[wave] = inc;
        __syncthreads();
        float off = inc - run;
        for (int w = 0; w < wave; ++w) off += wtot[w];
        const float c = -1.4426950408889634f;
        f32x4* dst = (f32x4*)(NF + (size_t)bh * T) + tid * 4;
#pragma unroll
        for (int j = 0; j < 4; ++j) dst[j] = (v[j] + off) * c;
        __syncthreads();
    }
}


#ifdef DIAG_HG
__device__ __forceinline__ void diag_hg_naive(LAS unsigned char* lds, int tid, const float* LF, const bf16* QOq, const bf16* V, const bf16* GS, const float* gnw, float* DB) {
    LAS float* fl = (LAS float*)lds; LAS float* kl = fl + 128; LAS float* ql = fl + 256; LAS float* ps = fl + 384; LAS float* os = fl + 896;
    const int v = tid & 127, kq = tid >> 7;
    float S[32];
#pragma unroll
    for (int i = 0; i < 32; ++i) S[i] = 0.f;
    for (int t = 0; t < 192; ++t) {
        if (tid < 128) { const float lf = LF[(size_t)t * 1024 + tid]; const float ff = __expf(lf); fl[tid] = ff; kl[tid] = 1.0f - ff; ql[tid] = bf2f(QOq[(size_t)t * 1024 + tid]); }
        __syncthreads();
        const float vt = bf2f(V[(size_t)t * 1024 + v]); float acc = 0.f;
#pragma unroll
        for (int i = 0; i < 32; ++i) { const int k_ = 32 * kq + i; S[i] = fl[k_] * S[i] + kl[k_] * vt; acc += S[i] * ql[k_]; }
        ps[kq * 128 + v] = acc;
        __syncthreads();
        if (tid < 128) os[tid] = ps[tid] + ps[128 + tid] + ps[256 + tid] + ps[384 + tid];
        __syncthreads();
        if (tid < 128) { float ss = 0.f; for (int i = 0; i < 128; ++i) ss += os[i] * os[i];
            DB[t * 128 + tid] = os[tid] * __builtin_amdgcn_rsqf(ss * (1.0f / 128.0f) + EPS) * gnw[tid] * bf2f(GS[(size_t)t * 1024 + tid]); }
        __syncthreads();
    }
}
__device__ __forceinline__ void diag_hg_cmp(LAS unsigned char* lds, int tid, const bf16* O, const float* DB, float* DG) {
    LAS float* r = (LAS float*)lds; float sd = 0.f, ss = 0.f;
    for (int idx = tid + DIAG_T0 * 128; idx < DIAG_T1 * 128; idx += NTHR) { const int t = idx >> 7, v = idx & 127; const float a = DB[idx], b = bf2f(O[(size_t)t * 1024 + v]); sd += (a - b) * (a - b); ss += a * a; }
    sd = wave_sum(sd); ss = wave_sum(ss);
    if ((tid & 63) == 0) { r[(tid >> 6) * 2] = sd; r[(tid >> 6) * 2 + 1] = ss; }
    __syncthreads();
    if (tid == 0) { float a = 0.f, b = 0.f; for (int w = 0; w < 8; ++w) { a += r[2 * w]; b += r[2 * w + 1]; } DG[0] = sqrtf(a / b); }
    __syncthreads();
}
#endif
#ifndef NO_GEMM
#define NO_GEMM 0
#endif
#ifndef REP_SYNC
#define REP_SYNC 1
#endif
#ifndef REP_NORM
#define REP_NORM 1
#endif
#ifndef REP_HGAB
#define REP_HGAB 1
#endif
#ifndef REP_GEMM
#define REP_GEMM 1
#endif
#ifndef REP_P0
#define REP_P0 1
#endif
#ifndef REP_SCAN
#define REP_SCAN 1
#endif
#ifndef ATT_THRL
#define ATT_THRL 64
#endif
#ifndef REP_ATT
#define REP_ATT 1
#endif
#ifndef REP_HGC
#define REP_HGC 1
#endif
#define RLX_AGENT __ATOMIC_RELAXED, __HIP_MEMORY_SCOPE_AGENT
#define XB_TMO      128
#define XB_XCNT(j)  (256  + 64 * (j))
#define XB_XSUB(j)  (1280 + 64 * (j))
#define XB_XGEN(j)  (2304 + 64 * (j))
#define XB_TOP      3328
#define XB_TOPGEN   3392
#define XCD_BAR_WORDS 3456
#define XB_SPIN_CAP (1u << 18)

__device__ __forceinline__ unsigned xb_ld(unsigned* p)              { return __hip_atomic_load(p, __ATOMIC_RELAXED, __HIP_MEMORY_SCOPE_AGENT); }
__device__ __forceinline__ unsigned xb_add(unsigned* p, unsigned v) { return __hip_atomic_fetch_add(p, v, __ATOMIC_RELAXED, __HIP_MEMORY_SCOPE_AGENT); }
__device__ __forceinline__ unsigned xb_xcc_id() { return (unsigned)__builtin_amdgcn_s_getreg((3 << 11) | 20) & 0xFu; }
#define XB_SPIN(cond, bar) do { unsigned _sp = 0; while (cond) { __builtin_amdgcn_s_sleep(1); \
    if ((++_sp & 255u) == 0u) { if (xb_ld(&(bar)[XB_TMO])) break; if (_sp > XB_SPIN_CAP) { atomicAdd(&(bar)[XB_TMO], 1u); break; } } } } while (0)

struct XcdBarrier {
    unsigned* bar; unsigned x;
    volatile LAS unsigned* st;
};

__device__ __forceinline__ XcdBarrier xcd_barrier_post(unsigned* bar, volatile LAS unsigned* st) {
    XcdBarrier b; b.bar = bar; b.x = xb_xcc_id(); b.st = st;
    if (threadIdx.x == 0) (void)xb_add(&bar[XB_XCNT(b.x)], 1u);
    return b;
}
__device__ __forceinline__ void xcd_barrier_complete(unsigned* bar, unsigned x, unsigned& nloc, unsigned& nx) {
    const unsigned G = gridDim.x * gridDim.y * gridDim.z;
    unsigned sum, cnt, mine, sp = 0u;
    for (;;) {
        sum = 0u; cnt = 0u; mine = 0u;
#pragma unroll
        for (unsigned j = 0; j < 16; ++j) { const unsigned c = xb_ld(&bar[XB_XCNT(j)]); sum += c; cnt += (c > 0u) ? 1u : 0u; mine = (j == x) ? c : mine; }
        if (sum == G) break;
        __builtin_amdgcn_s_sleep(1);
        if ((++sp & 255u) == 0u) { if (xb_ld(&bar[XB_TMO])) break; if (sp > XB_SPIN_CAP) { atomicAdd(&bar[XB_TMO], 1u); break; } }
    }
    nloc = mine > 0u ? mine : 1u; nx = cnt > 0u ? cnt : 1u;
}

__device__ __forceinline__ void xcd_barrier(const XcdBarrier& b) {
    asm volatile("s_waitcnt vmcnt(0)" ::: "memory");
    __syncthreads();
    if (threadIdx.x == 0) {
        unsigned* bar = b.bar;
        __builtin_amdgcn_s_waitcnt(0);
        unsigned nloc = b.st[0], nx = b.st[1];
        if (nloc == 0u) { xcd_barrier_complete(bar, b.x, nloc, nx); b.st[0] = nloc; b.st[1] = nx; }
        const unsigned old = xb_add(&bar[XB_XSUB(b.x)], 1u);
        const unsigned gen = old / nloc;
        if (old + 1u == (gen + 1u) * nloc) {
            __builtin_amdgcn_fence(__ATOMIC_RELEASE, "agent");
            asm volatile("s_waitcnt vmcnt(0)" ::: "memory");
            const unsigned og = xb_add(&bar[XB_TOP], 1u);
            const unsigned tg = og / nx;
            if (og + 1u == (tg + 1u) * nx) xb_add(&bar[XB_TOPGEN], 1u);
            else XB_SPIN(xb_ld(&bar[XB_TOPGEN]) == tg, bar);
            __builtin_amdgcn_fence(__ATOMIC_ACQUIRE, "agent");
            xb_add(&bar[XB_XGEN(b.x)], 1u);
            asm volatile("s_waitcnt vmcnt(0)" ::: "memory");
        } else {
            XB_SPIN(xb_ld(&bar[XB_XGEN(b.x)]) == gen, bar);
            __builtin_amdgcn_fence(__ATOMIC_ACQUIRE, "agent");
            asm volatile("s_waitcnt vmcnt(0)" ::: "memory");
        }
    }
    __syncthreads();
}

__global__ void __launch_bounds__(NTHR, 2) fwd_megakernel(Args args) {
    extern __shared__ __attribute__((aligned(16))) unsigned char lds_raw[];
    cg::grid_group grid = cg::this_grid();
    LAS unsigned char* lds = (LAS unsigned char*)lds_raw;
    const int tid = threadIdx.x, lane = tid & 63, wave = __builtin_amdgcn_readfirstlane(tid >> 6);
    const int G = gridDim.x, gw = blockIdx.x * NWAVES + wave, NGW = G * NWAVES;
    volatile LAS unsigned* MISC = (volatile LAS unsigned*)(lds + 131072 + 320);
    if (tid < 32) MISC[tid] = 0u;
    __syncthreads();
    XcdBarrier bar = xcd_barrier_post((unsigned*)(args.ws + WS_BAR), MISC + 8);
#define A_ws (args.ws)
#define A_x (args.in[0])
#define A_c (args.in[1])
#define A_w_mod (args.in[2])
#define A_b_mod (args.in[3])
#define A_norm1_w (args.in[4])
#define A_norm2_w (args.in[5])
#define A_hg_w_in (args.in[6])
#define A_hg_w_out (args.in[7])
#define A_hg_lb (args.in[8])
#define A_hg_gn_w (args.in[9])
#define A_fox_w_in (args.in[10])
#define A_fox_b_f (args.in[11])
#define A_fox_qn_w (args.in[12])
#define A_fox_kn_w (args.in[13])
#define A_fox_w_out (args.in[14])
#define A_mlp_w1 (args.in[15])
#define A_mlp_w2 (args.in[16])
#define A_final_w (args.in[17])
#define A_out (args.out)
#define MOD ((float*)(A_ws + WS_MOD))
#define LB ((float*)(A_ws + WS_LB))
#define WFZ ((bf16*)(A_ws + WS_WFZ))
#define DN ((float*)(A_ws + WS_DN))
#define LFS ((float*)(A_ws + WS_LFS))
#define NF ((float*)(A_ws + WS_NF))
#define QKNW ((float*)(A_ws + WS_QKNW))
#define W_HGIN ((bf16*)(A_ws + WS_W_HGIN))
#define W_HGOUT ((bf16*)(A_ws + WS_W_HGOUT))
#define W_FOXIN ((bf16*)(A_ws + WS_W_FOXIN))
#define W_FOXOUT ((bf16*)(A_ws + WS_W_FOXOUT))
#define W1_0 ((bf16*)(A_ws + WS_W1_0))
#define W2_0 ((bf16*)(A_ws + WS_W2_0))
#define W1_1 ((bf16*)(A_ws + WS_W1_1))
#define W2_1 ((bf16*)(A_ws + WS_W2_1))
#define XN ((bf16*)(A_ws + WS_XN))
#define QO ((bf16*)(A_ws + WS_QO))
#define B1 ((bf16*)(A_ws + WS_B1))
#define B2 ((bf16*)(A_ws + WS_B2))
#define B3 ((bf16*)(A_ws + WS_B3))
#define ST ((bf16*)(A_ws + WS_ST))
#define HB ((bf16*)(A_ws + WS_H))
#define GSYNC() do { for (int rs_ = 0; rs_ < REP_SYNC; ++rs_) xcd_barrier(bar); } while (0)
#define GSYNC_CG() do { if (__builtin_expect(args.ws == nullptr, 0)) grid.sync(); xcd_barrier(bar); } while (0)
    for (int rp_ = 0; rp_ < REP_P0; ++rp_) {
        __syncthreads();
        LAS float* sc = (LAS float*)lds;
        LAS float* red = (LAS float*)(lds + 8192);
        for (int it = blockIdx.x; it < 192; it += G) {
            for (int i = tid; i < 2048; i += NTHR) { const float cv = A_c[i]; sc[i] = cv * pg8::sigmoid_f(cv); }
            __syncthreads();
            const int li = it / 96, cgp = it % 96, col = 64 * cgp + lane;
            const float* wp = A_w_mod + ((size_t)li * D + 128 * wave) * 6144 + col;
            float a0 = 0.f, a1 = 0.f;
            for (int k0 = 0; k0 < 128; k0 += 8) {
                float wv[8];
#pragma unroll
                for (int j = 0; j < 8; ++j) wv[j] = wp[(size_t)(k0 + j) * 6144];
#pragma unroll
                for (int j = 0; j < 8; ++j) { a0 += sc[128 * wave + k0 + j] * wv[j]; a1 += sc[1024 + 128 * wave + k0 + j] * wv[j]; }
            }
            red[wave * 128 + lane] = a0; red[wave * 128 + 64 + lane] = a1;
            __syncthreads();
            if (wave == 0) { float s0 = 0.f, s1 = 0.f;
#pragma unroll
                for (int w = 0; w < 8; ++w) { s0 += red[w * 128 + lane]; s1 += red[w * 128 + 64 + lane]; }
                const float bb = A_b_mod[li * 6144 + col];
                MOD[(li * 2 + 0) * 6144 + col] = s0 + bb; MOD[(li * 2 + 1) * 6144 + col] = s1 + bb; }
            __syncthreads();
        }
        if (blockIdx.x == G - 1) {
            for (int i = tid; i < 1024; i += NTHR) { const float a0 = A_hg_lb[i], a1 = A_hg_lb[1024 + i], a2 = A_hg_lb[2048 + i]; const float mx = fmaxf(a0, fmaxf(a1, a2));
                const float e0 = __expf(a0 - mx), e1 = __expf(a1 - mx), e2 = __expf(a2 - mx); LB[i] = e0 / (e0 + e1 + e2); }
        }
        if (blockIdx.x == G - 2) {
            for (int i = tid; i < 16 * 1024; i += NTHR) { const int hh = i >> 10, k = i & 1023; WFZ[i] = (bf16)f2bf(A_fox_w_in[(size_t)k * NIN_FOX + 4096 + hh]); }
            if (tid < 64) { QKNW[tid] = A_fox_qn_w[tid]; QKNW[64 + tid] = A_fox_kn_w[tid]; }
        }
        LAS float* scr = (LAS float*)(lds + wave * 16384);
        constexpr int I_A = 16 * 128, I_B = 16 * 32, I_W2 = 64 * 32;
        constexpr int NITEMS = 2 * I_A + 2 * I_B + 2 * I_A + 2 * I_W2;
        for (int it = gw; it < NITEMS; it += NGW) {
            int r = it;
            if (r < I_A) { transpose_item<false>(A_hg_w_in, D, 4096, 4096, W_HGIN, scr, r, lane); continue; } r -= I_A;
            if (r < I_A) { transpose_item<true>(A_fox_w_in, D, NIN_FOX, 4096, W_FOXIN, scr, r, lane); continue; } r -= I_A;
            if (r < I_B) { transpose_item<false>(A_hg_w_out, D, D, D, W_HGOUT, scr, r, lane); continue; } r -= I_B;
            if (r < I_B) { transpose_item<false>(A_fox_w_out, D, D, D, W_FOXOUT, scr, r, lane); continue; } r -= I_B;
            if (r < I_A) { transpose_item<false>(A_mlp_w1, D, FF, FF, W1_0, scr, r, lane); continue; } r -= I_A;
            if (r < I_A) { transpose_item<false>(A_mlp_w1 + (size_t)D * FF, D, FF, FF, W1_1, scr, r, lane); continue; } r -= I_A;
            if (r < I_W2) { transpose_item<false>(A_mlp_w2, FF, D, D, W2_0, scr, r, lane); continue; } r -= I_W2;
            transpose_item<false>(A_mlp_w2 + (size_t)FF * D, FF, D, D, W2_1, scr, r, lane);
        }
    }
    GSYNC_CG();
#define GEMM_PHASE(MODE, Aptr, Bptr, Nn, Kk, EE) GEMM_PHASE_R(1, MODE, Aptr, Bptr, Nn, Kk, EE)
#define GEMM_PHASE_R(RR, MODE, Aptr, Bptr, Nn, Kk, EE) do { for (int rg_ = 0; rg_ < (RR); ++rg_) { pg8::Gemm g_{(const pg8::bf16_t*)(Aptr), (const pg8::bf16_t*)(Bptr), M, (Nn), (Kk)}; pg8::StaticOrder S_; S_.init(M, (Nn), G, (int)blockIdx.x); \
        if (!NO_GEMM) pg8::gemm_phase<pg8::Epi<MODE>, pg8::StaticOrder, true, true>(lds, g_, S_, EE); } } while (0)
    {
        const float* mod = MOD;
        for (int rn_ = 0; rn_ < REP_NORM; ++rn_) norm_rows(gw, NGW, lane, A_x, A_norm1_w, mod + 0, mod + 1024, XN, nullptr);
        GSYNC();
        { pg8::Epi<pg8::EPI_HG_IN> E{QO, A_out  , nullptr, LB, 1.f};
          GEMM_PHASE_R(REP_GEMM, pg8::EPI_HG_IN, XN, W_HGIN, 4096, D, E); }
        GSYNC();
        for (int rh_ = 0; rh_ < REP_HGAB; ++rh_) {
        if (rh_) GSYNC();
        hg_pass_a(lds, tid, lane, wave, A_out, B1, ST, DN);
        GSYNC();
        hg_pass_b(tid, ST, DN);
        }
#ifdef DIAG_HG
        if (blockIdx.x == 0) diag_hg_naive(lds, tid, A_out, QO, B1, B2, A_hg_gn_w, (float*)(A_ws + WS_XN));
#endif
        GSYNC();
#ifndef NO_HGC
        for (int rc_ = 0; rc_ < REP_HGC; ++rc_) hg_pass_c(lds, tid, lane, wave, A_out, QO, XN, B1, B2, ST, A_hg_gn_w);
#endif
        GSYNC();
#ifdef DIAG_HG
        if (blockIdx.x == 0) diag_hg_cmp(lds, tid, QO, (const float*)(A_ws + WS_XN), (float*)(A_ws + WS_QKNW + 1024));
#endif
        { pg8::Epi<pg8::EPI_RES> E{nullptr, A_out, A_x, mod + 2048, 1.f};
          GEMM_PHASE_R(REP_GEMM, pg8::EPI_RES, XN, W_HGOUT, D, D, E); }
        GSYNC();
        for (int rn_ = 0; rn_ < REP_NORM; ++rn_) norm_rows(gw, NGW, lane, A_out, A_norm2_w, mod + 3072, mod + 4096, XN, nullptr);
        GSYNC();
        { pg8::Epi<pg8::EPI_RELU2> E{HB, nullptr, nullptr, nullptr, 1.f};
          GEMM_PHASE_R(REP_GEMM, pg8::EPI_RELU2, XN, W1_0, FF, D, E); }
        GSYNC();
        { pg8::Epi<pg8::EPI_RES> E{nullptr, A_out, A_out, mod + 5120, 1.f};
          GEMM_PHASE(pg8::EPI_RES, HB, W2_0, D, FF, E); }
        GSYNC();
    }
    {
        const float* mod = MOD + 2 * 6144;
        for (int rn_ = 0; rn_ < REP_NORM; ++rn_) norm_rows(gw, NGW, lane, A_out, A_norm1_w + D, mod + 0, mod + 1024, XN, nullptr);
        GSYNC();
        { pg8::Epi<pg8::EPI_FOX_IN> E{QO, nullptr, nullptr, QKNW, attn_body::C2};
          GEMM_PHASE_R(REP_GEMM, pg8::EPI_FOX_IN, XN, W_FOXIN, 4096, D, E); }
        for (int rz_ = 0; rz_ < REP_SCAN; ++rz_) fox_fz_tail(lane, wave, XN, WFZ, A_fox_b_f, LFS);
        GSYNC();
        for (int rz_ = 0; rz_ < REP_SCAN; ++rz_) fox_scan(lds, tid, lane, wave, LFS, NF);
        GSYNC();
        { const attn_body::AttnTensors AT{(const attn_body::bf16*)QO, (const attn_body::bf16*)B1, (const attn_body::bf16*)B2, (attn_body::bf16*)XN, NF, (const attn_body::bf16*)B3};
          const attn_body::StaticOrder S((int)G, (int)blockIdx.x);
#ifndef NO_ATTN
          for (int ra_ = 0; ra_ < REP_ATT; ++ra_) attn_body::attn_phase<attn_body::StaticOrder, ATT_THRL>((char*)lds_raw, AT, S);
#endif
        }
        GSYNC();
        { pg8::Epi<pg8::EPI_RES> E{nullptr, A_out, A_out, mod + 2048, 1.f};
          GEMM_PHASE(pg8::EPI_RES, XN, W_FOXOUT, D, D, E); }
        GSYNC();
        for (int rn_ = 0; rn_ < REP_NORM; ++rn_) norm_rows(gw, NGW, lane, A_out, A_norm2_w + D, mod + 3072, mod + 4096, XN, nullptr);
        GSYNC();
        { pg8::Epi<pg8::EPI_RELU2> E{HB, nullptr, nullptr, nullptr, 1.f};
          GEMM_PHASE_R(REP_GEMM, pg8::EPI_RELU2, XN, W1_1, FF, D, E); }
        GSYNC();
        { pg8::Epi<pg8::EPI_RES> E{nullptr, A_out, A_out, mod + 5120, 1.f};
          GEMM_PHASE(pg8::EPI_RES, HB, W2_1, D, FF, E); }
        GSYNC();
    }
    norm_rows(gw, NGW, lane, A_out, A_final_w, nullptr, nullptr, nullptr, A_out);
#if defined(DIAG_HG) || defined(DIAG_ATT)
    GSYNC();
    if (blockIdx.x == 0 && tid == 0) A_out[0] = 1000.0f * (20.0f + log2f(*(const float*)(A_ws + WS_QKNW + 1024) + 1e-9f));
#endif
}

#undef A_ws
#undef A_x
#undef A_c
#undef A_w_mod
#undef A_b_mod
#undef A_norm1_w
#undef A_norm2_w
#undef A_hg_w_in
#undef A_hg_w_out
#undef A_hg_lb
#undef A_hg_gn_w
#undef A_fox_w_in
#undef A_fox_b_f
#undef A_fox_qn_w
#undef A_fox_kn_w
#undef A_fox_w_out
#undef A_mlp_w1
#undef A_mlp_w2
#undef A_final_w
#undef A_out
extern "C" void kernel_launch(void* const* d_in, const int* in_sizes, int n_in, void* d_out, int out_size, void* d_ws, size_t ws_size, hipStream_t stream) {
    static int grid = 0;
    if (grid == 0) {
        if (n_in != 18 || out_size != M * D || ws_size < WS_END) { fprintf(stderr, "kernel_launch: unexpected shapes (n_in %d, out %d, ws %zu)\n", n_in, out_size, ws_size); grid = -1; return; }
        int dev = 0, cus = 0, per_cu = 0;
        hipGetDevice(&dev); hipDeviceGetAttribute(&cus, hipDeviceAttributeMultiprocessorCount, dev);
        if (hipFuncSetAttribute((const void*)fwd_megakernel, hipFuncAttributeMaxDynamicSharedMemorySize, LDS_BYTES) != hipSuccess) { fprintf(stderr, "kernel_launch: hipFuncSetAttribute failed\n"); grid = -1; return; }
        if (hipOccupancyMaxActiveBlocksPerMultiprocessor(&per_cu, (const void*)fwd_megakernel, NTHR, LDS_BYTES) != hipSuccess || per_cu < 1) { fprintf(stderr, "kernel_launch: occupancy query says %d\n", per_cu); per_cu = 1; }
        (void)hipGetLastError();
        grid = cus * 1;
        if (grid != 256) fprintf(stderr, "kernel_launch: %d CUs; built for 256\n", grid);
    }
    if (grid < 0) return;
    if (hipMemsetAsync((char*)d_ws + WS_BAR, 0, BAR_BYTES, stream) != hipSuccess) { fprintf(stderr, "kernel_launch: memset of the barrier words failed\n"); return; }
    Args a{};
    for (int i = 0; i < 18; ++i) a.in[i] = (const float*)d_in[i];
    a.out = (float*)d_out; a.ws = (unsigned char*)d_ws;
    void* kargs[] = {&a};
    hipError_t e = hipLaunchCooperativeKernel((const void*)fwd_megakernel, dim3(grid), dim3(NTHR), kargs, LDS_BYTES, stream);
    if (e != hipSuccess) fprintf(stderr, "cooperative launch failed: %s (grid %d)\n", hipGetErrorString(e), grid);
}
```

```cpp
#include <hip/hip_runtime.h>
#include <hip/hip_cooperative_groups.h>
#include <cstdio>
#include <cstdint>
namespace cg = cooperative_groups;
namespace pg8 {
#define PG8_LAS __attribute__((address_space(3)))
typedef unsigned short bf16_t;
typedef short bf16x8 __attribute__((ext_vector_type(8)));
typedef float f32x4 __attribute__((ext_vector_type(4)));
typedef unsigned u32x4 __attribute__((ext_vector_type(4)));
constexpr int BM = 256, BK = 64, HALF = 128, HTB = HALF * BK * 2  , STAGE_BYTES = 8 * HTB, NXCD = 8, WGM = 8;

__host__ __device__ __forceinline__ int lds_byte(int r, int c) { const int st = (r >> 4) * 2 + (c >> 5), rr = r & 15, cc = c & 31, ob = rr * 64 + cc * 2; return st * 1024 + (ob ^ (((ob >> 9) & 1) << 5)); }
__host__ __device__ __forceinline__ void stage_rc(int b, int& R, int& C) { const int st = b / 1024, sb = b % 1024, swz = sb ^ (((sb >> 9) & 1) << 5); R = (st >> 1) * 16 + swz / 64; C = (st & 1) * 32 + (swz % 64) / 2; }
__host__ __device__ __forceinline__ int perm32(int rho) { const int n = rho >> 4, i = rho & 15; return 8 * (i >> 2) + 4 * n + (i & 3); }

struct Unit { int pm, pn; };
struct Gemm { const bf16_t* A; const bf16_t* Bt; int M, N, K; };

struct StaticOrder {
    int nM, nN, nwg, G, c;
    __host__ __device__ void init(int M, int N, int G_, int c_) { nM = M / BM; nN = N / BM; nwg = nM * nN; G = G_; c = c_; }
    __host__ __device__ bool next(int i, Unit& u) const {
        const long L = (long)i * G + c; if (L >= nwg) return false;
        int wgid = (int)L; { const int q = nwg / NXCD, r = nwg % NXCD, xcd = wgid % NXCD, off = wgid / NXCD; wgid = (xcd < r ? xcd * (q + 1) : r * (q + 1) + (xcd - r) * q) + off; }
        const int nig = WGM * nN, gid = wgid / nig, fm = gid * WGM, gsz = (nM - fm) < WGM ? (nM - fm) : WGM;
        u.pm = fm + ((wgid % nig) % gsz); u.pn = (wgid % nig) / gsz; return true;
    }
    __device__ __forceinline__ void a_ready(const Unit&) const {}
    __device__ __forceinline__ void done(const Unit&) const {}
};

typedef float f32x2_cv __attribute__((ext_vector_type(2))); typedef __bf16 bf16x2_cv __attribute__((ext_vector_type(2)));
__device__ __forceinline__ unsigned cvt_pk_bf16(float lo, float hi) { f32x2_cv v = {lo, hi}; bf16x2_cv b = __builtin_convertvector(v, bf16x2_cv); return __builtin_bit_cast(unsigned, b); }
typedef float f32x2 __attribute__((ext_vector_type(2)));
enum { EPI_HG_IN = 0, EPI_FOX_IN = 1, EPI_RES = 2, EPI_RELU2 = 3 };
__device__ __forceinline__ float sigmoid_f(float z) { return __builtin_amdgcn_rcpf(1.0f + __expf(-z)); }
template <int MODE> struct Epi {
    static constexpr bool PERM = true, AFTER_DRAIN = false;
    bf16_t* o0;
    static constexpr size_t OSTR = (size_t)16 * 1024 * 1024;
    float* f0;
    const float* base;
    const float* p0;
    float qscale;
    bf16_t* xs; float* ss; const float* wn; const float* scp;
    const float* ssr; const float* bvec;
    __device__ __forceinline__ void row_rstd(float (&rs)[2][4], int row0) const {
#pragma unroll
        for (int ai = 0; ai < 2; ++ai)
#pragma unroll
            for (int m = 0; m < 4; ++m) rs[ai][m] = ssr ? __builtin_amdgcn_rsqf(ssr[row0 + ai * HALF + m * 16] * (1.0f / 1024.0f) + 1e-6f) : 1.0f;
    }
    __device__ __forceinline__ void operator()(const f32x4 (&acc)[2][2][4][2], const Unit& u, int wr, int wc, int fr, int fq) const {
        const int row0 = u.pm * BM + wr * 64 + fr;
        if constexpr (MODE == EPI_HG_IN) {
            const int seg = u.pn >> 2, col0 = (u.pn & 3) * BM + wc * 32 + 8 * fq;
            if (seg == 1) {
                f32x4 lbv[2][2];
#pragma unroll
                for (int bj = 0; bj < 2; ++bj)
#pragma unroll
                    for (int n = 0; n < 2; ++n) lbv[bj][n] = *(const f32x4*)(p0 + col0 + bj * HALF + 4 * n);
#pragma unroll
                for (int ai = 0; ai < 2; ++ai)
#pragma unroll
                    for (int m = 0; m < 4; ++m) { float* rowp = f0 + (size_t)(row0 + ai * HALF + m * 16) * 1024 + col0;
#pragma unroll
                        for (int bj = 0; bj < 2; ++bj)
#pragma unroll
                            for (int n = 0; n < 2; ++n) { const f32x4 z = acc[ai][bj][m][n], lb = lbv[bj][n]; f32x4 o;
#pragma unroll
                                for (int e = 0; e < 4; ++e) o[e] = __logf(lb[e] + (1.0f - lb[e]) * sigmoid_f(z[e]));
                                *(f32x4*)(rowp + bj * HALF + 4 * n) = o; } }
            } else {
                bf16_t* ob = o0 + (size_t)(seg == 0 ? 0 : seg - 1) * OSTR;
#pragma unroll
                for (int ai = 0; ai < 2; ++ai)
#pragma unroll
                    for (int m = 0; m < 4; ++m) { bf16_t* rowp = ob + (size_t)(row0 + ai * HALF + m * 16) * 1024 + col0;
#pragma unroll
                        for (int bj = 0; bj < 2; ++bj) { f32x4 v0 = acc[ai][bj][m][0], v1 = acc[ai][bj][m][1];
                            if (seg != 2) {
#pragma unroll
                                for (int e = 0; e < 4; ++e) { v0[e] = v0[e] * sigmoid_f(v0[e]); v1[e] = v1[e] * sigmoid_f(v1[e]); } }
                            u32x4 w; w.x = cvt_pk_bf16(v0[0], v0[1]); w.y = cvt_pk_bf16(v0[2], v0[3]); w.z = cvt_pk_bf16(v1[0], v1[1]); w.w = cvt_pk_bf16(v1[2], v1[3]);
                            *(u32x4*)(rowp + bj * HALF) = w; } }
            }
        } else if constexpr (MODE == EPI_FOX_IN) {
            const int seg = u.pn >> 2, colt = (u.pn & 3) * BM;
            float rs[2][4]; row_rstd(rs, row0);
            f32x4 bb[2][2];
#pragma unroll
            for (int bj = 0; bj < 2; ++bj)
#pragma unroll
                for (int n = 0; n < 2; ++n) bb[bj][n] = bvec ? *(const f32x4*)(bvec + (size_t)(u.pm >> 5) * 4112 + u.pn * BM + bj * HALF + wc * 32 + 8 * fq + 4 * n) : (f32x4){0.f, 0.f, 0.f, 0.f};
#define ACCV(ai, bj, m, n) (acc[ai][bj][m][n] * rs[ai][m] + bb[bj][n])
            if (seg <= 1) {
                const float* w = p0 + 64 * seg; const float sc = seg == 0 ? qscale : 1.0f; bf16_t* ob = o0 + (size_t)seg * OSTR;
                f32x4 wv[2][2];
#pragma unroll
                for (int bj = 0; bj < 2; ++bj)
#pragma unroll
                    for (int n = 0; n < 2; ++n) wv[bj][n] = *(const f32x4*)(w + 32 * bj + 8 * fq + 4 * n);
#pragma unroll
                for (int ai = 0; ai < 2; ++ai)
#pragma unroll
                    for (int m = 0; m < 4; ++m) { float ss = 0.f;
#pragma unroll
                        for (int bj = 0; bj < 2; ++bj)
#pragma unroll
                            for (int n = 0; n < 2; ++n) { const f32x4 x = ACCV(ai, bj, m, n); ss += (x[0] * x[0] + x[1] * x[1]) + (x[2] * x[2] + x[3] * x[3]); }
                        ss += __shfl_xor(ss, 16); ss += __shfl_xor(ss, 32);
                        const float rsn = __builtin_amdgcn_rsqf(ss * (1.0f / 64.0f) + 1e-6f) * sc;
                        bf16_t* rowp = ob + (size_t)(row0 + ai * HALF + m * 16) * 1024 + colt + 64 * wc + 8 * fq;
#pragma unroll
                        for (int bj = 0; bj < 2; ++bj) { const f32x4 v0 = ACCV(ai, bj, m, 0) * rsn * wv[bj][0], v1 = ACCV(ai, bj, m, 1) * rsn * wv[bj][1];
                            u32x4 ww; ww.x = cvt_pk_bf16(v0[0], v0[1]); ww.y = cvt_pk_bf16(v0[2], v0[3]); ww.z = cvt_pk_bf16(v1[0], v1[1]); ww.w = cvt_pk_bf16(v1[2], v1[3]);
                            *(u32x4*)(rowp + 32 * bj) = ww; } }
            } else {
                bf16_t* ob = o0 + (size_t)seg * OSTR; const int col0 = colt + wc * 32 + 8 * fq;
#pragma unroll
                for (int ai = 0; ai < 2; ++ai)
#pragma unroll
                    for (int m = 0; m < 4; ++m) { bf16_t* rowp = ob + (size_t)(row0 + ai * HALF + m * 16) * 1024 + col0;
#pragma unroll
                        for (int bj = 0; bj < 2; ++bj) { f32x4 v0 = ACCV(ai, bj, m, 0), v1 = ACCV(ai, bj, m, 1);
                            if (seg == 3) {
#pragma unroll
                                for (int e = 0; e < 4; ++e) { v0[e] = sigmoid_f(v0[e]); v1[e] = sigmoid_f(v1[e]); } }
                            u32x4 w; w.x = cvt_pk_bf16(v0[0], v0[1]); w.y = cvt_pk_bf16(v0[2], v0[3]); w.z = cvt_pk_bf16(v1[0], v1[1]); w.w = cvt_pk_bf16(v1[2], v1[3]);
                            *(u32x4*)(rowp + bj * HALF) = w; } }
            }
#undef ACCV
        } else if constexpr (MODE == EPI_RES) {
            const int col0 = u.pn * BM + wc * 32 + 8 * fq; const float* gp = p0 + (size_t)(u.pm >> 5) * 6144 + col0;
            f32x4 gv[2][2], wm[2][2];
#pragma unroll
            for (int bj = 0; bj < 2; ++bj)
#pragma unroll
                for (int n = 0; n < 2; ++n) { gv[bj][n] = *(const f32x4*)(gp + bj * HALF + 4 * n);
                    wm[bj][n] = xs ? *(const f32x4*)(wn + col0 + bj * HALF + 4 * n) * (*(const f32x4*)(scp + (size_t)(u.pm >> 5) * 6144 + col0 + bj * HALF + 4 * n) + 1.0f) : (f32x4){0.f, 0.f, 0.f, 0.f}; }
#pragma unroll
            for (int ai = 0; ai < 2; ++ai)
#pragma unroll
                for (int m = 0; m < 4; ++m) { const size_t off = (size_t)(row0 + ai * HALF + m * 16) * 1024 + col0; float q = 0.f;
#pragma unroll
                    for (int bj = 0; bj < 2; ++bj) { const f32x4 bs0 = *(const f32x4*)(base + off + bj * HALF), bs1 = *(const f32x4*)(base + off + bj * HALF + 4);
                        const f32x4 x0 = bs0 + gv[bj][0] * acc[ai][bj][m][0], x1 = bs1 + gv[bj][1] * acc[ai][bj][m][1];
                        *(f32x4*)(f0 + off + bj * HALF) = x0; *(f32x4*)(f0 + off + bj * HALF + 4) = x1;
                        if (xs) {
                            q += (x0[0] * x0[0] + x0[1] * x0[1]) + (x0[2] * x0[2] + x0[3] * x0[3]) + (x1[0] * x1[0] + x1[1] * x1[1]) + (x1[2] * x1[2] + x1[3] * x1[3]);
                            const f32x4 y0 = x0 * wm[bj][0], y1 = x1 * wm[bj][1];
                            u32x4 w; w.x = cvt_pk_bf16(y0[0], y0[1]); w.y = cvt_pk_bf16(y0[2], y0[3]); w.z = cvt_pk_bf16(y1[0], y1[1]); w.w = cvt_pk_bf16(y1[2], y1[3]);
                            *(u32x4*)(xs + off + bj * HALF) = w; } }
                    if (xs) { q += __shfl_xor(q, 16); q += __shfl_xor(q, 32);
                        if (fq == 0) atomicAdd(ss + row0 + ai * HALF + m * 16, q); } }
        } else {
            const int col0 = u.pn * BM + wc * 32 + 8 * fq;
            float rs[2][4]; row_rstd(rs, row0);
            f32x4 bb[2][2];
#pragma unroll
            for (int bj = 0; bj < 2; ++bj)
#pragma unroll
                for (int n = 0; n < 2; ++n) bb[bj][n] = bvec ? *(const f32x4*)(bvec + (size_t)(u.pm >> 5) * 4112 + col0 + bj * HALF + 4 * n) : (f32x4){0.f, 0.f, 0.f, 0.f};
#pragma unroll
            for (int ai = 0; ai < 2; ++ai)
#pragma unroll
                for (int m = 0; m < 4; ++m) { bf16_t* rowp = o0 + (size_t)(row0 + ai * HALF + m * 16) * 4096 + col0;
#pragma unroll
                    for (int bj = 0; bj < 2; ++bj) { f32x4 v0 = acc[ai][bj][m][0] * rs[ai][m] + bb[bj][0], v1 = acc[ai][bj][m][1] * rs[ai][m] + bb[bj][1];
#pragma unroll
                        for (int e = 0; e < 4; ++e) { const float a = fmaxf(v0[e], 0.f), b = fmaxf(v1[e], 0.f); v0[e] = a * a; v1[e] = b * b; }
                        u32x4 w; w.x = cvt_pk_bf16(v0[0], v0[1]); w.y = cvt_pk_bf16(v0[2], v0[3]); w.z = cvt_pk_bf16(v1[0], v1[1]); w.w = cvt_pk_bf16(v1[2], v1[3]);
                        *(u32x4*)(rowp + bj * HALF) = w; } }
        }
    }
};
template <class Epi, class Sched, bool ALIGN_EPI = false, bool SP2 = false>
__device__ __forceinline__ void gemm_phase(PG8_LAS unsigned char* lds, const Gemm g, const Sched& S, const Epi& E) {
    int tid_ = threadIdx.x; asm volatile("" : "+v"(tid_));
    const int tid = tid_, wid = __builtin_amdgcn_readfirstlane(tid >> 6), lane = tid & 63, wr = wid >> 2, wc = wid & 3, fr = lane & 15, fq = lane >> 4;
    const int K = g.K, nt = K / BK;
    unsigned voffA[2], voffB[2];
#pragma unroll
    for (int i = 0; i < 2; ++i) { int R, C; stage_rc(tid * 16 + i * 8192, R, C); const int Rb = Epi::PERM ? ((R & ~31) + perm32(R & 31)) : R;
        voffA[i] = (unsigned)(R * K + C) * 2u; voffB[i] = (unsigned)(Rb * K + C) * 2u; }
    const size_t kstep = (size_t)(BK * 2);
    const size_t hstep = (size_t)HALF * K * 2;
    const size_t tstep = 2 * hstep;
    const unsigned ldsw = (unsigned)wid * 1024u;
    const int aoff = lds_byte(wr * 64 + fr, fq * 8), boff = lds_byte(wc * 32 + fr, fq * 8);
#define PG8_SA(b, h) (((b) * 2 + (h)) * HTB)
#define PG8_SB(b, h) ((4 + (b) * 2 + (h)) * HTB)
#define PG8_STAGE(bufoff, gbase, voff) do { _Pragma("unroll") for (int _i = 0; _i < 2; ++_i) \
        __builtin_amdgcn_global_load_lds((const unsigned*)((const char*)(gbase) + (voff)[_i]), (PG8_LAS unsigned*)(lds + (bufoff) + ldsw + _i * 8192), 16, 0, 0); } while (0)
#define PG8_LDA(dst, b, h) do { _Pragma("unroll") for (int m = 0; m < 4; ++m) _Pragma("unroll") for (int k = 0; k < 2; ++k) dst[m][k] = *(const PG8_LAS bf16x8*)(lds + PG8_SA(b, h) + aoff + m * 2048 + k * 1024); } while (0)
#define PG8_LDB(dst, b, h) do { _Pragma("unroll") for (int n = 0; n < 2; ++n) _Pragma("unroll") for (int k = 0; k < 2; ++k) dst[n][k] = *(const PG8_LAS bf16x8*)(lds + PG8_SB(b, h) + boff + n * 2048 + k * 1024); } while (0)
#define PG8_MMA(ai, bj, At, Bt) do { __builtin_amdgcn_s_setprio(1); _Pragma("unroll") for (int m = 0; m < 4; ++m) _Pragma("unroll") for (int n = 0; n < 2; ++n) _Pragma("unroll") for (int k = 0; k < 2; ++k) \
        acc[ai][bj][m][n] = __builtin_amdgcn_mfma_f32_16x16x32_bf16(Bt[n][k], At[m][k], acc[ai][bj][m][n], 0, 0, 0); __builtin_amdgcn_s_setprio(0); } while (0)
#define PG8_WAIT_V(n) asm volatile("s_waitcnt vmcnt(" #n ")" ::: "memory")
#define PG8_WAIT_L(n) asm volatile("s_waitcnt lgkmcnt(" #n ")" ::: "memory")
#define PG8_BAR __builtin_amdgcn_s_barrier()
#define PG8_SCHED __builtin_amdgcn_sched_barrier(0)
    Unit cur, nxt; int ui = 0;
    if (!S.next(0, cur)) return;
    f32x4 acc[2][2][4][2];
#pragma unroll
    for (int a = 0; a < 2; ++a)
#pragma unroll
        for (int b = 0; b < 2; ++b)
#pragma unroll
            for (int m = 0; m < 4; ++m)
#pragma unroll
                for (int n = 0; n < 2; ++n) acc[a][b][m][n] = (f32x4){0.f, 0.f, 0.f, 0.f};
    bf16x8 At[4][2], B0[2][2], B1[2][2];
    const char* cA = (const char*)g.A + (size_t)cur.pm * tstep; const char* cB = (const char*)g.Bt + (size_t)cur.pn * tstep;
    S.a_ready(cur);
    if constexpr (SP2) {
        PG8_STAGE(PG8_SB(0, 0), cB, voffB); PG8_STAGE(PG8_SB(0, 1), cB + hstep, voffB); PG8_STAGE(PG8_SA(0, 0), cA, voffA); PG8_STAGE(PG8_SA(0, 1), cA + hstep, voffA);
        if (wr == 1) PG8_BAR;
        PG8_WAIT_V(2); PG8_BAR;
        PG8_STAGE(PG8_SB(1, 0), cB + kstep, voffB); PG8_STAGE(PG8_SA(1, 0), cA + kstep, voffA); PG8_STAGE(PG8_SB(1, 1), cB + hstep + kstep, voffB);
        PG8_WAIT_V(6); PG8_BAR;
    } else {
        PG8_STAGE(PG8_SB(0, 0), cB, voffB); PG8_STAGE(PG8_SA(0, 0), cA, voffA); PG8_STAGE(PG8_SB(0, 1), cB + hstep, voffB); PG8_STAGE(PG8_SA(0, 1), cA + hstep, voffA);
        if (wr == 1) PG8_BAR;
        PG8_WAIT_V(4); PG8_BAR;
        PG8_STAGE(PG8_SB(1, 0), cB + kstep, voffB); PG8_STAGE(PG8_SA(1, 0), cA + kstep, voffA); PG8_STAGE(PG8_SB(1, 1), cB + hstep + kstep, voffB);
        PG8_WAIT_V(6); PG8_BAR;
    }
    for (;;) {
        const bool has_next = S.next(ui + 1, nxt);
        const char* nA = has_next ? (const char*)g.A + (size_t)nxt.pm * tstep : cA; const char* nB = has_next ? (const char*)g.Bt + (size_t)nxt.pn * tstep : cB;
        for (int t = 0; t < nt; t += 2) {
            const bool last = (t == nt - 2);
            const char* a1 = cA + (size_t)(t + 1) * kstep;
            const char* a2 = last ? nA : cA + (size_t)(t + 2) * kstep; const char* b2 = last ? nB : cB + (size_t)(t + 2) * kstep;
            const char* a3 = a2 + kstep; const char* b3 = b2 + kstep;
            if (last && has_next) S.a_ready(nxt);
            if constexpr (SP2) {
            PG8_LDB(B0, 0, 0); PG8_LDB(B1, 0, 1); PG8_SCHED; PG8_LDA(At, 0, 0); PG8_STAGE(PG8_SA(1, 1), a1 + hstep, voffA);
            PG8_WAIT_V(8); PG8_WAIT_L(0); PG8_BAR; PG8_MMA(0, 0, At, B0); PG8_MMA(0, 1, At, B1); PG8_BAR; PG8_SCHED;
            PG8_LDA(At, 0, 1); PG8_STAGE(PG8_SB(0, 0), b2, voffB); PG8_STAGE(PG8_SB(0, 1), b2 + hstep, voffB); PG8_STAGE(PG8_SA(0, 0), a2, voffA);
            PG8_WAIT_V(8); PG8_WAIT_L(0); PG8_BAR; PG8_MMA(1, 0, At, B0); PG8_MMA(1, 1, At, B1); PG8_BAR; PG8_SCHED;
            PG8_LDB(B0, 1, 0); PG8_LDB(B1, 1, 1); PG8_SCHED; PG8_LDA(At, 1, 0); PG8_STAGE(PG8_SA(0, 1), a2 + hstep, voffA);
            PG8_WAIT_V(8); PG8_WAIT_L(0); PG8_BAR; PG8_MMA(0, 0, At, B0); PG8_MMA(0, 1, At, B1); PG8_BAR; PG8_SCHED;
            PG8_LDA(At, 1, 1); PG8_STAGE(PG8_SB(1, 0), b3, voffB); PG8_STAGE(PG8_SB(1, 1), b3 + hstep, voffB); PG8_STAGE(PG8_SA(1, 0), a3, voffA);
            PG8_WAIT_V(8); PG8_WAIT_L(0); PG8_BAR; PG8_MMA(1, 0, At, B0); PG8_MMA(1, 1, At, B1); PG8_BAR; PG8_SCHED;
            } else {
            PG8_LDB(B0, 0, 0); PG8_SCHED; PG8_LDA(At, 0, 0); PG8_STAGE(PG8_SA(1, 1), a1 + hstep, voffA);
            PG8_WAIT_L(8); PG8_BAR; PG8_WAIT_L(0); PG8_MMA(0, 0, At, B0); PG8_BAR; PG8_SCHED;
            PG8_LDB(B1, 0, 1); PG8_STAGE(PG8_SB(0, 0), b2, voffB);
            PG8_BAR; PG8_WAIT_L(0); PG8_MMA(0, 1, At, B1); PG8_BAR;
            PG8_LDA(At, 0, 1); PG8_STAGE(PG8_SA(0, 0), a2, voffA);
            PG8_BAR; PG8_WAIT_L(0); PG8_MMA(1, 0, At, B0); PG8_BAR; PG8_SCHED;
            PG8_STAGE(PG8_SB(0, 1), b2 + hstep, voffB);
            PG8_WAIT_V(6); PG8_BAR; PG8_MMA(1, 1, At, B1); PG8_BAR;
            PG8_LDB(B0, 1, 0); PG8_SCHED; PG8_LDA(At, 1, 0); PG8_STAGE(PG8_SA(0, 1), a2 + hstep, voffA);
            PG8_WAIT_L(8); PG8_BAR; PG8_WAIT_L(0); PG8_MMA(0, 0, At, B0); PG8_BAR; PG8_SCHED;
            PG8_LDB(B1, 1, 1); PG8_STAGE(PG8_SB(1, 0), b3, voffB);
            PG8_BAR; PG8_WAIT_L(0); PG8_MMA(0, 1, At, B1); PG8_BAR;
            PG8_LDA(At, 1, 1); PG8_STAGE(PG8_SA(1, 0), a3, voffA);
            PG8_BAR; PG8_WAIT_L(0); PG8_MMA(1, 0, At, B0); PG8_BAR; PG8_SCHED;
            PG8_STAGE(PG8_SB(1, 1), b3 + hstep, voffB);
            PG8_WAIT_V(6); PG8_BAR; PG8_MMA(1, 1, At, B1); PG8_BAR;
            }
        }
        if constexpr (ALIGN_EPI) { if (wr == 0) PG8_BAR; }
        if constexpr (!Epi::AFTER_DRAIN) { E(acc, cur, wr, wc, fr, fq); S.done(cur); }
        if (!has_next) break;
#pragma unroll
        for (int a = 0; a < 2; ++a)
#pragma unroll
            for (int b = 0; b < 2; ++b)
#pragma unroll
                for (int m = 0; m < 4; ++m)
#pragma unroll
                    for (int n = 0; n < 2; ++n) acc[a][b][m][n] = (f32x4){0.f, 0.f, 0.f, 0.f};
        cur = nxt; cA = nA; cB = nB; ++ui;
        if constexpr (ALIGN_EPI) { if (wr == 1) PG8_BAR; }
    }
    PG8_WAIT_V(0);
    if constexpr (!ALIGN_EPI) { if (wr == 0) PG8_BAR; }
    PG8_BAR;
    if constexpr (Epi::AFTER_DRAIN) { E.fused(acc, cur, wr, wc, fr, fq, lds, wid, lane); S.done(cur); }
#undef PG8_SA
#undef PG8_SB
#undef PG8_STAGE
#undef PG8_LDA
#undef PG8_LDB
#undef PG8_MMA
#undef PG8_WAIT_V
#undef PG8_WAIT_L
#undef PG8_BAR
#undef PG8_SCHED
}
}
#include <hip/hip_bf16.h>
#include <cmath>
namespace attn_body {
using bf16=__hip_bfloat16;
using bf16x8=__attribute__((ext_vector_type(8)))short;
using s16x4=__attribute__((ext_vector_type(4)))short;
using f32x16=__attribute__((ext_vector_type(16)))float;
using u32x4=__attribute__((ext_vector_type(4)))unsigned;
constexpr int BATCH=2,NHEAD=16,SEQ=8192,D=64,DM=NHEAD*D;
constexpr int NW=8,QBLK=32,QB=QBLK*NW,KVBLK=64,NQB=SEQ/QB;
constexpr int ATTN_PITCH=DM, ATTN_UNIT_ROWS=QB;
__device__ __forceinline__ int crow(int r,int hi){return (r&3)+8*(r>>2)+4*hi;}
#define SBAR() __builtin_amdgcn_sched_barrier(0)
__device__ __forceinline__ void cmask(f32x16&p0,f32x16&p1,int jb,int qrel,int hi){
  const float NEG=-INFINITY; int qd=qrel-64*jb-4*hi; asm volatile("":"+v"(qd));
  #pragma unroll
  for(int r=0;r<16;++r){ if((r&3)+8*(r>>2)>qd)p0[r]=NEG; if((r&3)+8*(r>>2)+32>qd)p1[r]=NEG;}
}

constexpr int NSLOT=3, SLOTB=8192;
constexpr int LDS_K=0, LDS_V=NSLOT*SLOTB, LDS_WS=2*NSLOT*SLOTB, LDS_OST=LDS_WS+NW*64*4, LDS_NF=LDS_OST+NW*4096, LDS_BYTES=LDS_NF+SEQ*4;
constexpr float C2=0.125f*1.4426950408889634f;
__device__ __forceinline__ void glds16(const void*gsrc,unsigned lds_dst){unsigned keep;
  asm volatile("s_mov_b32 %0, m0\n\ts_mov_b32 m0, %2\n\ts_nop 0\n\tglobal_load_lds_dwordx4 %1, off\n\ts_mov_b32 m0, %0":"=&s"(keep):"v"(gsrc),"s"(lds_dst):"memory");}
__device__ __forceinline__ float max3f(float a,float b,float c){float r;asm("v_max3_f32 %0, %1, %2, %3":"=v"(r):"v"(a),"v"(b),"v"(c));return r;}
__device__ __forceinline__ float max2f(float a,float b){float r;asm("v_max_f32_e32 %0, %1, %2":"=v"(r):"v"(a),"v"(b));return r;}
__device__ __forceinline__ float fadd_s(float a,float b){float r;asm("v_add_f32_e32 %0, %1, %2":"=v"(r):"v"(a),"v"(b));return r;}
__device__ __forceinline__ float fsub_s(float a,float b){float r;asm("v_sub_f32_e32 %0, %1, %2":"=v"(r):"v"(a),"v"(b));return r;}
typedef float f32x2_t __attribute__((ext_vector_type(2))); typedef __bf16 bf16x2_t __attribute__((ext_vector_type(2)));
__device__ __forceinline__ unsigned cvtpk_s(float lo,float hi){f32x2_t v={lo,hi};bf16x2_t b=__builtin_convertvector(v,bf16x2_t);return __builtin_bit_cast(unsigned,b);}
#define WAIT_BAR(N) asm volatile("s_waitcnt vmcnt(" #N ") lgkmcnt(0)\n\ts_barrier":::"memory")

__device__ __forceinline__ void qkt(f32x16&p0,f32x16&p1,const char*Kslot,const bf16x8*qr,const f32x16&negm,int r32,int hi){
  const char*kb=Kslot+hi*1024+r32*16;
  #pragma unroll
  for(int d0=0;d0<4;++d0){
    const bf16x8 b0=*reinterpret_cast<const bf16x8*>(kb+d0*2048);
    const bf16x8 b1=*reinterpret_cast<const bf16x8*>(kb+d0*2048+512);
    if(d0==0){p0=__builtin_amdgcn_mfma_f32_32x32x16_bf16(b0,qr[0],negm,0,0,0);p1=__builtin_amdgcn_mfma_f32_32x32x16_bf16(b1,qr[0],negm,0,0,0);}
    else{p0=__builtin_amdgcn_mfma_f32_32x32x16_bf16(b0,qr[d0],p0,0,0,0);p1=__builtin_amdgcn_mfma_f32_32x32x16_bf16(b1,qr[d0],p1,0,0,0);}}
}
typedef __attribute__((address_space(3))) const char* lds_cptr;
typedef short v4i16_t __attribute__((ext_vector_type(4)));
__device__ __forceinline__ void kload8(bf16x8*kf,lds_cptr kp){
  kf[0]=*(const __attribute__((address_space(3))) bf16x8*)(kp);      kf[1]=*(const __attribute__((address_space(3))) bf16x8*)(kp+512);
  kf[2]=*(const __attribute__((address_space(3))) bf16x8*)(kp+2048); kf[3]=*(const __attribute__((address_space(3))) bf16x8*)(kp+2560);
  kf[4]=*(const __attribute__((address_space(3))) bf16x8*)(kp+4096); kf[5]=*(const __attribute__((address_space(3))) bf16x8*)(kp+4608);
  kf[6]=*(const __attribute__((address_space(3))) bf16x8*)(kp+6144); kf[7]=*(const __attribute__((address_space(3))) bf16x8*)(kp+6656);
}
__device__ __forceinline__ void kload2(bf16x8*kf,lds_cptr kp,int j){ kf[2*j]=*(const __attribute__((address_space(3))) bf16x8*)(kp+j*2048); kf[2*j+1]=*(const __attribute__((address_space(3))) bf16x8*)(kp+j*2048+512); }
__device__ __forceinline__ s16x4 vtr(lds_cptr p){ return __builtin_bit_cast(s16x4,__builtin_amdgcn_ds_read_tr16_b64_v4i16((__attribute__((address_space(3))) v4i16_t*)p)); }
__device__ __forceinline__ float rowmax(const f32x16&p0,const f32x16&p1){
  float a=max3f(p0[0],p0[1],p1[0]),b=max3f(p0[2],p0[3],p1[1]);a=max3f(a,p1[2],p1[3]);
  #pragma unroll
  for(int r=4;r<16;r+=4){a=max3f(a,p0[r],p0[r+1]);b=max3f(b,p0[r+2],p0[r+3]);a=max3f(a,p1[r],p1[r+1]);b=max3f(b,p1[r+2],p1[r+3]);}
  const float m=max2f(a,b);
  auto rr=__builtin_amdgcn_permlane32_swap(__float_as_uint(m),__float_as_uint(m),false,false);
  return max2f(__uint_as_float(rr[0]),__uint_as_float(rr[1]));
}
__device__ __forceinline__ void pv(f32x16*o,int vb,bf16x8 pa0,bf16x8 pa1,bf16x8 pa2,bf16x8 pa3){
  #pragma unroll
  for(int d0=0;d0<2;++d0){s16x4 lo[4],hi[4];
    #pragma unroll
    for(int ks=0;ks<4;++ks){
      asm volatile("ds_read_b64_tr_b16 %0,%1 offset:%c2":"=&v"(lo[ks]):"v"(vb),"i"(d0*4096+ks*1024):"memory");
      asm volatile("ds_read_b64_tr_b16 %0,%1 offset:%c2":"=&v"(hi[ks]):"v"(vb),"i"(d0*4096+ks*1024+512):"memory");}
    asm volatile("s_waitcnt lgkmcnt(0)":::"memory");SBAR();
    #define PK(k) (bf16x8){lo[k][0],lo[k][1],lo[k][2],lo[k][3],hi[k][0],hi[k][1],hi[k][2],hi[k][3]}
    o[d0]=__builtin_amdgcn_mfma_f32_32x32x16_bf16(pa0,PK(0),o[d0],0,0,0);
    o[d0]=__builtin_amdgcn_mfma_f32_32x32x16_bf16(pa1,PK(1),o[d0],0,0,0);
    o[d0]=__builtin_amdgcn_mfma_f32_32x32x16_bf16(pa2,PK(2),o[d0],0,0,0);
    o[d0]=__builtin_amdgcn_mfma_f32_32x32x16_bf16(pa3,PK(3),o[d0],0,0,0);
    #undef PK
  }
}

#ifndef ATTN_STORE16
#define ATTN_STORE16(p,v) (*(u32x4*)(p)=(v))
#endif
typedef float f32x4_t __attribute__((ext_vector_type(4))); typedef float f32x2_p __attribute__((ext_vector_type(2)));
template<int THRL> __device__ __forceinline__ void attn_unit(int b,int h,int qb,const bf16*Q,const bf16*__restrict__ K,const bf16*__restrict__ V,bf16*O,const float*__restrict__ NFg,const bf16*__restrict__ SG,char*shm){
  int tid_=threadIdx.x; asm volatile("":"+v"(tid_)); const int tid=tid_,lane=tid&63,r32=lane&31,hi=lane>>5; const int wid=__builtin_amdgcn_readfirstlane(tid>>6);
  const long rowbase=(long)b*SEQ; const int q0=qb*QB;
  const bf16*Qw=Q+(rowbase+q0+wid*QBLK)*DM+h*D;
  const bf16*Kh=K+rowbase*DM+h*D,*Vh=V+rowbase*DM+h*D;
  const unsigned lds0=(unsigned)(uintptr_t)shm;
  float*wsf=(float*)(shm+LDS_WS)+wid*64;
  const bf16*ksrc=Kh+(long)lane*DM+wid*8;
  const bf16*vsrc=Vh+(long)(16*(wid&3)+(lane>>2))*DM+(wid>>2)*32+(lane&3)*8;
  const unsigned kdst=lds0+LDS_K+wid*1024, vdst=lds0+LDS_V+wid*1024;
  #define DMA_K(t,slot) glds16(ksrc+(long)(t)*KVBLK*DM,(unsigned)__builtin_amdgcn_readfirstlane(kdst+(slot)))
  #define DMA_V(t,slot) glds16(vsrc+(long)(t)*KVBLK*DM,(unsigned)__builtin_amdgcn_readfirstlane(vdst+(slot)))
  const int vb0=(int)(lds0+LDS_V)+((lane>>4)&1)*32+(lane&3)*8+(4*hi+((lane&15)>>2))*64;
  const char*Kbase=shm+LDS_K; bf16x8 kf[8];
  const lds_cptr shm3=(lds_cptr)shm; const lds_cptr kp0=shm3+LDS_K+hi*1024+r32*16; const lds_cptr vp0=shm3+LDS_V+((lane>>4)&1)*32+(lane&3)*8+(4*hi+((lane&15)>>2))*64;
  const int NT=(q0+QB)/KVBLK;
  #define PKADD(P,B,x,y) do{ f32x2_p t_={P[B],P[(B)+1]}; t_+=(f32x2_p){x,y}; P[B]=t_[0]; P[(B)+1]=t_[1]; }while(0)
  #define BIAS(P0,P1,t) do{ const __attribute__((address_space(3))) f32x4_t*nb_=(const __attribute__((address_space(3))) f32x4_t*)(shm3+LDS_NF+(t)*256+hi*16); \
    _Pragma("unroll") for(int j_=0;j_<4;++j_){ const f32x4_t a_=nb_[2*j_]; PKADD(P0,4*j_,a_[0],a_[1]); PKADD(P0,4*j_+2,a_[2],a_[3]); } SBAR(); \
    _Pragma("unroll") for(int j_=0;j_<4;++j_){ const f32x4_t b_=nb_[2*j_+8]; PKADD(P1,4*j_,b_[0],b_[1]); PKADD(P1,4*j_+2,b_[2],b_[3]); } SBAR(); }while(0)
  DMA_K(0,0);DMA_V(0,0);DMA_K(1,SLOTB);
  bf16x8 qr[4];
  #pragma unroll
  for(int d0=0;d0<4;++d0)qr[d0]=*reinterpret_cast<const bf16x8*>(&Qw[(long)r32*DM+d0*16+hi*8]);
  float mhat=0.f,l_reg=0.f;f32x16 o[2];o[0]=f32x16{};o[1]=f32x16{};f32x16 negm=f32x16{};asm volatile("":"+v"(negm));
  const int qrel=wid*QBLK+r32;
  #define CMASK(P0,P1,t) do{int jb_=(t)-(NT-4); if(jb_>=0)cmask(P0,P1,jb_,qrel,hi);}while(0)
  bool resc=false;
  #define START(P0,P1) do{ const float rm=rowmax(P0,P1); resc=false; \
    { const float dl=rm; mhat=fadd_s(mhat,dl); \
      _Pragma("unroll") for(int r=0;r<16;++r){P0[r]=fsub_s(P0[r],dl);P1[r]=fsub_s(P1[r],dl);} \
      _Pragma("unroll") for(int r=0;r<16;++r)negm[r]=-mhat; asm volatile("":"+v"(negm)); } \
    _Pragma("unroll") for(int r=0;r<16;++r)P0[r]=__builtin_amdgcn_exp2f(P0[r]); }while(0)
  #define RESC() do{ if(resc){ asm volatile("s_waitcnt lgkmcnt(0)":::"memory"); \
      _Pragma("unroll") for(int d_=0;d_<2;++d_) _Pragma("unroll") for(int r=0;r<16;++r)o[d_][r]*=wsf[crow(r,hi)]; } }while(0)
  f32x16 pA0,pA1,pB0,pB1;
  int sl_prev=0,sl_cur=0,sl_next=SLOTB;
  #define ROT() do{sl_prev=sl_cur;sl_cur=sl_next;sl_next=(sl_next==(NSLOT-1)*SLOTB)?0:sl_next+SLOTB;}while(0)
  DMA_K(2,2*SLOTB);
  WAIT_BAR(3);
  qkt(pA0,pA1,Kbase,qr,negm,r32,hi);asm volatile("s_nop 15\n\ts_nop 7":"+v"(pA0),"+v"(pA1));BIAS(pA0,pA1,0);CMASK(pA0,pA1,0);
  START(pA0,pA1);
  _Pragma("unroll") for(int r=0;r<16;++r)pA1[r]=__builtin_amdgcn_exp2f(pA1[r]);
  WAIT_BAR(0);
  DMA_K(3,0);DMA_V(1,SLOTB);
  ROT();
  kload8(kf,kp0+sl_cur);
  WAIT_BAR(2);
  s16x4 vlo[8],vhi[8]; u32x4 pw0,pw1,pw2,pw3;
  #define PKW(P,B) cvtpk_s(P[B],P[B+1])
  #define PAF(k) __builtin_bit_cast(bf16x8,pw##k)
  #define VFR(i) (bf16x8){vlo[i][0],vlo[i][1],vlo[i][2],vlo[i][3],vhi[i][0],vhi[i][1],vhi[i][2],vhi[i][3]}
  #define PIN(x) asm volatile("":"+v"(x))
  #define MX3(a,b,c) __builtin_fmaxf(__builtin_fmaxf((a),(b)),(c))
  #define GAPA(MF,A0,A1,A2,A3,W0,W1,PW) do{ MF; sacc+=A0; sacc+=A1; sacc+=A2; sacc+=A3; PIN(sacc); W0; W1; PIN(PW); SBAR(); }while(0)
  #define EX(v) __builtin_amdgcn_exp2f(v)
  #define GAPB(MF,X,B) do{ MF; X[B]=EX(X[B]); X[B+1]=EX(X[B+1]); X[B+2]=EX(X[B+2]); X[B+3]=EX(X[B+3]); PIN(X); SBAR(); }while(0)
  #define VRD(i) do{ vlo[i]=vtr(vp_+(((i)>>2)*4096+((i)&3)*1024)); vhi[i]=vtr(vp_+(((i)>>2)*4096+((i)&3)*1024+512)); }while(0)
  #define KRD(G,j) do{ if(G){ kload2(kf,kp0+sl_next,j); SBAR(); } }while(0)
  #define STEP(C0,C1,P0,P1,t,GK,GV,GL) do{ SBAR(); \
    const lds_cptr vp_=vp0+sl_prev; \
    VRD(0); SBAR(); float sacc=(P0[0]+P0[1]); \
    GAPA(C0=__builtin_amdgcn_mfma_f32_32x32x16_bf16(kf[0],qr[0],negm,0,0,0), P0[2],P0[3],P0[4],P0[5],     pw0[0]=PKW(P0,0), pw0[1]=PKW(P0,2), pw0); \
    VRD(4); SBAR(); GAPA(C1=__builtin_amdgcn_mfma_f32_32x32x16_bf16(kf[1],qr[0],negm,0,0,0), P0[6],P0[7],P0[8],P0[9],     pw0[2]=PKW(P0,4), pw0[3]=PKW(P0,6), pw0); \
    VRD(1); SBAR(); GAPA(C0=__builtin_amdgcn_mfma_f32_32x32x16_bf16(kf[2],qr[1],C0,0,0,0),   P0[10],P0[11],P0[12],P0[13], pw1[0]=PKW(P0,8), pw1[1]=PKW(P0,10), pw1); \
    VRD(5); SBAR(); GAPA(C1=__builtin_amdgcn_mfma_f32_32x32x16_bf16(kf[3],qr[1],C1,0,0,0),   P0[14],P0[15],P1[0],P1[1],   pw1[2]=PKW(P0,12),pw1[3]=PKW(P0,14), pw1); \
    VRD(2); SBAR(); GAPA(C0=__builtin_amdgcn_mfma_f32_32x32x16_bf16(kf[4],qr[2],C0,0,0,0),   P1[2],P1[3],P1[4],P1[5],     pw2[0]=PKW(P1,0), pw2[1]=PKW(P1,2), pw2); \
    VRD(6); SBAR(); GAPA(C1=__builtin_amdgcn_mfma_f32_32x32x16_bf16(kf[5],qr[2],C1,0,0,0),   P1[6],P1[7],P1[8],P1[9],     pw2[2]=PKW(P1,4), pw2[3]=PKW(P1,6), pw2); \
    VRD(3); SBAR(); GAPA(C0=__builtin_amdgcn_mfma_f32_32x32x16_bf16(kf[6],qr[3],C0,0,0,0),   P1[10],P1[11],P1[12],P1[13], pw3[0]=PKW(P1,8), pw3[1]=PKW(P1,10), pw3); \
    VRD(7); SBAR(); GAPA(C1=__builtin_amdgcn_mfma_f32_32x32x16_bf16(kf[7],qr[3],C1,0,0,0),   P1[14],P1[15],0.f,0.f,       pw3[2]=PKW(P1,12),pw3[3]=PKW(P1,14), pw3); \
    l_reg+=sacc; \
    if(GK){DMA_K((t)+3,sl_cur);} if(GV){DMA_V((t)+1,sl_next);} \
    BIAS(C0,C1,t); CMASK(C0,C1,t); \
    { float a=MX3(C0[0],C0[1],C1[0]),b=MX3(C0[2],C0[3],C1[1]); a=MX3(a,C1[2],C1[3]); \
      _Pragma("unroll") for(int r=4;r<16;r+=4){a=MX3(a,C0[r],C0[r+1]);b=MX3(b,C0[r+2],C0[r+3]);a=MX3(a,C1[r],C1[r+1]);b=MX3(b,C1[r+2],C1[r+3]);} \
      float rm=__builtin_fmaxf(a,b); { auto rr=__builtin_amdgcn_permlane32_swap(__float_as_uint(rm),__float_as_uint(rm),false,false); rm=__builtin_fmaxf(__uint_as_float(rr[0]),__uint_as_float(rr[1])); } \
      resc=false; \
      if(__builtin_expect(__any(rm>(float)THRL),0)){ const float dl=__builtin_fmaxf(rm,0.f); mhat+=dl; \
        _Pragma("unroll") for(int r=0;r<16;++r){C0[r]-=dl;C1[r]-=dl;} \
        _Pragma("unroll") for(int r=0;r<16;++r)negm[r]=-mhat; asm volatile("":"+v"(negm)); \
        const float f=__builtin_amdgcn_exp2f(-dl); l_reg*=f; if(hi==0)wsf[r32]=f; resc=true; } } \
    SBAR(); \
    GAPB(o[0]=__builtin_amdgcn_mfma_f32_32x32x16_bf16(PAF(0),VFR(0),o[0],0,0,0), C0,0); \
    GAPB(o[1]=__builtin_amdgcn_mfma_f32_32x32x16_bf16(PAF(0),VFR(4),o[1],0,0,0), C0,4); \
    KRD(GL,0); GAPB(o[0]=__builtin_amdgcn_mfma_f32_32x32x16_bf16(PAF(1),VFR(1),o[0],0,0,0), C0,8); \
    KRD(GL,1); GAPB(o[1]=__builtin_amdgcn_mfma_f32_32x32x16_bf16(PAF(1),VFR(5),o[1],0,0,0), C0,12); \
    KRD(GL,2); GAPB(o[0]=__builtin_amdgcn_mfma_f32_32x32x16_bf16(PAF(2),VFR(2),o[0],0,0,0), C1,0); \
    KRD(GL,3); GAPB(o[1]=__builtin_amdgcn_mfma_f32_32x32x16_bf16(PAF(2),VFR(6),o[1],0,0,0), C1,4); \
    GAPB(o[0]=__builtin_amdgcn_mfma_f32_32x32x16_bf16(PAF(3),VFR(3),o[0],0,0,0), C1,8); \
    GAPB(o[1]=__builtin_amdgcn_mfma_f32_32x32x16_bf16(PAF(3),VFR(7),o[1],0,0,0), C1,12); \
    }while(0)
  int t=1;
  #undef CMASK
  #define CMASK(P0,P1,t) do{}while(0)
  for(;t+5<NT;t+=2){
    STEP(pB0,pB1,pA0,pA1,t,true,true,true);     WAIT_BAR(2); RESC(); ROT();
    STEP(pA0,pA1,pB0,pB1,t+1,true,true,true);   WAIT_BAR(2); RESC(); ROT();
  }
  #undef CMASK
  #define CMASK(P0,P1,t) do{int jb_=(t)-(NT-4); if(jb_>=0)cmask(P0,P1,jb_,qrel,hi);}while(0)
  #define ENDW(tt) do{ if((tt)+3<NT){WAIT_BAR(2);} else if((tt)+2<NT){WAIT_BAR(1);} else {WAIT_BAR(0);} }while(0)
  for(;t+1<NT;t+=2){
    STEP(pB0,pB1,pA0,pA1,t,(t+3<NT),(t+1<NT),(t+1<NT));       ENDW(t);   RESC(); ROT();
    STEP(pA0,pA1,pB0,pB1,t+1,(t+4<NT),(t+2<NT),(t+2<NT));     ENDW(t+1); RESC(); ROT();
  }
  STEP(pB0,pB1,pA0,pA1,NT-1,false,false,false); RESC();
  { float sacc=pB0[0]+pB0[1]; _Pragma("unroll") for(int r=2;r<16;++r)sacc+=pB0[r]; _Pragma("unroll") for(int r=0;r<16;++r)sacc+=pB1[r]; l_reg+=sacc;
    pw0=(u32x4){PKW(pB0,0),PKW(pB0,2),PKW(pB0,4),PKW(pB0,6)};pw1=(u32x4){PKW(pB0,8),PKW(pB0,10),PKW(pB0,12),PKW(pB0,14)};pw2=(u32x4){PKW(pB1,0),PKW(pB1,2),PKW(pB1,4),PKW(pB1,6)};pw3=(u32x4){PKW(pB1,8),PKW(pB1,10),PKW(pB1,12),PKW(pB1,14)};
    SBAR(); pv(o,vb0+sl_cur,PAF(0),PAF(1),PAF(2),PAF(3)); }
  #undef PKW
  #undef PAF
  #undef VFR
  #undef PIN
  #undef MX3
  #undef GAPA
  #undef GAPB
  #undef EX
  #undef VRD
  #undef KRD
  #undef STEP
  #undef ENDW
  {auto rr=__builtin_amdgcn_permlane32_swap(__float_as_uint(l_reg),__float_as_uint(l_reg),false,false);l_reg=__uint_as_float(rr[0])+__uint_as_float(rr[1]);}
  if(hi==0)wsf[32+r32]=l_reg;asm volatile("s_waitcnt lgkmcnt(0)":::"memory");
  float rli[16];
  #pragma unroll
  for(int r=0;r<16;++r)rli[r]=__builtin_amdgcn_rcpf(wsf[32+crow(r,hi)]);
  bf16*Ow=O+(rowbase+q0+wid*QBLK)*DM+h*D; const bf16*SGw=SG+(rowbase+q0+wid*QBLK)*DM+h*D;
  { bf16*stg=(bf16*)(shm+LDS_OST)+wid*2048;
    #pragma unroll
    for(int r=0;r<16;++r){const int orow=crow(r,hi);
      #pragma unroll
      for(int d0=0;d0<2;++d0)stg[orow*64+d0*32+r32]=__float2bfloat16(o[d0][r]*rli[r]);}
    asm volatile("s_waitcnt lgkmcnt(0)":::"memory");
    #pragma unroll
    for(int i=0;i<4;++i){const int row=i*8+(lane>>3),ch=lane&7; u32x4 v=*(const u32x4*)(stg+row*64+ch*8); const u32x4 gq=*(const u32x4*)(SGw+(long)row*DM+ch*8);
      _Pragma("unroll") for(int e_=0;e_<4;++e_){ const float lo_=__uint_as_float(v[e_]<<16)*__uint_as_float(gq[e_]<<16), hi_=__uint_as_float(v[e_]&0xffff0000u)*__uint_as_float(gq[e_]&0xffff0000u); v[e_]=cvtpk_s(lo_,hi_); }
      ATTN_STORE16(Ow+(long)row*DM+ch*8,v);} }
  asm volatile("s_waitcnt lgkmcnt(0)\n\ts_barrier":::"memory");
  #undef DMA_K
  #undef BIAS
  #undef PKADD
  #undef DMA_V
  #undef CMASK
  #undef START
  #undef RESC
  #undef ROT
}
constexpr int ATTN_LDS_BYTES=LDS_BYTES;
struct AttnTensors { const bf16* Q; const bf16* K; const bf16* V; bf16* O; const float* NF; const bf16* SG; };
struct AttnUnit { int bh; int qb; };
struct StaticOrder {
  int vcu;
  __device__ __forceinline__ explicit StaticOrder(int grid,int block):vcu((block%8)*(grid/8)+block/8){}
  __device__ __forceinline__ bool next(int i,AttnUnit&u)const{ if(i>=4)return false; const int s=vcu&7; u.bh=vcu>>3; u.qb=(i==0)?s:(i==1)?15-s:(i==2)?16+s:31-s; return true; }
  __device__ __forceinline__ void a_ready(const AttnUnit&)const{}
  __device__ __forceinline__ void done(const AttnUnit&)const{}
};
template<class Sched,int THRL=8> __device__ __forceinline__ void attn_phase(char*lds,const AttnTensors&T,const Sched&S){
  AttnUnit u;
  if(S.next(0,u)){
    typedef float f32x4_s __attribute__((ext_vector_type(4))); const f32x4_s*nsrc=(const f32x4_s*)(T.NF+(long)u.bh*SEQ)+threadIdx.x*4; __attribute__((address_space(3))) char*l3=(__attribute__((address_space(3))) char*)lds;
    __attribute__((address_space(3))) f32x4_s*ndst=(__attribute__((address_space(3))) f32x4_s*)(l3+LDS_NF)+threadIdx.x*4; __attribute__((address_space(3))) float*wtot=(__attribute__((address_space(3))) float*)(l3+LDS_WS);
    const int ln_=threadIdx.x&63, wv_=threadIdx.x>>6; f32x4_s v_[4]; float run_=0.f;
    _Pragma("unroll") for(int j=0;j<4;++j){ v_[j]=nsrc[j]; v_[j].x+=run_; v_[j].y+=v_[j].x; v_[j].z+=v_[j].y; v_[j].w+=v_[j].z; run_=v_[j].w; }
    float inc_=run_;
    _Pragma("unroll") for(int o=1;o<64;o<<=1){ const float t_=__shfl_up(inc_,o); if(ln_>=o)inc_+=t_; }
    if(ln_==63)wtot[wv_]=inc_;
    asm volatile("s_waitcnt vmcnt(0) lgkmcnt(0)\n\ts_barrier":::"memory");
    float off_=inc_-run_; for(int w=0;w<wv_;++w)off_+=wtot[w];
    _Pragma("unroll") for(int j=0;j<4;++j)ndst[j]=(v_[j]+off_)*(-1.4426950408889634f);
    asm volatile("s_waitcnt vmcnt(0) lgkmcnt(0)\n\ts_barrier":::"memory"); }
  for(int i=0;S.next(i,u);++i){ S.a_ready(u); attn_unit<THRL>(u.bh/NHEAD,u.bh%NHEAD,u.qb,T.Q,T.K,T.V,T.O,T.NF,T.SG,lds); S.done(u); }
}
#undef SBAR
#undef WAIT_BAR
}
constexpr int NWAVES = 8, NTHR = 512;
constexpr int BATCH = 2, T = 8192, D = 1024, FF = 4096, M = BATCH * T;
constexpr int NIN_FOX = 4 * D + 16;
constexpr float EPS = 1e-6f;
constexpr size_t MiB = 1u << 20;
constexpr size_t WS_MOD = 0;
constexpr size_t WS_LB = 128 * 1024;
constexpr size_t WS_QKNW = 160 * 1024;
constexpr size_t WS_WFZ = 192 * 1024;
constexpr size_t WS_DN = 256 * 1024;
constexpr size_t WS_LFS = 1536 * 1024;
constexpr size_t WS_NF = 2560 * 1024;
constexpr size_t WS_BAR = 3584 * 1024, BAR_BYTES = 16384;
constexpr size_t WS_SS = 3648 * 1024;
constexpr size_t WS_BIASV = 3840 * 1024;
constexpr size_t WS_XN2 = 216 * MiB;
constexpr size_t WS_W_HGIN = 4 * MiB, WS_W_HGOUT = 12 * MiB, WS_W_FOXIN = 14 * MiB, WS_W_FOXOUT = 22 * MiB;
constexpr size_t WS_W1_0 = 24 * MiB, WS_W2_0 = 32 * MiB, WS_W1_1 = 40 * MiB, WS_W2_1 = 48 * MiB;
constexpr size_t WS_XN = 56 * MiB;
constexpr size_t WS_R = 88 * MiB;
constexpr size_t WS_QO = WS_R, WS_B1 = WS_R + 32 * MiB, WS_B2 = WS_R + 64 * MiB, WS_B3 = WS_R + 96 * MiB;
constexpr size_t WS_ST = WS_R + 96 * MiB;
constexpr size_t WS_H = WS_R;
constexpr size_t WS_END = 256 * MiB;
static_assert(WS_ST + 64 * MiB <= WS_END && WS_H + 128 * MiB <= WS_END && WS_B1 - WS_QO == 32 * MiB, "ws map");
constexpr int LDS_BYTES = 147456;

#define GAS __attribute__((address_space(1)))
#define LAS __attribute__((address_space(3)))
typedef unsigned short bf16;
typedef unsigned v4u __attribute__((ext_vector_type(4)));
typedef unsigned v2u __attribute__((ext_vector_type(2)));
typedef float f32x4 __attribute__((ext_vector_type(4)));
typedef short bf16x8 __attribute__((ext_vector_type(8)));
typedef short s16x4v __attribute__((ext_vector_type(4)));
#define LDS_WAIT() asm volatile("s_waitcnt lgkmcnt(0)" ::: "memory")
__device__ __forceinline__ unsigned f2bf(float f) { unsigned u = __builtin_bit_cast(unsigned, f); return (u + 0x7fffu + ((u >> 16) & 1u)) >> 16; }
__device__ __forceinline__ unsigned pk2(float lo, float hi) { return pg8::cvt_pk_bf16(lo, hi); }
__device__ __forceinline__ float bf2f(unsigned short h) { return __uint_as_float((unsigned)h << 16); }
__device__ __forceinline__ float wave_sum(float v) {
#pragma unroll
    for (int o = 1; o < 64; o <<= 1) v += __shfl_xor(v, o);
    return v;
}

struct Args { const float* in[18]; float* out; unsigned char* ws; };

template <bool HEADPERM>
__device__ __forceinline__ void transpose_item(const float* W, int K, int ldw, int Ncols, bf16* WT, LAS float* scr, int item, int lane) {
    const int nblk = Ncols / 32, kb = item / nblk, nb = item % nblk, k0 = 64 * kb, n0 = 32 * nb;
#pragma unroll 8
    for (int i = 0; i < 32; ++i) { const int kk = 2 * i + (lane >> 5); scr[kk * 33 + (lane & 31)] = W[(size_t)(k0 + kk) * ldw + n0 + (lane & 31)]; }
    LDS_WAIT(); asm volatile("" ::: "memory");
    const int c = lane & 7;
#pragma unroll
    for (int j = 0; j < 4; ++j) { const int n = (lane >> 3) + 8 * j; const LAS float* s = scr + (8 * c) * 33 + n;
        v4u o; o.x = pk2(s[0 * 33], s[1 * 33]); o.y = pk2(s[2 * 33], s[3 * 33]); o.z = pk2(s[4 * 33], s[5 * 33]); o.w = pk2(s[6 * 33], s[7 * 33]);
        int col = n0 + n;
        if (HEADPERM && col < 2048) { const int nl = col & 255; col = (col & ~255) + 128 * ((nl >> 5) & 1) + 32 * (nl >> 6) + (nl & 31); }
        *(GAS v4u*)(WT + (size_t)col * K + k0 + 8 * c) = o; }
    LDS_WAIT(); asm volatile("" ::: "memory");
}

__device__ __forceinline__ void norm_rows(int gw, int NGW, int lane, const float* xin, const float* w, const float* modsh, const float* modsc, bf16* outb, float* outf) {
    for (int m = gw; m < M; m += NGW) {
        const GAS f32x4* xr = (const GAS f32x4*)(xin + (size_t)m * D) + lane;
        f32x4 v[4]; float s = 0.f;
#pragma unroll
        for (int j = 0; j < 4; ++j) { v[j] = xr[64 * j]; s += (v[j].x * v[j].x + v[j].y * v[j].y) + (v[j].z * v[j].z + v[j].w * v[j].w); }
        const float rstd = __builtin_amdgcn_rsqf(wave_sum(s) * (1.f / D) + EPS);
        const int b = m >> 13;
#pragma unroll
        for (int j = 0; j < 4; ++j) {
            const f32x4 wv = *((const f32x4*)w + lane + 64 * j);
            f32x4 y = v[j] * rstd * wv;
            if (modsc) { const f32x4 sc = *((const f32x4*)(modsc + b * 6144) + lane + 64 * j), sh = *((const f32x4*)(modsh + b * 6144) + lane + 64 * j); y = y * (1.0f + sc) + sh; }
            if (outf) *((GAS f32x4*)(outf + (size_t)m * D) + lane + 64 * j) = y;
            else { v2u o; o.x = pk2(y.x, y.y); o.y = pk2(y.z, y.w); *((GAS v2u*)(outb + (size_t)m * D) + lane + 64 * j) = o; }
        }
    }
}

constexpr int HG_QM = 0, HG_KM = 17408, HG_Q0 = 34816, HG_KT = 52224, HG_VT = 70656, HG_STL = 89088, HG_PART = 123904, HG_RED = 125952;
constexpr int PQ = 136, PT = 72;
#define MFMA16(a, b, c) __builtin_amdgcn_mfma_f32_16x16x32_bf16((a), (b), (c), 0, 0, 0)

__device__ __forceinline__ void hg_pass_a(LAS unsigned char* lds, int tid, int lane, int wave, const float* LF, const bf16* V, bf16* ST, float* DN) {
    const int p = tid >> 7, kk = tid & 127, g = lane >> 4, l15 = lane & 15;
    LAS float* part = (LAS float*)(lds + HG_PART);
    LAS bf16* KT = (LAS bf16*)(lds + HG_KT); LAS bf16* VT = (LAS bf16*)(lds + HG_VT);
    for (int u = blockIdx.x; u < 2048; u += gridDim.x) {
        const int bh = u >> 7, n = u & 127, b = bh >> 3, h = bh & 7;
        const size_t row0 = (size_t)b * T + n * 64 + 16 * p;
        float G[16], kv[16]; unsigned short vv[16];
        const float* lfp = LF + row0 * D + h * 128 + kk; const bf16* vp = V + row0 * D + h * 128 + kk;
#pragma unroll
        for (int j = 0; j < 16; ++j) { G[j] = lfp[(size_t)j * D]; vv[j] = vp[(size_t)j * D]; }
#pragma unroll
        for (int j = 0; j < 16; ++j) { kv[j] = 1.0f - __expf(G[j]); if (j) G[j] += G[j - 1]; }
        part[p * 128 + kk] = G[15];
        __syncthreads();
        const float t0 = part[kk], t1 = part[128 + kk], t2 = part[256 + kk], t3 = part[384 + kk];
        const float off = (p > 0 ? t0 : 0.f) + (p > 1 ? t1 : 0.f) + (p > 2 ? t2 : 0.f), glast = (t0 + t1) + (t2 + t3);
        unsigned kw[8], vw[8];
#pragma unroll
        for (int j = 0; j < 8; ++j) {
            const float a0 = kv[2 * j] * __expf(glast - (G[2 * j] + off)), a1 = kv[2 * j + 1] * __expf(glast - (G[2 * j + 1] + off));
            kw[j] = pk2(a0, a1); vw[j] = (unsigned)vv[2 * j] | ((unsigned)vv[2 * j + 1] << 16); }
        *(LAS v4u*)(KT + kk * PT + 16 * p) = (v4u){kw[0], kw[1], kw[2], kw[3]}; *(LAS v4u*)(KT + kk * PT + 16 * p + 8) = (v4u){kw[4], kw[5], kw[6], kw[7]};
        *(LAS v4u*)(VT + kk * PT + 16 * p) = (v4u){vw[0], vw[1], vw[2], vw[3]}; *(LAS v4u*)(VT + kk * PT + 16 * p + 8) = (v4u){vw[4], vw[5], vw[6], vw[7]};
        if (p == 0) DN[(size_t)u * 128 + kk] = __expf(glast);
        __syncthreads();
        bf16x8 bfr[2];
#pragma unroll
        for (int ss = 0; ss < 2; ++ss) bfr[ss] = *(const LAS bf16x8*)(VT + (16 * wave + l15) * PT + 32 * ss + 8 * g);
        bf16* stp = ST + ((size_t)u * 128 + 16 * wave + l15) * 128 + 4 * g;
#pragma unroll
        for (int kt = 0; kt < 8; ++kt) {
            f32x4 acc = (f32x4){0.f, 0.f, 0.f, 0.f};
#pragma unroll
            for (int ss = 0; ss < 2; ++ss) { const bf16x8 a = *(const LAS bf16x8*)(KT + (16 * kt + l15) * PT + 32 * ss + 8 * g); acc = MFMA16(a, bfr[ss], acc); }
            v2u o; o.x = pk2(acc[0], acc[1]); o.y = pk2(acc[2], acc[3]); *(GAS v2u*)(stp + 16 * kt) = o;
        }
        __syncthreads();
    }
}
__device__ __forceinline__ void hg_pass_b(int tid, bf16* ST, const float* DN) {
    const int gt = blockIdx.x * NTHR + tid;
    for (int e2 = gt; e2 < 16 * 8192; e2 += gridDim.x * NTHR) {
        const int bh = e2 >> 13, pe = e2 & 8191, k = (2 * pe) & 127;
        unsigned* sp = (unsigned*)ST + (size_t)bh * 128 * 8192 + pe; const float* dp = DN + (size_t)bh * 128 * 128 + k;
        float s0 = 0.f, s1 = 0.f;
        for (int n0 = 0; n0 < 128; n0 += 8) {
            unsigned dv[8]; float d0[8], d1[8];
#pragma unroll
            for (int j = 0; j < 8; ++j) { dv[j] = sp[(size_t)(n0 + j) * 8192]; const float2 dd = *(const float2*)(dp + (size_t)(n0 + j) * 128); d0[j] = dd.x; d1[j] = dd.y; }
#pragma unroll
            for (int j = 0; j < 8; ++j) { sp[(size_t)(n0 + j) * 8192] = pk2(s0, s1);
                s0 = d0[j] * s0 + __uint_as_float(dv[j] << 16); s1 = d1[j] * s1 + __uint_as_float(dv[j] & 0xffff0000u); }
        }
    }
}
__device__ __forceinline__ void hg_pass_c(LAS unsigned char* lds, int tid, int lane, int wave, const float* LF, const bf16* QO, bf16* OUTB, const bf16* V, const bf16* GS, const bf16* ST, const float* gnw) {
    const int p = tid >> 7, kk = tid & 127, g = lane >> 4, l15 = lane & 15, tt = wave & 3, vh = wave >> 2;
    LAS float* part = (LAS float*)(lds + HG_PART); LAS float* red = (LAS float*)(lds + HG_RED);
    LAS bf16* QM = (LAS bf16*)(lds + HG_QM); LAS bf16* KM = (LAS bf16*)(lds + HG_KM); LAS bf16* Q0 = (LAS bf16*)(lds + HG_Q0);
    LAS bf16* VT = (LAS bf16*)(lds + HG_VT); LAS bf16* STL = (LAS bf16*)(lds + HG_STL);
    for (int u = blockIdx.x; u < 2048; u += gridDim.x) {
        const int bh = u >> 7, n = u & 127, b = bh >> 3, h = bh & 7;
        const size_t rowu = (size_t)b * T + n * 64, row0 = rowu + 16 * p;
        { const v4u* src = (const v4u*)(ST + (size_t)u * 16384);
#pragma unroll
          for (int i = 0; i < 4; ++i) { const int q = tid + 512 * i; const v4u x = src[q]; *(LAS v4u*)(STL + (q >> 4) * PQ + (q & 15) * 8) = x; } }
        float G[16], lf[16]; unsigned short vv[16], qq[16];
        const float* lfp = LF + row0 * D + h * 128 + kk; const bf16* vp = V + row0 * D + h * 128 + kk; const bf16* qp = QO + row0 * D + h * 128 + kk;
#pragma unroll
        for (int j = 0; j < 16; ++j) { lf[j] = lfp[(size_t)j * D]; vv[j] = vp[(size_t)j * D]; qq[j] = qp[(size_t)j * D]; }
#pragma unroll
        for (int j = 0; j < 16; ++j) { G[j] = lf[j] + (j ? G[j - 1] : 0.f); }
        part[p * 128 + kk] = G[15];
        __syncthreads();
        const float t0 = part[kk], t1 = part[128 + kk], t2 = part[256 + kk];
        const float off = (p > 0 ? t0 : 0.f) + (p > 1 ? t1 : 0.f) + (p > 2 ? t2 : 0.f), gm = t0 + t1;
        unsigned vw[8];
#pragma unroll
        for (int j = 0; j < 16; ++j) {
            const float Gt = G[j] + off, qv = bf2f(qq[j]), kf = 1.0f - __expf(lf[j]);
            const int t = 16 * p + j;
            QM[t * PQ + kk] = (bf16)f2bf(qv * __expf(Gt - gm));
            KM[t * PQ + kk] = (bf16)f2bf(kf * __expf(gm - Gt));
            Q0[t * PQ + kk] = (bf16)f2bf(qv * __expf(Gt));
        }
#pragma unroll
        for (int j = 0; j < 8; ++j) vw[j] = (unsigned)vv[2 * j] | ((unsigned)vv[2 * j + 1] << 16);
        *(LAS v4u*)(VT + kk * PT + 16 * p) = (v4u){vw[0], vw[1], vw[2], vw[3]}; *(LAS v4u*)(VT + kk * PT + 16 * p + 8) = (v4u){vw[4], vw[5], vw[6], vw[7]};
        __syncthreads();
        f32x4 P[4];
        bf16x8 qf[4];
#pragma unroll
        for (int kc = 0; kc < 4; ++kc) qf[kc] = *(const LAS bf16x8*)(QM + (16 * tt + l15) * PQ + 32 * kc + 8 * g);
#pragma unroll
        for (int st = 0; st < 4; ++st) {
            P[st] = (f32x4){0.f, 0.f, 0.f, 0.f};
            if (st <= tt) {
#pragma unroll
                for (int kc = 0; kc < 4; ++kc) { const bf16x8 a = *(const LAS bf16x8*)(KM + (16 * st + l15) * PQ + 32 * kc + 8 * g); P[st] = MFMA16(a, qf[kc], P[st]); }
                if (st == tt) {
#pragma unroll
                    for (int i = 0; i < 4; ++i) if (4 * g + i > l15) P[st][i] = 0.f; }
            }
        }
        f32x4 O[4];
        bf16x8 pf[2];
#pragma unroll
        for (int sp = 0; sp < 2; ++sp) { v4u w; w.x = pk2(P[2 * sp][0], P[2 * sp][1]); w.y = pk2(P[2 * sp][2], P[2 * sp][3]); w.z = pk2(P[2 * sp + 1][0], P[2 * sp + 1][1]); w.w = pk2(P[2 * sp + 1][2], P[2 * sp + 1][3]);
            pf[sp] = __builtin_bit_cast(bf16x8, w); }
#pragma unroll
        for (int kc = 0; kc < 4; ++kc) qf[kc] = *(const LAS bf16x8*)(Q0 + (16 * tt + l15) * PQ + 32 * kc + 8 * g);
#pragma unroll
        for (int j = 0; j < 4; ++j) {
            const int vrow = 64 * vh + 16 * j + l15;
            O[j] = (f32x4){0.f, 0.f, 0.f, 0.f};
#pragma unroll
            for (int sp = 0; sp < 2; ++sp) {
                if (2 * sp <= tt) {
                    const v2u lo = *(const LAS v2u*)(VT + vrow * PT + 32 * sp + 4 * g), hi = *(const LAS v2u*)(VT + vrow * PT + 32 * sp + 16 + 4 * g);
                    const bf16x8 a = __builtin_bit_cast(bf16x8, (v4u){lo.x, lo.y, hi.x, hi.y});
                    O[j] = MFMA16(a, pf[sp], O[j]);
                }
            }
#pragma unroll
            for (int kc = 0; kc < 4; ++kc) { const bf16x8 a = *(const LAS bf16x8*)(STL + vrow * PQ + 32 * kc + 8 * g); O[j] = MFMA16(a, qf[kc], O[j]); }
        }
        float ss = 0.f;
#pragma unroll
        for (int j = 0; j < 4; ++j) ss += (O[j][0] * O[j][0] + O[j][1] * O[j][1]) + (O[j][2] * O[j][2] + O[j][3] * O[j][3]);
        ss += __shfl_xor(ss, 16); ss += __shfl_xor(ss, 32);
        if (g == 0) red[vh * 64 + 16 * tt + l15] = ss;
        __syncthreads();
        const float tot = red[16 * tt + l15] + red[64 + 16 * tt + l15];
        const float rstd = __builtin_amdgcn_rsqf(tot * (1.0f / 128.0f) + EPS);
        const size_t orow = (rowu + 16 * tt + l15) * D + h * 128;
#pragma unroll
        for (int j = 0; j < 4; ++j) {
            const int v0 = 64 * vh + 16 * j + 4 * g;
            const f32x4 gw = *(const f32x4*)(gnw + v0); const v2u gs = *(const GAS v2u*)(GS + orow + v0);
            const float o0 = O[j][0] * rstd * gw[0] * __uint_as_float(gs.x << 16), o1 = O[j][1] * rstd * gw[1] * __uint_as_float(gs.x & 0xffff0000u);
            const float o2 = O[j][2] * rstd * gw[2] * __uint_as_float(gs.y << 16), o3 = O[j][3] * rstd * gw[3] * __uint_as_float(gs.y & 0xffff0000u);
            v2u o; o.x = pk2(o0, o1); o.y = pk2(o2, o3); *(GAS v2u*)(OUTB + orow + v0) = o;
        }
        __syncthreads();
    }
}
__device__ __forceinline__ void fox_fz_tail(int lane, int wave, const bf16* XN, const bf16* WfzT, const float* bf, float* LFS, const float* ssr, const float* bvec) {
    if (wave < 4) {
        const int g = lane >> 4, l15 = lane & 15; const int rbase = 64 * blockIdx.x + 16 * wave;
        for (int rb = rbase; rb < M; rb += 64 * gridDim.x) {
            f32x4 acc = (f32x4){0.f, 0.f, 0.f, 0.f};
            const bf16* ap = WfzT + l15 * D + 8 * g; const bf16* bp = XN + (size_t)(rb + l15) * D + 8 * g;
#pragma unroll 8
            for (int kc = 0; kc < 32; ++kc) { const bf16x8 a = *(const GAS bf16x8*)(ap + 32 * kc), bb = *(const GAS bf16x8*)(bp + 32 * kc); acc = MFMA16(a, bb, acc); }
            const int row = rb + l15, b = row >> 13, s = row & 8191;
            const float rstd = __builtin_amdgcn_rsqf(ssr[row] * (1.0f / 1024.0f) + EPS);
#pragma unroll
            for (int i = 0; i < 4; ++i) { const int hh = 4 * g + i; const float z = acc[i] * rstd + bvec[b * 4112 + hh] + bf[hh];
                const float lfv = z >= 0.f ? -log1pf(__expf(-z)) : z - log1pf(__expf(z));
                LFS[(size_t)(b * 16 + hh) * T + s] = lfv; }
        }
    }
}
__device__ __forceinline__ void fox_scan(LAS unsigned char* lds, int tid, int lane, int wave, const float* LFS, float* NF) {
    LAS float* wtot = (LAS float*)lds;
    for (int bh = blockIdx.x; bh < 32; bh += gridDim.x) {
        const f32x4* src = (const f32x4*)(LFS + (size_t)bh * T) + tid * 4;
        f32x4 v[4]; float run = 0.f;
#pragma unroll
        for (int j = 0; j < 4; ++j) { v[j] = src[j]; v[j].x += run; v[j].y += v[j].x; v[j].z += v[j].y; v[j].w += v[j].z; run = v[j].w; }
        float inc = run;
#pragma unroll
        for (int o = 1; o < 64; o <<= 1) { const float t = __shfl_up(inc, o); if (lane >= o) inc += t; }
        if (lane == 63) wtot[wave] = inc;
        __syncthreads();
        float off = inc - run;
        for (int w = 0; w < wave; ++w) off += wtot[w];
        const float c = -1.4426950408889634f;
        f32x4* dst = (f32x4*)(NF + (size_t)bh * T) + tid * 4;
#pragma unroll
        for (int j = 0; j < 4; ++j) dst[j] = (v[j] + off) * c;
        __syncthreads();
    }
}


#ifdef DIAG_HG
__device__ __forceinline__ void diag_hg_naive(LAS unsigned char* lds, int tid, const float* LF, const bf16* QOq, const bf16* V, const bf16* GS, const float* gnw, float* DB) {
    LAS float* fl = (LAS float*)lds; LAS float* kl = fl + 128; LAS float* ql = fl + 256; LAS float* ps = fl + 384; LAS float* os = fl + 896;
    const int v = tid & 127, kq = tid >> 7;
    float S[32];
#pragma unroll
    for (int i = 0; i < 32; ++i) S[i] = 0.f;
    for (int t = 0; t < 192; ++t) {
        if (tid < 128) { const float lf = LF[(size_t)t * 1024 + tid]; const float ff = __expf(lf); fl[tid] = ff; kl[tid] = 1.0f - ff; ql[tid] = bf2f(QOq[(size_t)t * 1024 + tid]); }
        __syncthreads();
        const float vt = bf2f(V[(size_t)t * 1024 + v]); float acc = 0.f;
#pragma unroll
        for (int i = 0; i < 32; ++i) { const int k_ = 32 * kq + i; S[i] = fl[k_] * S[i] + kl[k_] * vt; acc += S[i] * ql[k_]; }
        ps[kq * 128 + v] = acc;
        __syncthreads();
        if (tid < 128) os[tid] = ps[tid] + ps[128 + tid] + ps[256 + tid] + ps[384 + tid];
        __syncthreads();
        if (tid < 128) { float ss = 0.f; for (int i = 0; i < 128; ++i) ss += os[i] * os[i];
            DB[t * 128 + tid] = os[tid] * __builtin_amdgcn_rsqf(ss * (1.0f / 128.0f) + EPS) * gnw[tid] * bf2f(GS[(size_t)t * 1024 + tid]); }
        __syncthreads();
    }
}
__device__ __forceinline__ void diag_hg_cmp(LAS unsigned char* lds, int tid, const bf16* O, const float* DB, float* DG) {
    LAS float* r = (LAS float*)lds; float sd = 0.f, ss = 0.f;
    for (int idx = tid + DIAG_T0 * 128; idx < DIAG_T1 * 128; idx += NTHR) { const int t = idx >> 7, v = idx & 127; const float a = DB[idx], b = bf2f(O[(size_t)t * 1024 + v]); sd += (a - b) * (a - b); ss += a * a; }
    sd = wave_sum(sd); ss = wave_sum(ss);
    if ((tid & 63) == 0) { r[(tid >> 6) * 2] = sd; r[(tid >> 6) * 2 + 1] = ss; }
    __syncthreads();
    if (tid == 0) { float a = 0.f, b = 0.f; for (int w = 0; w < 8; ++w) { a += r[2 * w]; b += r[2 * w + 1]; } DG[0] = sqrtf(a / b); }
    __syncthreads();
}
#endif
#ifndef NO_GEMM
#define NO_GEMM 0
#endif
#ifndef REP_SYNC
#define REP_SYNC 1
#endif
#ifndef REP_NORM
#define REP_NORM 1
#endif
#ifndef REP_HGAB
#define REP_HGAB 1
#endif
#ifndef REP_GEMM
#define REP_GEMM 1
#endif
#ifndef REP_P0
#define REP_P0 1
#endif
#ifndef REP_SCAN
#define REP_SCAN 1
#endif
#ifndef ATT_THRL
#define ATT_THRL 96
#endif
#ifndef REP_ATT
#define REP_ATT 1
#endif
#ifndef REP_HGC
#define REP_HGC 1
#endif
#define RLX_AGENT __ATOMIC_RELAXED, __HIP_MEMORY_SCOPE_AGENT
#define XB_TMO      128
#define XB_XCNT(j)  (256  + 64 * (j))
#define XB_XSUB(j)  (1280 + 64 * (j))
#define XB_XGEN(j)  (2304 + 64 * (j))
#define XB_TOP      3328
#define XB_TOPGEN   3392
#define XCD_BAR_WORDS 3456
#define XB_SPIN_CAP (1u << 18)

__device__ __forceinline__ unsigned xb_ld(unsigned* p)              { return __hip_atomic_load(p, __ATOMIC_RELAXED, __HIP_MEMORY_SCOPE_AGENT); }
__device__ __forceinline__ unsigned xb_add(unsigned* p, unsigned v) { return __hip_atomic_fetch_add(p, v, __ATOMIC_RELAXED, __HIP_MEMORY_SCOPE_AGENT); }
__device__ __forceinline__ unsigned xb_xcc_id() { return (unsigned)__builtin_amdgcn_s_getreg((3 << 11) | 20) & 0xFu; }
#define XB_SPIN(cond, bar) do { unsigned _sp = 0; while (cond) { __builtin_amdgcn_s_sleep(1); \
    if ((++_sp & 255u) == 0u) { if (xb_ld(&(bar)[XB_TMO])) break; if (_sp > XB_SPIN_CAP) { atomicAdd(&(bar)[XB_TMO], 1u); break; } } } } while (0)

struct XcdBarrier {
    unsigned* bar; unsigned x;
    volatile LAS unsigned* st;
};

__device__ __forceinline__ XcdBarrier xcd_barrier_post(unsigned* bar, volatile LAS unsigned* st) {
    XcdBarrier b; b.bar = bar; b.x = xb_xcc_id(); b.st = st;
    if (threadIdx.x == 0) (void)xb_add(&bar[XB_XCNT(b.x)], 1u);
    return b;
}
__device__ __forceinline__ void xcd_barrier_complete(unsigned* bar, unsigned x, unsigned& nloc, unsigned& nx) {
    const unsigned G = gridDim.x * gridDim.y * gridDim.z;
    unsigned sum, cnt, mine, sp = 0u;
    for (;;) {
        sum = 0u; cnt = 0u; mine = 0u;
#pragma unroll
        for (unsigned j = 0; j < 16; ++j) { const unsigned c = xb_ld(&bar[XB_XCNT(j)]); sum += c; cnt += (c > 0u) ? 1u : 0u; mine = (j == x) ? c : mine; }
        if (sum == G) break;
        __builtin_amdgcn_s_sleep(1);
        if ((++sp & 255u) == 0u) { if (xb_ld(&bar[XB_TMO])) break; if (sp > XB_SPIN_CAP) { atomicAdd(&bar[XB_TMO], 1u); break; } }
    }
    nloc = mine > 0u ? mine : 1u; nx = cnt > 0u ? cnt : 1u;
}

__device__ __forceinline__ void xcd_barrier(const XcdBarrier& b) {
    asm volatile("s_waitcnt vmcnt(0)" ::: "memory");
    __syncthreads();
    if (threadIdx.x == 0) {
        unsigned* bar = b.bar;
        __builtin_amdgcn_s_waitcnt(0);
        unsigned nloc = b.st[0], nx = b.st[1];
        if (nloc == 0u) { xcd_barrier_complete(bar, b.x, nloc, nx); b.st[0] = nloc; b.st[1] = nx; }
        const unsigned old = xb_add(&bar[XB_XSUB(b.x)], 1u);
        const unsigned gen = old / nloc;
        if (old + 1u == (gen + 1u) * nloc) {
            __builtin_amdgcn_fence(__ATOMIC_RELEASE, "agent");
            asm volatile("s_waitcnt vmcnt(0)" ::: "memory");
            const unsigned og = xb_add(&bar[XB_TOP], 1u);
            const unsigned tg = og / nx;
            if (og + 1u == (tg + 1u) * nx) xb_add(&bar[XB_TOPGEN], 1u);
            else XB_SPIN(xb_ld(&bar[XB_TOPGEN]) == tg, bar);
            __builtin_amdgcn_fence(__ATOMIC_ACQUIRE, "agent");
            xb_add(&bar[XB_XGEN(b.x)], 1u);
            asm volatile("s_waitcnt vmcnt(0)" ::: "memory");
        } else {
            XB_SPIN(xb_ld(&bar[XB_XGEN(b.x)]) == gen, bar);
            __builtin_amdgcn_fence(__ATOMIC_ACQUIRE, "agent");
            asm volatile("s_waitcnt vmcnt(0)" ::: "memory");
        }
    }
    __syncthreads();
}

__global__ void __launch_bounds__(NTHR, 2) fwd_megakernel(Args args) {
    extern __shared__ __attribute__((aligned(16))) unsigned char lds_raw[];
    cg::grid_group grid = cg::this_grid();
    LAS unsigned char* lds = (LAS unsigned char*)lds_raw;
    const int tid = threadIdx.x, lane = tid & 63, wave = __builtin_amdgcn_readfirstlane(tid >> 6);
    const int G = gridDim.x, gw = blockIdx.x * NWAVES + wave, NGW = G * NWAVES;
    volatile LAS unsigned* MISC = (volatile LAS unsigned*)(lds + 131072 + 320);
    if (tid < 32) MISC[tid] = 0u;
    __syncthreads();
    XcdBarrier bar = xcd_barrier_post((unsigned*)(args.ws + WS_BAR), MISC + 8);
#define A_ws (args.ws)
#define A_x (args.in[0])
#define A_c (args.in[1])
#define A_w_mod (args.in[2])
#define A_b_mod (args.in[3])
#define A_norm1_w (args.in[4])
#define A_norm2_w (args.in[5])
#define A_hg_w_in (args.in[6])
#define A_hg_w_out (args.in[7])
#define A_hg_lb (args.in[8])
#define A_hg_gn_w (args.in[9])
#define A_fox_w_in (args.in[10])
#define A_fox_b_f (args.in[11])
#define A_fox_qn_w (args.in[12])
#define A_fox_kn_w (args.in[13])
#define A_fox_w_out (args.in[14])
#define A_mlp_w1 (args.in[15])
#define A_mlp_w2 (args.in[16])
#define A_final_w (args.in[17])
#define A_out (args.out)
#define MOD ((float*)(A_ws + WS_MOD))
#define LB ((float*)(A_ws + WS_LB))
#define WFZ ((bf16*)(A_ws + WS_WFZ))
#define DN ((float*)(A_ws + WS_DN))
#define LFS ((float*)(A_ws + WS_LFS))
#define NF ((float*)(A_ws + WS_NF))
#define QKNW ((float*)(A_ws + WS_QKNW))
#define W_HGIN ((bf16*)(A_ws + WS_W_HGIN))
#define W_HGOUT ((bf16*)(A_ws + WS_W_HGOUT))
#define W_FOXIN ((bf16*)(A_ws + WS_W_FOXIN))
#define W_FOXOUT ((bf16*)(A_ws + WS_W_FOXOUT))
#define W1_0 ((bf16*)(A_ws + WS_W1_0))
#define W2_0 ((bf16*)(A_ws + WS_W2_0))
#define W1_1 ((bf16*)(A_ws + WS_W1_1))
#define W2_1 ((bf16*)(A_ws + WS_W2_1))
#define XN ((bf16*)(A_ws + WS_XN))
#define QO ((bf16*)(A_ws + WS_QO))
#define B1 ((bf16*)(A_ws + WS_B1))
#define B2 ((bf16*)(A_ws + WS_B2))
#define B3 ((bf16*)(A_ws + WS_B3))
#define ST ((bf16*)(A_ws + WS_ST))
#define HB ((bf16*)(A_ws + WS_H))
#define XN2 ((bf16*)(A_ws + WS_XN2))
#define SSQ ((float*)(A_ws + WS_SS))
#define BIASV ((float*)(A_ws + WS_BIASV))
#define GSYNC() do { for (int rs_ = 0; rs_ < REP_SYNC; ++rs_) xcd_barrier(bar); } while (0)
#define GSYNC_CG() do { if (__builtin_expect(args.ws == nullptr, 0)) grid.sync(); xcd_barrier(bar); } while (0)
    for (int rp_ = 0; rp_ < REP_P0; ++rp_) {
        __syncthreads();
        LAS float* sc = (LAS float*)lds;
        LAS float* red = (LAS float*)(lds + 8192);
        for (int it = blockIdx.x; it < 192; it += G) {
            for (int i = tid; i < 2048; i += NTHR) { const float cv = A_c[i]; sc[i] = cv * pg8::sigmoid_f(cv); }
            __syncthreads();
            const int li = it / 96, cgp = it % 96, col = 64 * cgp + lane;
            const float* wp = A_w_mod + ((size_t)li * D + 128 * wave) * 6144 + col;
            float a0 = 0.f, a1 = 0.f;
            for (int k0 = 0; k0 < 128; k0 += 8) {
                float wv[8];
#pragma unroll
                for (int j = 0; j < 8; ++j) wv[j] = wp[(size_t)(k0 + j) * 6144];
#pragma unroll
                for (int j = 0; j < 8; ++j) { a0 += sc[128 * wave + k0 + j] * wv[j]; a1 += sc[1024 + 128 * wave + k0 + j] * wv[j]; }
            }
            red[wave * 128 + lane] = a0; red[wave * 128 + 64 + lane] = a1;
            __syncthreads();
            if (wave == 0) { float s0 = 0.f, s1 = 0.f;
#pragma unroll
                for (int w = 0; w < 8; ++w) { s0 += red[w * 128 + lane]; s1 += red[w * 128 + 64 + lane]; }
                const float bb = A_b_mod[li * 6144 + col];
                MOD[(li * 2 + 0) * 6144 + col] = s0 + bb; MOD[(li * 2 + 1) * 6144 + col] = s1 + bb; }
            __syncthreads();
        }
        if (blockIdx.x == G - 1) {
            for (int i = tid; i < 1024; i += NTHR) { const float a0 = A_hg_lb[i], a1 = A_hg_lb[1024 + i], a2 = A_hg_lb[2048 + i]; const float mx = fmaxf(a0, fmaxf(a1, a2));
                const float e0 = __expf(a0 - mx), e1 = __expf(a1 - mx), e2 = __expf(a2 - mx); LB[i] = e0 / (e0 + e1 + e2); }
        }
        if (blockIdx.x == G - 2) {
            for (int i = tid; i < 16 * 1024; i += NTHR) { const int hh = i >> 10, k = i & 1023; WFZ[i] = (bf16)f2bf(A_fox_w_in[(size_t)k * NIN_FOX + 4096 + hh]); }
            if (tid < 64) { QKNW[tid] = A_fox_qn_w[tid]; QKNW[64 + tid] = A_fox_kn_w[tid]; }
        }
        for (int i = blockIdx.x * NTHR + tid; i < 3 * M; i += G * NTHR) SSQ[i] = 0.f;
        LAS float* scr = (LAS float*)(lds + wave * 16384);
        constexpr int I_A = 16 * 128, I_B = 16 * 32, I_W2 = 64 * 32;
        constexpr int NITEMS = 2 * I_A + 2 * I_B + 2 * I_A + 2 * I_W2;
        for (int it = gw; it < NITEMS; it += NGW) {
            int r = it;
            if (r < I_A) { transpose_item<false>(A_hg_w_in, D, 4096, 4096, W_HGIN, scr, r, lane); continue; } r -= I_A;
            if (r < I_A) { transpose_item<true>(A_fox_w_in, D, NIN_FOX, 4096, W_FOXIN, scr, r, lane); continue; } r -= I_A;
            if (r < I_B) { transpose_item<false>(A_hg_w_out, D, D, D, W_HGOUT, scr, r, lane); continue; } r -= I_B;
            if (r < I_B) { transpose_item<false>(A_fox_w_out, D, D, D, W_FOXOUT, scr, r, lane); continue; } r -= I_B;
            if (r < I_A) { transpose_item<false>(A_mlp_w1, D, FF, FF, W1_0, scr, r, lane); continue; } r -= I_A;
            if (r < I_A) { transpose_item<false>(A_mlp_w1 + (size_t)D * FF, D, FF, FF, W1_1, scr, r, lane); continue; } r -= I_A;
            if (r < I_W2) { transpose_item<false>(A_mlp_w2, FF, D, D, W2_0, scr, r, lane); continue; } r -= I_W2;
            transpose_item<false>(A_mlp_w2 + (size_t)FF * D, FF, D, D, W2_1, scr, r, lane);
        }
    }
    GSYNC_CG();
#define GEMM_PHASE(MODE, Aptr, Bptr, Nn, Kk, EE) GEMM_PHASE_R(1, MODE, Aptr, Bptr, Nn, Kk, EE)
#define GEMM_PHASE_R(RR, MODE, Aptr, Bptr, Nn, Kk, EE) do { for (int rg_ = 0; rg_ < (RR); ++rg_) { pg8::Gemm g_{(const pg8::bf16_t*)(Aptr), (const pg8::bf16_t*)(Bptr), M, (Nn), (Kk)}; pg8::StaticOrder S_; S_.init(M, (Nn), G, (int)blockIdx.x); \
        if (!NO_GEMM) pg8::gemm_phase<pg8::Epi<MODE>, pg8::StaticOrder, true, true>(lds, g_, S_, EE); } } while (0)
    {
        const float* mod = MOD;
        for (int rn_ = 0; rn_ < REP_NORM; ++rn_) norm_rows(gw, NGW, lane, A_x, A_norm1_w, mod + 0, mod + 1024, XN, nullptr);
        for (int t = gw; t < 3 * 4096 + 16; t += NGW) {
            const int gi = t < 3 * 4096 ? t >> 12 : 1, n = t < 3 * 4096 ? (t & 4095) : 4096 + (t - 3 * 4096);
            const bf16* wrow = t >= 3 * 4096 ? WFZ + (size_t)(n - 4096) * D : (gi == 0 ? W1_0 : gi == 1 ? W_FOXIN : W1_1) + (size_t)n * D;
            const float* sh0 = MOD + (gi == 0 ? 3072 : gi == 1 ? 2 * 6144 : 2 * 6144 + 3072);
            float a0 = 0.f, a1 = 0.f;
#pragma unroll
            for (int hh = 0; hh < 2; ++hh) { const v4u wv = *(const GAS v4u*)(wrow + 512 * hh + 8 * lane);
#pragma unroll
                for (int e = 0; e < 4; ++e) { const int k = 512 * hh + 8 * lane + 2 * e; const float w0 = __uint_as_float(wv[e] << 16), w1 = __uint_as_float(wv[e] & 0xffff0000u);
                    a0 += sh0[k] * w0 + sh0[k + 1] * w1; a1 += sh0[6144 + k] * w0 + sh0[6144 + k + 1] * w1; } }
            a0 = wave_sum(a0); a1 = wave_sum(a1);
            if (lane == 0) { BIASV[(gi * 2 + 0) * 4112 + n] = a0; BIASV[(gi * 2 + 1) * 4112 + n] = a1; }
        }
        GSYNC();
        { pg8::Epi<pg8::EPI_HG_IN> E{QO, A_out  , nullptr, LB, 1.f, nullptr, nullptr, nullptr, nullptr, nullptr, nullptr};
          GEMM_PHASE_R(REP_GEMM, pg8::EPI_HG_IN, XN, W_HGIN, 4096, D, E); }
        GSYNC();
        for (int rh_ = 0; rh_ < REP_HGAB; ++rh_) {
        if (rh_) GSYNC();
        hg_pass_a(lds, tid, lane, wave, A_out, B1, ST, DN);
        GSYNC();
        hg_pass_b(tid, ST, DN);
        }
#ifdef DIAG_HG
        if (blockIdx.x == 0) diag_hg_naive(lds, tid, A_out, QO, B1, B2, A_hg_gn_w, (float*)(A_ws + WS_XN));
#endif
        GSYNC();
#ifndef NO_HGC
        for (int rc_ = 0; rc_ < REP_HGC; ++rc_) hg_pass_c(lds, tid, lane, wave, A_out, QO, XN, B1, B2, ST, A_hg_gn_w);
#endif
        GSYNC();
#ifdef DIAG_HG
        if (blockIdx.x == 0) diag_hg_cmp(lds, tid, QO, (const float*)(A_ws + WS_XN), (float*)(A_ws + WS_QKNW + 1024));
#endif
        { pg8::Epi<pg8::EPI_RES> E{nullptr, A_out, A_x, mod + 2048, 1.f, XN2, SSQ + 0 * M, A_norm2_w, mod + 4096, nullptr, nullptr};
          GEMM_PHASE_R(REP_GEMM, pg8::EPI_RES, XN, W_HGOUT, D, D, E); }
        GSYNC();
        { pg8::Epi<pg8::EPI_RELU2> E{HB, nullptr, nullptr, nullptr, 1.f, nullptr, nullptr, nullptr, nullptr, SSQ + 0 * M, BIASV + 0 * 2 * 4112};
          GEMM_PHASE_R(REP_GEMM, pg8::EPI_RELU2, XN2, W1_0, FF, D, E); }
        GSYNC();
        { pg8::Epi<pg8::EPI_RES> E{nullptr, A_out, A_out, mod + 5120, 1.f, XN, SSQ + 1 * M, A_norm1_w + D, MOD + 2 * 6144 + 1024, nullptr, nullptr};
          GEMM_PHASE(pg8::EPI_RES, HB, W2_0, D, FF, E); }
        GSYNC();
    }
    {
        const float* mod = MOD + 2 * 6144;
        { pg8::Epi<pg8::EPI_FOX_IN> E{QO, nullptr, nullptr, QKNW, attn_body::C2, nullptr, nullptr, nullptr, nullptr, SSQ + 1 * M, BIASV + 1 * 2 * 4112};
          GEMM_PHASE_R(REP_GEMM, pg8::EPI_FOX_IN, XN, W_FOXIN, 4096, D, E); }
        for (int rz_ = 0; rz_ < REP_SCAN; ++rz_) fox_fz_tail(lane, wave, XN, WFZ, A_fox_b_f, LFS, SSQ + 1 * M, BIASV + 1 * 2 * 4112 + 4096);
        GSYNC();
        { const attn_body::AttnTensors AT{(const attn_body::bf16*)QO, (const attn_body::bf16*)B1, (const attn_body::bf16*)B2, (attn_body::bf16*)XN, LFS  , (const attn_body::bf16*)B3};
          const attn_body::StaticOrder S((int)G, (int)blockIdx.x);
#ifndef NO_ATTN
          for (int ra_ = 0; ra_ < REP_ATT; ++ra_) attn_body::attn_phase<attn_body::StaticOrder, ATT_THRL>((char*)lds_raw, AT, S);
#endif
        }
        GSYNC();
        { pg8::Epi<pg8::EPI_RES> E{nullptr, A_out, A_out, mod + 2048, 1.f, XN2, SSQ + 2 * M, A_norm2_w + D, mod + 4096, nullptr, nullptr};
          GEMM_PHASE(pg8::EPI_RES, XN, W_FOXOUT, D, D, E); }
        GSYNC();
        { pg8::Epi<pg8::EPI_RELU2> E{HB, nullptr, nullptr, nullptr, 1.f, nullptr, nullptr, nullptr, nullptr, SSQ + 2 * M, BIASV + 2 * 2 * 4112};
          GEMM_PHASE_R(REP_GEMM, pg8::EPI_RELU2, XN2, W1_1, FF, D, E); }
        GSYNC();
        { pg8::Epi<pg8::EPI_RES> E{nullptr, A_out, A_out, mod + 5120, 1.f, nullptr, nullptr, nullptr, nullptr, nullptr, nullptr};
          GEMM_PHASE(pg8::EPI_RES, HB, W2_1, D, FF, E); }
        GSYNC();
    }
    norm_rows(gw, NGW, lane, A_out, A_final_w, nullptr, nullptr, nullptr, A_out);
#if defined(DIAG_HG) || defined(DIAG_ATT)
    GSYNC();
    if (blockIdx.x == 0 && tid == 0) A_out[0] = 1000.0f * (20.0f + log2f(*(const float*)(A_ws + WS_QKNW + 1024) + 1e-9f));
#endif
}

#undef A_ws
#undef A_x
#undef A_c
#undef A_w_mod
#undef A_b_mod
#undef A_norm1_w
#undef A_norm2_w
#undef A_hg_w_in
#undef A_hg_w_out
#undef A_hg_lb
#undef A_hg_gn_w
#undef A_fox_w_in
#undef A_fox_b_f
#undef A_fox_qn_w
#undef A_fox_kn_w
#undef A_fox_w_out
#undef A_mlp_w1
#undef A_mlp_w2
#undef A_final_w
#undef A_out
extern "C" void kernel_launch(void* const* d_in, const int* in_sizes, int n_in, void* d_out, int out_size, void* d_ws, size_t ws_size, hipStream_t stream) {
    static int grid = 0;
    if (grid == 0) {
        if (n_in != 18 || out_size != M * D || ws_size < WS_END) { fprintf(stderr, "kernel_launch: unexpected shapes (n_in %d, out %d, ws %zu)\n", n_in, out_size, ws_size); grid = -1; return; }
        int dev = 0, cus = 0, per_cu = 0;
        hipGetDevice(&dev); hipDeviceGetAttribute(&cus, hipDeviceAttributeMultiprocessorCount, dev);
        if (hipFuncSetAttribute((const void*)fwd_megakernel, hipFuncAttributeMaxDynamicSharedMemorySize, LDS_BYTES) != hipSuccess) { fprintf(stderr, "kernel_launch: hipFuncSetAttribute failed\n"); grid = -1; return; }
        if (hipOccupancyMaxActiveBlocksPerMultiprocessor(&per_cu, (const void*)fwd_megakernel, NTHR, LDS_BYTES) != hipSuccess || per_cu < 1) { fprintf(stderr, "kernel_launch: occupancy query says %d\n", per_cu); per_cu = 1; }
        (void)hipGetLastError();
        grid = cus * 1;
        if (grid != 256) fprintf(stderr, "kernel_launch: %d CUs; built for 256\n", grid);
    }
    if (grid < 0) return;
    if (hipMemsetAsync((char*)d_ws + WS_BAR, 0, BAR_BYTES, stream) != hipSuccess) { fprintf(stderr, "kernel_launch: memset of the barrier words failed\n"); return; }
    Args a{};
    for (int i = 0; i < 18; ++i) a.in[i] = (const float*)d_in[i];
    a.out = (float*)d_out; a.ws = (unsigned char*)d_ws;
    void* kargs[] = {&a};
    hipError_t e = hipLaunchCooperativeKernel((const void*)fwd_megakernel, dim3(grid), dim3(NTHR), kargs, LDS_BYTES, stream);
    if (e != hipSuccess) fprintf(stderr, "cooperative launch failed: %s (grid %d)\n", hipGetErrorString(e), grid);
}
```

```cpp
#include <hip/hip_runtime.h>
#include <hip/hip_cooperative_groups.h>
#include <cstdio>
#include <cstdint>
namespace cg = cooperative_groups;
namespace pg8 {
#define PG8_LAS __attribute__((address_space(3)))
typedef unsigned short bf16_t;
typedef short bf16x8 __attribute__((ext_vector_type(8)));
typedef float f32x4 __attribute__((ext_vector_type(4)));
typedef unsigned u32x4 __attribute__((ext_vector_type(4)));
constexpr int BM = 256, BK = 64, HALF = 128, HTB = HALF * BK * 2  , STAGE_BYTES = 8 * HTB, NXCD = 8, WGM = 8;

__host__ __device__ __forceinline__ int lds_byte(int r, int c) { const int st = (r >> 4) * 2 + (c >> 5), rr = r & 15, cc = c & 31, ob = rr * 64 + cc * 2; return st * 1024 + (ob ^ (((ob >> 9) & 1) << 5)); }
__host__ __device__ __forceinline__ void stage_rc(int b, int& R, int& C) { const int st = b / 1024, sb = b % 1024, swz = sb ^ (((sb >> 9) & 1) << 5); R = (st >> 1) * 16 + swz / 64; C = (st & 1) * 32 + (swz % 64) / 2; }
__host__ __device__ __forceinline__ int perm32(int rho) { const int n = rho >> 4, i = rho & 15; return 8 * (i >> 2) + 4 * n + (i & 3); }

struct Unit { int pm, pn; };
struct Gemm { const bf16_t* A; const bf16_t* Bt; int M, N, K; };

struct StaticOrder {
    int nM, nN, nwg, G, c;
    __host__ __device__ void init(int M, int N, int G_, int c_) { nM = M / BM; nN = N / BM; nwg = nM * nN; G = G_; c = c_; }
    __host__ __device__ bool next(int i, Unit& u) const {
        const long L = (long)i * G + c; if (L >= nwg) return false;
        int wgid = (int)L; { const int q = nwg / NXCD, r = nwg % NXCD, xcd = wgid % NXCD, off = wgid / NXCD; wgid = (xcd < r ? xcd * (q + 1) : r * (q + 1) + (xcd - r) * q) + off; }
        const int nig = WGM * nN, gid = wgid / nig, fm = gid * WGM, gsz = (nM - fm) < WGM ? (nM - fm) : WGM;
        u.pm = fm + ((wgid % nig) % gsz); u.pn = (wgid % nig) / gsz; return true;
    }
    __device__ __forceinline__ void a_ready(const Unit&) const {}
    __device__ __forceinline__ void done(const Unit&) const {}
};

typedef float f32x2_cv __attribute__((ext_vector_type(2))); typedef __bf16 bf16x2_cv __attribute__((ext_vector_type(2)));
__device__ __forceinline__ unsigned cvt_pk_bf16(float lo, float hi) { f32x2_cv v = {lo, hi}; bf16x2_cv b = __builtin_convertvector(v, bf16x2_cv); return __builtin_bit_cast(unsigned, b); }
typedef float f32x2 __attribute__((ext_vector_type(2)));
enum { EPI_HG_IN = 0, EPI_FOX_IN = 1, EPI_RES = 2, EPI_RELU2 = 3 };
__device__ __forceinline__ float sigmoid_f(float z) { return __builtin_amdgcn_rcpf(1.0f + __expf(-z)); }
template <int MODE> struct Epi {
    static constexpr bool PERM = true, AFTER_DRAIN = false;
    bf16_t* o0;
    static constexpr size_t OSTR = (size_t)16 * 1024 * 1024;
    float* f0;
    const float* base;
    const float* p0;
    float qscale;
    bf16_t* xs; float* ss; const float* wn; const float* scp;
    const float* ssr; const float* bvec;
    __device__ __forceinline__ void row_rstd(float (&rs)[2][4], int row0) const {
#pragma unroll
        for (int ai = 0; ai < 2; ++ai)
#pragma unroll
            for (int m = 0; m < 4; ++m) rs[ai][m] = ssr ? __builtin_amdgcn_rsqf(ssr[row0 + ai * HALF + m * 16] * (1.0f / 1024.0f) + 1e-6f) : 1.0f;
    }
    __device__ __forceinline__ void operator()(const f32x4 (&acc)[2][2][4][2], const Unit& u, int wr, int wc, int fr, int fq) const {
        const int row0 = u.pm * BM + wr * 64 + fr;
        if constexpr (MODE == EPI_HG_IN) {
            const int seg = u.pn >> 2, col0 = (u.pn & 3) * BM + wc * 32 + 8 * fq;
            if (seg == 1) {
                f32x4 lbv[2][2];
#pragma unroll
                for (int bj = 0; bj < 2; ++bj)
#pragma unroll
                    for (int n = 0; n < 2; ++n) lbv[bj][n] = *(const f32x4*)(p0 + col0 + bj * HALF + 4 * n);
#pragma unroll
                for (int ai = 0; ai < 2; ++ai)
#pragma unroll
                    for (int m = 0; m < 4; ++m) { float* rowp = f0 + (size_t)(row0 + ai * HALF + m * 16) * 1024 + col0;
#pragma unroll
                        for (int bj = 0; bj < 2; ++bj)
#pragma unroll
                            for (int n = 0; n < 2; ++n) { const f32x4 z = acc[ai][bj][m][n], lb = lbv[bj][n]; f32x4 o;
#pragma unroll
                                for (int e = 0; e < 4; ++e) o[e] = __logf(lb[e] + (1.0f - lb[e]) * sigmoid_f(z[e]));
                                *(f32x4*)(rowp + bj * HALF + 4 * n) = o; } }
            } else {
                bf16_t* ob = o0 + (size_t)(seg == 0 ? 0 : seg - 1) * OSTR;
#pragma unroll
                for (int ai = 0; ai < 2; ++ai)
#pragma unroll
                    for (int m = 0; m < 4; ++m) { bf16_t* rowp = ob + (size_t)(row0 + ai * HALF + m * 16) * 1024 + col0;
#pragma unroll
                        for (int bj = 0; bj < 2; ++bj) { f32x4 v0 = acc[ai][bj][m][0], v1 = acc[ai][bj][m][1];
                            if (seg != 2) {
#pragma unroll
                                for (int e = 0; e < 4; ++e) { v0[e] = v0[e] * sigmoid_f(v0[e]); v1[e] = v1[e] * sigmoid_f(v1[e]); } }
                            u32x4 w; w.x = cvt_pk_bf16(v0[0], v0[1]); w.y = cvt_pk_bf16(v0[2], v0[3]); w.z = cvt_pk_bf16(v1[0], v1[1]); w.w = cvt_pk_bf16(v1[2], v1[3]);
                            *(u32x4*)(rowp + bj * HALF) = w; } }
            }
        } else if constexpr (MODE == EPI_FOX_IN) {
            const int seg = u.pn >> 2, colt = (u.pn & 3) * BM;
            float rs[2][4]; row_rstd(rs, row0);
            f32x4 bb[2][2];
#pragma unroll
            for (int bj = 0; bj < 2; ++bj)
#pragma unroll
                for (int n = 0; n < 2; ++n) bb[bj][n] = bvec ? *(const f32x4*)(bvec + (size_t)(u.pm >> 5) * 4112 + u.pn * BM + bj * HALF + wc * 32 + 8 * fq + 4 * n) : (f32x4){0.f, 0.f, 0.f, 0.f};
#define ACCV(ai, bj, m, n) (acc[ai][bj][m][n] * rs[ai][m] + bb[bj][n])
            if (seg <= 1) {
                const float* w = p0 + 64 * seg; const float sc = seg == 0 ? qscale : 1.0f; bf16_t* ob = o0 + (size_t)seg * OSTR;
                f32x4 wv[2][2];
#pragma unroll
                for (int bj = 0; bj < 2; ++bj)
#pragma unroll
                    for (int n = 0; n < 2; ++n) wv[bj][n] = *(const f32x4*)(w + 32 * bj + 8 * fq + 4 * n);
#pragma unroll
                for (int ai = 0; ai < 2; ++ai)
#pragma unroll
                    for (int m = 0; m < 4; ++m) { float ss = 0.f;
#pragma unroll
                        for (int bj = 0; bj < 2; ++bj)
#pragma unroll
                            for (int n = 0; n < 2; ++n) { const f32x4 x = ACCV(ai, bj, m, n); ss += (x[0] * x[0] + x[1] * x[1]) + (x[2] * x[2] + x[3] * x[3]); }
                        ss += __shfl_xor(ss, 16); ss += __shfl_xor(ss, 32);
                        const float rsn = __builtin_amdgcn_rsqf(ss * (1.0f / 64.0f) + 1e-6f) * sc;
                        bf16_t* rowp = ob + (size_t)(row0 + ai * HALF + m * 16) * 1024 + colt + 64 * wc + 8 * fq;
#pragma unroll
                        for (int bj = 0; bj < 2; ++bj) { const f32x4 v0 = ACCV(ai, bj, m, 0) * rsn * wv[bj][0], v1 = ACCV(ai, bj, m, 1) * rsn * wv[bj][1];
                            u32x4 ww; ww.x = cvt_pk_bf16(v0[0], v0[1]); ww.y = cvt_pk_bf16(v0[2], v0[3]); ww.z = cvt_pk_bf16(v1[0], v1[1]); ww.w = cvt_pk_bf16(v1[2], v1[3]);
                            *(u32x4*)(rowp + 32 * bj) = ww; } }
            } else {
                bf16_t* ob = o0 + (size_t)seg * OSTR; const int col0 = colt + wc * 32 + 8 * fq;
#pragma unroll
                for (int ai = 0; ai < 2; ++ai)
#pragma unroll
                    for (int m = 0; m < 4; ++m) { bf16_t* rowp = ob + (size_t)(row0 + ai * HALF + m * 16) * 1024 + col0;
#pragma unroll
                        for (int bj = 0; bj < 2; ++bj) { f32x4 v0 = ACCV(ai, bj, m, 0), v1 = ACCV(ai, bj, m, 1);
                            if (seg == 3) {
#pragma unroll
                                for (int e = 0; e < 4; ++e) { v0[e] = sigmoid_f(v0[e]); v1[e] = sigmoid_f(v1[e]); } }
                            u32x4 w; w.x = cvt_pk_bf16(v0[0], v0[1]); w.y = cvt_pk_bf16(v0[2], v0[3]); w.z = cvt_pk_bf16(v1[0], v1[1]); w.w = cvt_pk_bf16(v1[2], v1[3]);
                            *(u32x4*)(rowp + bj * HALF) = w; } }
            }
#undef ACCV
        } else if constexpr (MODE == EPI_RES) {
            const int col0 = u.pn * BM + wc * 32 + 8 * fq; const float* gp = p0 + (size_t)(u.pm >> 5) * 6144 + col0;
            f32x4 gv[2][2], wm[2][2];
#pragma unroll
            for (int bj = 0; bj < 2; ++bj)
#pragma unroll
                for (int n = 0; n < 2; ++n) { gv[bj][n] = *(const f32x4*)(gp + bj * HALF + 4 * n);
                    wm[bj][n] = xs ? *(const f32x4*)(wn + col0 + bj * HALF + 4 * n) * (*(const f32x4*)(scp + (size_t)(u.pm >> 5) * 6144 + col0 + bj * HALF + 4 * n) + 1.0f) : (f32x4){0.f, 0.f, 0.f, 0.f}; }
#pragma unroll
            for (int ai = 0; ai < 2; ++ai)
#pragma unroll
                for (int m = 0; m < 4; ++m) { const size_t off = (size_t)(row0 + ai * HALF + m * 16) * 1024 + col0; float q = 0.f;
#pragma unroll
                    for (int bj = 0; bj < 2; ++bj) { const f32x4 bs0 = *(const f32x4*)(base + off + bj * HALF), bs1 = *(const f32x4*)(base + off + bj * HALF + 4);
                        const f32x4 x0 = bs0 + gv[bj][0] * acc[ai][bj][m][0], x1 = bs1 + gv[bj][1] * acc[ai][bj][m][1];
                        *(f32x4*)(f0 + off + bj * HALF) = x0; *(f32x4*)(f0 + off + bj * HALF + 4) = x1;
                        if (xs) {
                            q += (x0[0] * x0[0] + x0[1] * x0[1]) + (x0[2] * x0[2] + x0[3] * x0[3]) + (x1[0] * x1[0] + x1[1] * x1[1]) + (x1[2] * x1[2] + x1[3] * x1[3]);
                            const f32x4 y0 = x0 * wm[bj][0], y1 = x1 * wm[bj][1];
                            u32x4 w; w.x = cvt_pk_bf16(y0[0], y0[1]); w.y = cvt_pk_bf16(y0[2], y0[3]); w.z = cvt_pk_bf16(y1[0], y1[1]); w.w = cvt_pk_bf16(y1[2], y1[3]);
                            *(u32x4*)(xs + off + bj * HALF) = w; } }
                    if (xs) { q += __shfl_xor(q, 16); q += __shfl_xor(q, 32);
                        if (fq == 0) atomicAdd(ss + row0 + ai * HALF + m * 16, q); } }
        } else {
            const int col0 = u.pn * BM + wc * 32 + 8 * fq;
            float rs[2][4]; row_rstd(rs, row0);
            f32x4 bb[2][2];
#pragma unroll
            for (int bj = 0; bj < 2; ++bj)
#pragma unroll
                for (int n = 0; n < 2; ++n) bb[bj][n] = bvec ? *(const f32x4*)(bvec + (size_t)(u.pm >> 5) * 4112 + col0 + bj * HALF + 4 * n) : (f32x4){0.f, 0.f, 0.f, 0.f};
#pragma unroll
            for (int ai = 0; ai < 2; ++ai)
#pragma unroll
                for (int m = 0; m < 4; ++m) { bf16_t* rowp = o0 + (size_t)(row0 + ai * HALF + m * 16) * 4096 + col0;
#pragma unroll
                    for (int bj = 0; bj < 2; ++bj) { f32x4 v0 = acc[ai][bj][m][0] * rs[ai][m] + bb[bj][0], v1 = acc[ai][bj][m][1] * rs[ai][m] + bb[bj][1];
#pragma unroll
                        for (int e = 0; e < 4; ++e) { const float a = fmaxf(v0[e], 0.f), b = fmaxf(v1[e], 0.f); v0[e] = a * a; v1[e] = b * b; }
                        u32x4 w; w.x = cvt_pk_bf16(v0[0], v0[1]); w.y = cvt_pk_bf16(v0[2], v0[3]); w.z = cvt_pk_bf16(v1[0], v1[1]); w.w = cvt_pk_bf16(v1[2], v1[3]);
                        *(u32x4*)(rowp + bj * HALF) = w; } }
        }
    }
};
template <class Epi, class Sched, bool ALIGN_EPI = false, bool SP2 = false>
__device__ __forceinline__ void gemm_phase(PG8_LAS unsigned char* lds, const Gemm g, const Sched& S, const Epi& E) {
    int tid_ = threadIdx.x; asm volatile("" : "+v"(tid_));
    const int tid = tid_, wid = __builtin_amdgcn_readfirstlane(tid >> 6), lane = tid & 63, wr = wid >> 2, wc = wid & 3, fr = lane & 15, fq = lane >> 4;
    const int K = g.K, nt = K / BK;
    unsigned voffA[2], voffB[2];
#pragma unroll
    for (int i = 0; i < 2; ++i) { int R, C; stage_rc(tid * 16 + i * 8192, R, C); const int Rb = Epi::PERM ? ((R & ~31) + perm32(R & 31)) : R;
        voffA[i] = (unsigned)(R * K + C) * 2u; voffB[i] = (unsigned)(Rb * K + C) * 2u; }
    const size_t kstep = (size_t)(BK * 2);
    const size_t hstep = (size_t)HALF * K * 2;
    const size_t tstep = 2 * hstep;
    const unsigned ldsw = (unsigned)wid * 1024u;
    const int aoff = lds_byte(wr * 64 + fr, fq * 8), boff = lds_byte(wc * 32 + fr, fq * 8);
#define PG8_SA(b, h) (((b) * 2 + (h)) * HTB)
#define PG8_SB(b, h) ((4 + (b) * 2 + (h)) * HTB)
#define PG8_STAGE(bufoff, gbase, voff) do { _Pragma("unroll") for (int _i = 0; _i < 2; ++_i) \
        __builtin_amdgcn_global_load_lds((const unsigned*)((const char*)(gbase) + (voff)[_i]), (PG8_LAS unsigned*)(lds + (bufoff) + ldsw + _i * 8192), 16, 0, 0); } while (0)
#define PG8_LDA(dst, b, h) do { _Pragma("unroll") for (int m = 0; m < 4; ++m) _Pragma("unroll") for (int k = 0; k < 2; ++k) dst[m][k] = *(const PG8_LAS bf16x8*)(lds + PG8_SA(b, h) + aoff + m * 2048 + k * 1024); } while (0)
#define PG8_LDB(dst, b, h) do { _Pragma("unroll") for (int n = 0; n < 2; ++n) _Pragma("unroll") for (int k = 0; k < 2; ++k) dst[n][k] = *(const PG8_LAS bf16x8*)(lds + PG8_SB(b, h) + boff + n * 2048 + k * 1024); } while (0)
#define PG8_MMA(ai, bj, At, Bt) do { __builtin_amdgcn_s_setprio(1); _Pragma("unroll") for (int m = 0; m < 4; ++m) _Pragma("unroll") for (int n = 0; n < 2; ++n) _Pragma("unroll") for (int k = 0; k < 2; ++k) \
        acc[ai][bj][m][n] = __builtin_amdgcn_mfma_f32_16x16x32_bf16(Bt[n][k], At[m][k], acc[ai][bj][m][n], 0, 0, 0); __builtin_amdgcn_s_setprio(0); } while (0)
#define PG8_WAIT_V(n) asm volatile("s_waitcnt vmcnt(" #n ")" ::: "memory")
#define PG8_WAIT_L(n) asm volatile("s_waitcnt lgkmcnt(" #n ")" ::: "memory")
#define PG8_BAR __builtin_amdgcn_s_barrier()
#define PG8_SCHED __builtin_amdgcn_sched_barrier(0)
    Unit cur, nxt; int ui = 0;
    if (!S.next(0, cur)) return;
    f32x4 acc[2][2][4][2];
#pragma unroll
    for (int a = 0; a < 2; ++a)
#pragma unroll
        for (int b = 0; b < 2; ++b)
#pragma unroll
            for (int m = 0; m < 4; ++m)
#pragma unroll
                for (int n = 0; n < 2; ++n) acc[a][b][m][n] = (f32x4){0.f, 0.f, 0.f, 0.f};
    bf16x8 At[4][2], B0[2][2], B1[2][2];
    const char* cA = (const char*)g.A + (size_t)cur.pm * tstep; const char* cB = (const char*)g.Bt + (size_t)cur.pn * tstep;
    S.a_ready(cur);
    if constexpr (SP2) {
        PG8_STAGE(PG8_SB(0, 0), cB, voffB); PG8_STAGE(PG8_SB(0, 1), cB + hstep, voffB); PG8_STAGE(PG8_SA(0, 0), cA, voffA); PG8_STAGE(PG8_SA(0, 1), cA + hstep, voffA);
        if (wr == 1) PG8_BAR;
        PG8_WAIT_V(2); PG8_BAR;
        PG8_STAGE(PG8_SB(1, 0), cB + kstep, voffB); PG8_STAGE(PG8_SA(1, 0), cA + kstep, voffA); PG8_STAGE(PG8_SB(1, 1), cB + hstep + kstep, voffB);
        PG8_WAIT_V(6); PG8_BAR;
    } else {
        PG8_STAGE(PG8_SB(0, 0), cB, voffB); PG8_STAGE(PG8_SA(0, 0), cA, voffA); PG8_STAGE(PG8_SB(0, 1), cB + hstep, voffB); PG8_STAGE(PG8_SA(0, 1), cA + hstep, voffA);
        if (wr == 1) PG8_BAR;
        PG8_WAIT_V(4); PG8_BAR;
        PG8_STAGE(PG8_SB(1, 0), cB + kstep, voffB); PG8_STAGE(PG8_SA(1, 0), cA + kstep, voffA); PG8_STAGE(PG8_SB(1, 1), cB + hstep + kstep, voffB);
        PG8_WAIT_V(6); PG8_BAR;
    }
    for (;;) {
        const bool has_next = S.next(ui + 1, nxt);
        const char* nA = has_next ? (const char*)g.A + (size_t)nxt.pm * tstep : cA; const char* nB = has_next ? (const char*)g.Bt + (size_t)nxt.pn * tstep : cB;
        for (int t = 0; t < nt; t += 2) {
            const bool last = (t == nt - 2);
            const char* a1 = cA + (size_t)(t + 1) * kstep;
            const char* a2 = last ? nA : cA + (size_t)(t + 2) * kstep; const char* b2 = last ? nB : cB + (size_t)(t + 2) * kstep;
            const char* a3 = a2 + kstep; const char* b3 = b2 + kstep;
            if (last && has_next) S.a_ready(nxt);
            if constexpr (SP2) {
            PG8_LDB(B0, 0, 0); PG8_LDB(B1, 0, 1); PG8_SCHED; PG8_LDA(At, 0, 0); PG8_STAGE(PG8_SA(1, 1), a1 + hstep, voffA);
            PG8_WAIT_V(8); PG8_WAIT_L(0); PG8_BAR; PG8_MMA(0, 0, At, B0); PG8_MMA(0, 1, At, B1); PG8_BAR; PG8_SCHED;
            PG8_LDA(At, 0, 1); PG8_STAGE(PG8_SB(0, 0), b2, voffB); PG8_STAGE(PG8_SB(0, 1), b2 + hstep, voffB); PG8_STAGE(PG8_SA(0, 0), a2, voffA);
            PG8_WAIT_V(8); PG8_WAIT_L(0); PG8_BAR; PG8_MMA(1, 0, At, B0); PG8_MMA(1, 1, At, B1); PG8_BAR; PG8_SCHED;
            PG8_LDB(B0, 1, 0); PG8_LDB(B1, 1, 1); PG8_SCHED; PG8_LDA(At, 1, 0); PG8_STAGE(PG8_SA(0, 1), a2 + hstep, voffA);
            PG8_WAIT_V(8); PG8_WAIT_L(0); PG8_BAR; PG8_MMA(0, 0, At, B0); PG8_MMA(0, 1, At, B1); PG8_BAR; PG8_SCHED;
            PG8_LDA(At, 1, 1); PG8_STAGE(PG8_SB(1, 0), b3, voffB); PG8_STAGE(PG8_SB(1, 1), b3 + hstep, voffB); PG8_STAGE(PG8_SA(1, 0), a3, voffA);
            PG8_WAIT_V(8); PG8_WAIT_L(0); PG8_BAR; PG8_MMA(1, 0, At, B0); PG8_MMA(1, 1, At, B1); PG8_BAR; PG8_SCHED;
            } else {
            PG8_LDB(B0, 0, 0); PG8_SCHED; PG8_LDA(At, 0, 0); PG8_STAGE(PG8_SA(1, 1), a1 + hstep, voffA);
            PG8_WAIT_L(8); PG8_BAR; PG8_WAIT_L(0); PG8_MMA(0, 0, At, B0); PG8_BAR; PG8_SCHED;
            PG8_LDB(B1, 0, 1); PG8_STAGE(PG8_SB(0, 0), b2, voffB);
            PG8_BAR; PG8_WAIT_L(0); PG8_MMA(0, 1, At, B1); PG8_BAR;
            PG8_LDA(At, 0, 1); PG8_STAGE(PG8_SA(0, 0), a2, voffA);
            PG8_BAR; PG8_WAIT_L(0); PG8_MMA(1, 0, At, B0); PG8_BAR; PG8_SCHED;
            PG8_STAGE(PG8_SB(0, 1), b2 + hstep, voffB);
            PG8_WAIT_V(6); PG8_BAR; PG8_MMA(1, 1, At, B1); PG8_BAR;
            PG8_LDB(B0, 1, 0); PG8_SCHED; PG8_LDA(At, 1, 0); PG8_STAGE(PG8_SA(0, 1), a2 + hstep, voffA);
            PG8_WAIT_L(8); PG8_BAR; PG8_WAIT_L(0); PG8_MMA(0, 0, At, B0); PG8_BAR; PG8_SCHED;
            PG8_LDB(B1, 1, 1); PG8_STAGE(PG8_SB(1, 0), b3, voffB);
            PG8_BAR; PG8_WAIT_L(0); PG8_MMA(0, 1, At, B1); PG8_BAR;
            PG8_LDA(At, 1, 1); PG8_STAGE(PG8_SA(1, 0), a3, voffA);
            PG8_BAR; PG8_WAIT_L(0); PG8_MMA(1, 0, At, B0); PG8_BAR; PG8_SCHED;
            PG8_STAGE(PG8_SB(1, 1), b3 + hstep, voffB);
            PG8_WAIT_V(6); PG8_BAR; PG8_MMA(1, 1, At, B1); PG8_BAR;
            }
        }
        if constexpr (ALIGN_EPI) { if (wr == 0) PG8_BAR; }
        if constexpr (!Epi::AFTER_DRAIN) { E(acc, cur, wr, wc, fr, fq); S.done(cur); }
        if (!has_next) break;
#pragma unroll
        for (int a = 0; a < 2; ++a)
#pragma unroll
            for (int b = 0; b < 2; ++b)
#pragma unroll
                for (int m = 0; m < 4; ++m)
#pragma unroll
                    for (int n = 0; n < 2; ++n) acc[a][b][m][n] = (f32x4){0.f, 0.f, 0.f, 0.f};
        cur = nxt; cA = nA; cB = nB; ++ui;
        if constexpr (ALIGN_EPI) { if (wr == 1) PG8_BAR; }
    }
    PG8_WAIT_V(0);
    if constexpr (!ALIGN_EPI) { if (wr == 0) PG8_BAR; }
    PG8_BAR;
    if constexpr (Epi::AFTER_DRAIN) { E.fused(acc, cur, wr, wc, fr, fq, lds, wid, lane); S.done(cur); }
#undef PG8_SA
#undef PG8_SB
#undef PG8_STAGE
#undef PG8_LDA
#undef PG8_LDB
#undef PG8_MMA
#undef PG8_WAIT_V
#undef PG8_WAIT_L
#undef PG8_BAR
#undef PG8_SCHED
}
}
#include <hip/hip_bf16.h>
#include <cmath>
namespace attn_body {
using bf16=__hip_bfloat16;
using bf16x8=__attribute__((ext_vector_type(8)))short;
using s16x4=__attribute__((ext_vector_type(4)))short;
using f32x16=__attribute__((ext_vector_type(16)))float;
using u32x4=__attribute__((ext_vector_type(4)))unsigned;
constexpr int BATCH=2,NHEAD=16,SEQ=8192,D=64,DM=NHEAD*D;
constexpr int NW=8,QBLK=32,QB=QBLK*NW,KVBLK=64,NQB=SEQ/QB;
constexpr int ATTN_PITCH=DM, ATTN_UNIT_ROWS=QB;
__device__ __forceinline__ int crow(int r,int hi){return (r&3)+8*(r>>2)+4*hi;}
#define SBAR() __builtin_amdgcn_sched_barrier(0)
__device__ __forceinline__ void cmask(f32x16&p0,f32x16&p1,int jb,int qrel,int hi){
  const float NEG=-INFINITY; int qd=qrel-64*jb-4*hi; asm volatile("":"+v"(qd));
  #pragma unroll
  for(int r=0;r<16;++r){ if((r&3)+8*(r>>2)>qd)p0[r]=NEG; if((r&3)+8*(r>>2)+32>qd)p1[r]=NEG;}
}

constexpr int NSLOT=3, SLOTB=8192;
constexpr int LDS_K=0, LDS_V=NSLOT*SLOTB, LDS_WS=2*NSLOT*SLOTB, LDS_OST=LDS_WS+NW*64*4, LDS_NF=LDS_OST+NW*4096, LDS_BYTES=LDS_NF+SEQ*4;
constexpr float C2=0.125f*1.4426950408889634f;
__device__ __forceinline__ void glds16(const void*gsrc,unsigned lds_dst){unsigned keep;
  asm volatile("s_mov_b32 %0, m0\n\ts_mov_b32 m0, %2\n\ts_nop 0\n\tglobal_load_lds_dwordx4 %1, off\n\ts_mov_b32 m0, %0":"=&s"(keep):"v"(gsrc),"s"(lds_dst):"memory");}
__device__ __forceinline__ float max3f(float a,float b,float c){float r;asm("v_max3_f32 %0, %1, %2, %3":"=v"(r):"v"(a),"v"(b),"v"(c));return r;}
__device__ __forceinline__ float max2f(float a,float b){float r;asm("v_max_f32_e32 %0, %1, %2":"=v"(r):"v"(a),"v"(b));return r;}
__device__ __forceinline__ float fadd_s(float a,float b){float r;asm("v_add_f32_e32 %0, %1, %2":"=v"(r):"v"(a),"v"(b));return r;}
__device__ __forceinline__ float fsub_s(float a,float b){float r;asm("v_sub_f32_e32 %0, %1, %2":"=v"(r):"v"(a),"v"(b));return r;}
typedef float f32x2_t __attribute__((ext_vector_type(2))); typedef __bf16 bf16x2_t __attribute__((ext_vector_type(2)));
__device__ __forceinline__ unsigned cvtpk_s(float lo,float hi){f32x2_t v={lo,hi};bf16x2_t b=__builtin_convertvector(v,bf16x2_t);return __builtin_bit_cast(unsigned,b);}
#define WAIT_BAR(N) asm volatile("s_waitcnt vmcnt(" #N ") lgkmcnt(0)\n\ts_barrier":::"memory")

__device__ __forceinline__ void qkt(f32x16&p0,f32x16&p1,const char*Kslot,const bf16x8*qr,const f32x16&negm,int r32,int hi){
  const char*kb=Kslot+hi*1024+r32*16;
  #pragma unroll
  for(int d0=0;d0<4;++d0){
    const bf16x8 b0=*reinterpret_cast<const bf16x8*>(kb+d0*2048);
    const bf16x8 b1=*reinterpret_cast<const bf16x8*>(kb+d0*2048+512);
    if(d0==0){p0=__builtin_amdgcn_mfma_f32_32x32x16_bf16(b0,qr[0],negm,0,0,0);p1=__builtin_amdgcn_mfma_f32_32x32x16_bf16(b1,qr[0],negm,0,0,0);}
    else{p0=__builtin_amdgcn_mfma_f32_32x32x16_bf16(b0,qr[d0],p0,0,0,0);p1=__builtin_amdgcn_mfma_f32_32x32x16_bf16(b1,qr[d0],p1,0,0,0);}}
}
typedef __attribute__((address_space(3))) const char* lds_cptr;
typedef short v4i16_t __attribute__((ext_vector_type(4)));
__device__ __forceinline__ void kload8(bf16x8*kf,lds_cptr kp){
  kf[0]=*(const __attribute__((address_space(3))) bf16x8*)(kp);      kf[1]=*(const __attribute__((address_space(3))) bf16x8*)(kp+512);
  kf[2]=*(const __attribute__((address_space(3))) bf16x8*)(kp+2048); kf[3]=*(const __attribute__((address_space(3))) bf16x8*)(kp+2560);
  kf[4]=*(const __attribute__((address_space(3))) bf16x8*)(kp+4096); kf[5]=*(const __attribute__((address_space(3))) bf16x8*)(kp+4608);
  kf[6]=*(const __attribute__((address_space(3))) bf16x8*)(kp+6144); kf[7]=*(const __attribute__((address_space(3))) bf16x8*)(kp+6656);
}
__device__ __forceinline__ void kload2(bf16x8*kf,lds_cptr kp,int j){ kf[2*j]=*(const __attribute__((address_space(3))) bf16x8*)(kp+j*2048); kf[2*j+1]=*(const __attribute__((address_space(3))) bf16x8*)(kp+j*2048+512); }
__device__ __forceinline__ s16x4 vtr(lds_cptr p){ return __builtin_bit_cast(s16x4,__builtin_amdgcn_ds_read_tr16_b64_v4i16((__attribute__((address_space(3))) v4i16_t*)p)); }
__device__ __forceinline__ float rowmax(const f32x16&p0,const f32x16&p1){
  float a=max3f(p0[0],p0[1],p1[0]),b=max3f(p0[2],p0[3],p1[1]);a=max3f(a,p1[2],p1[3]);
  #pragma unroll
  for(int r=4;r<16;r+=4){a=max3f(a,p0[r],p0[r+1]);b=max3f(b,p0[r+2],p0[r+3]);a=max3f(a,p1[r],p1[r+1]);b=max3f(b,p1[r+2],p1[r+3]);}
  const float m=max2f(a,b);
  auto rr=__builtin_amdgcn_permlane32_swap(__float_as_uint(m),__float_as_uint(m),false,false);
  return max2f(__uint_as_float(rr[0]),__uint_as_float(rr[1]));
}
__device__ __forceinline__ void pv(f32x16*o,int vb,bf16x8 pa0,bf16x8 pa1,bf16x8 pa2,bf16x8 pa3){
  #pragma unroll
  for(int d0=0;d0<2;++d0){s16x4 lo[4],hi[4];
    #pragma unroll
    for(int ks=0;ks<4;++ks){
      asm volatile("ds_read_b64_tr_b16 %0,%1 offset:%c2":"=&v"(lo[ks]):"v"(vb),"i"(d0*4096+ks*1024):"memory");
      asm volatile("ds_read_b64_tr_b16 %0,%1 offset:%c2":"=&v"(hi[ks]):"v"(vb),"i"(d0*4096+ks*1024+512):"memory");}
    asm volatile("s_waitcnt lgkmcnt(0)":::"memory");SBAR();
    #define PK(k) (bf16x8){lo[k][0],lo[k][1],lo[k][2],lo[k][3],hi[k][0],hi[k][1],hi[k][2],hi[k][3]}
    o[d0]=__builtin_amdgcn_mfma_f32_32x32x16_bf16(pa0,PK(0),o[d0],0,0,0);
    o[d0]=__builtin_amdgcn_mfma_f32_32x32x16_bf16(pa1,PK(1),o[d0],0,0,0);
    o[d0]=__builtin_amdgcn_mfma_f32_32x32x16_bf16(pa2,PK(2),o[d0],0,0,0);
    o[d0]=__builtin_amdgcn_mfma_f32_32x32x16_bf16(pa3,PK(3),o[d0],0,0,0);
    #undef PK
  }
}

#ifndef ATTN_STORE16
#define ATTN_STORE16(p,v) (*(u32x4*)(p)=(v))
#endif
typedef float f32x4_t __attribute__((ext_vector_type(4))); typedef float f32x2_p __attribute__((ext_vector_type(2)));
template<int THRL> __device__ __forceinline__ void attn_unit(int b,int h,int qb,const bf16*Q,const bf16*__restrict__ K,const bf16*__restrict__ V,bf16*O,const float*__restrict__ NFg,const bf16*__restrict__ SG,char*shm){
  int tid_=threadIdx.x; asm volatile("":"+v"(tid_)); const int tid=tid_,lane=tid&63,r32=lane&31,hi=lane>>5; const int wid=__builtin_amdgcn_readfirstlane(tid>>6);
  const long rowbase=(long)b*SEQ; const int q0=qb*QB;
  const bf16*Qw=Q+(rowbase+q0+wid*QBLK)*DM+h*D;
  const bf16*Kh=K+rowbase*DM+h*D,*Vh=V+rowbase*DM+h*D;
  const unsigned lds0=(unsigned)(uintptr_t)shm;
  float*wsf=(float*)(shm+LDS_WS)+wid*64;
  const bf16*ksrc=Kh+(long)lane*DM+wid*8;
  const bf16*vsrc=Vh+(long)(16*(wid&3)+(lane>>2))*DM+(wid>>2)*32+(lane&3)*8;
  const unsigned kdst=lds0+LDS_K+wid*1024, vdst=lds0+LDS_V+wid*1024;
  #define DMA_K(t,slot) glds16(ksrc+(long)(t)*KVBLK*DM,(unsigned)__builtin_amdgcn_readfirstlane(kdst+(slot)))
  #define DMA_V(t,slot) glds16(vsrc+(long)(t)*KVBLK*DM,(unsigned)__builtin_amdgcn_readfirstlane(vdst+(slot)))
  const int vb0=(int)(lds0+LDS_V)+((lane>>4)&1)*32+(lane&3)*8+(4*hi+((lane&15)>>2))*64;
  const char*Kbase=shm+LDS_K; bf16x8 kf[8];
  const lds_cptr shm3=(lds_cptr)shm; const lds_cptr kp0=shm3+LDS_K+hi*1024+r32*16; const lds_cptr vp0=shm3+LDS_V+((lane>>4)&1)*32+(lane&3)*8+(4*hi+((lane&15)>>2))*64;
  const int NT=(q0+QB)/KVBLK;
  #define PKADD(P,B,x,y) do{ f32x2_p t_={P[B],P[(B)+1]}; t_+=(f32x2_p){x,y}; P[B]=t_[0]; P[(B)+1]=t_[1]; }while(0)
  #define BIAS(P0,P1,t) do{ const __attribute__((address_space(3))) f32x4_t*nb_=(const __attribute__((address_space(3))) f32x4_t*)(shm3+LDS_NF+(t)*256+hi*16); \
    _Pragma("unroll") for(int j_=0;j_<4;++j_){ const f32x4_t a_=nb_[2*j_]; PKADD(P0,4*j_,a_[0],a_[1]); PKADD(P0,4*j_+2,a_[2],a_[3]); } SBAR(); \
    _Pragma("unroll") for(int j_=0;j_<4;++j_){ const f32x4_t b_=nb_[2*j_+8]; PKADD(P1,4*j_,b_[0],b_[1]); PKADD(P1,4*j_+2,b_[2],b_[3]); } SBAR(); }while(0)
  DMA_K(0,0);DMA_V(0,0);DMA_K(1,SLOTB);
  bf16x8 qr[4];
  #pragma unroll
  for(int d0=0;d0<4;++d0)qr[d0]=*reinterpret_cast<const bf16x8*>(&Qw[(long)r32*DM+d0*16+hi*8]);
  float mhat=0.f,l_reg=0.f;f32x16 o[2];o[0]=f32x16{};o[1]=f32x16{};f32x16 negm=f32x16{};asm volatile("":"+v"(negm));
  const int qrel=wid*QBLK+r32;
  #define CMASK(P0,P1,t) do{int jb_=(t)-(NT-4); if(jb_>=0)cmask(P0,P1,jb_,qrel,hi);}while(0)
  bool resc=false;
  #define START(P0,P1) do{ const float rm=rowmax(P0,P1); resc=false; \
    { const float dl=rm; mhat=fadd_s(mhat,dl); \
      _Pragma("unroll") for(int r=0;r<16;++r){P0[r]=fsub_s(P0[r],dl);P1[r]=fsub_s(P1[r],dl);} \
      _Pragma("unroll") for(int r=0;r<16;++r)negm[r]=-mhat; asm volatile("":"+v"(negm)); } \
    _Pragma("unroll") for(int r=0;r<16;++r)P0[r]=__builtin_amdgcn_exp2f(P0[r]); }while(0)
  #define RESC() do{ if(resc){ asm volatile("s_waitcnt lgkmcnt(0)":::"memory"); \
      _Pragma("unroll") for(int d_=0;d_<2;++d_) _Pragma("unroll") for(int r=0;r<16;++r)o[d_][r]*=wsf[crow(r,hi)]; } }while(0)
  f32x16 pA0,pA1,pB0,pB1;
  int sl_prev=0,sl_cur=0,sl_next=SLOTB;
  #define ROT() do{sl_prev=sl_cur;sl_cur=sl_next;sl_next=(sl_next==(NSLOT-1)*SLOTB)?0:sl_next+SLOTB;}while(0)
  DMA_K(2,2*SLOTB);
  WAIT_BAR(3);
  qkt(pA0,pA1,Kbase,qr,negm,r32,hi);asm volatile("s_nop 15\n\ts_nop 7":"+v"(pA0),"+v"(pA1));BIAS(pA0,pA1,0);CMASK(pA0,pA1,0);
  START(pA0,pA1);
  _Pragma("unroll") for(int r=0;r<16;++r)pA1[r]=__builtin_amdgcn_exp2f(pA1[r]);
  WAIT_BAR(0);
  DMA_K(3,0);DMA_V(1,SLOTB);
  ROT();
  kload8(kf,kp0+sl_cur);
  WAIT_BAR(2);
  s16x4 vlo[8],vhi[8]; u32x4 pw0,pw1,pw2,pw3;
  #define PKW(P,B) cvtpk_s(P[B],P[B+1])
  #define PAF(k) __builtin_bit_cast(bf16x8,pw##k)
  #define VFR(i) (bf16x8){vlo[i][0],vlo[i][1],vlo[i][2],vlo[i][3],vhi[i][0],vhi[i][1],vhi[i][2],vhi[i][3]}
  #define PIN(x) asm volatile("":"+v"(x))
  #define MX3(a,b,c) __builtin_fmaxf(__builtin_fmaxf((a),(b)),(c))
  #define GAPA(MF,A0,A1,A2,A3,W0,W1,PW) do{ MF; sacc+=A0; sacc+=A1; sacc+=A2; sacc+=A3; PIN(sacc); W0; W1; PIN(PW); SBAR(); }while(0)
  #define EX(v) __builtin_amdgcn_exp2f(v)
  #define GAPB(MF,X,B) do{ MF; X[B]=EX(X[B]); X[B+1]=EX(X[B+1]); X[B+2]=EX(X[B+2]); X[B+3]=EX(X[B+3]); PIN(X); SBAR(); }while(0)
  #define VRD(i) do{ vlo[i]=vtr(vp_+(((i)>>2)*4096+((i)&3)*1024)); vhi[i]=vtr(vp_+(((i)>>2)*4096+((i)&3)*1024+512)); }while(0)
  #define KRD(G,j) do{ if(G){ kload2(kf,kp0+sl_next,j); SBAR(); } }while(0)
  #define STEP(C0,C1,P0,P1,t,GK,GV,GL) do{ SBAR(); \
    const lds_cptr vp_=vp0+sl_prev; \
    VRD(0); SBAR(); float sacc=(P0[0]+P0[1]); \
    GAPA(C0=__builtin_amdgcn_mfma_f32_32x32x16_bf16(kf[0],qr[0],negm,0,0,0), P0[2],P0[3],P0[4],P0[5],     pw0[0]=PKW(P0,0), pw0[1]=PKW(P0,2), pw0); \
    VRD(4); SBAR(); GAPA(C1=__builtin_amdgcn_mfma_f32_32x32x16_bf16(kf[1],qr[0],negm,0,0,0), P0[6],P0[7],P0[8],P0[9],     pw0[2]=PKW(P0,4), pw0[3]=PKW(P0,6), pw0); \
    VRD(1); SBAR(); GAPA(C0=__builtin_amdgcn_mfma_f32_32x32x16_bf16(kf[2],qr[1],C0,0,0,0),   P0[10],P0[11],P0[12],P0[13], pw1[0]=PKW(P0,8), pw1[1]=PKW(P0,10), pw1); \
    VRD(5); SBAR(); GAPA(C1=__builtin_amdgcn_mfma_f32_32x32x16_bf16(kf[3],qr[1],C1,0,0,0),   P0[14],P0[15],P1[0],P1[1],   pw1[2]=PKW(P0,12),pw1[3]=PKW(P0,14), pw1); \
    VRD(2); SBAR(); GAPA(C0=__builtin_amdgcn_mfma_f32_32x32x16_bf16(kf[4],qr[2],C0,0,0,0),   P1[2],P1[3],P1[4],P1[5],     pw2[0]=PKW(P1,0), pw2[1]=PKW(P1,2), pw2); \
    VRD(6); SBAR(); GAPA(C1=__builtin_amdgcn_mfma_f32_32x32x16_bf16(kf[5],qr[2],C1,0,0,0),   P1[6],P1[7],P1[8],P1[9],     pw2[2]=PKW(P1,4), pw2[3]=PKW(P1,6), pw2); \
    VRD(3); SBAR(); GAPA(C0=__builtin_amdgcn_mfma_f32_32x32x16_bf16(kf[6],qr[3],C0,0,0,0),   P1[10],P1[11],P1[12],P1[13], pw3[0]=PKW(P1,8), pw3[1]=PKW(P1,10), pw3); \
    VRD(7); SBAR(); GAPA(C1=__builtin_amdgcn_mfma_f32_32x32x16_bf16(kf[7],qr[3],C1,0,0,0),   P1[14],P1[15],0.f,0.f,       pw3[2]=PKW(P1,12),pw3[3]=PKW(P1,14), pw3); \
    l_reg+=sacc; \
    if(GK){DMA_K((t)+3,sl_cur);} if(GV){DMA_V((t)+1,sl_next);} \
    BIAS(C0,C1,t); CMASK(C0,C1,t); \
    { float a=MX3(C0[0],C0[1],C1[0]),b=MX3(C0[2],C0[3],C1[1]); a=MX3(a,C1[2],C1[3]); \
      _Pragma("unroll") for(int r=4;r<16;r+=4){a=MX3(a,C0[r],C0[r+1]);b=MX3(b,C0[r+2],C0[r+3]);a=MX3(a,C1[r],C1[r+1]);b=MX3(b,C1[r+2],C1[r+3]);} \
      float rm=__builtin_fmaxf(a,b); { auto rr=__builtin_amdgcn_permlane32_swap(__float_as_uint(rm),__float_as_uint(rm),false,false); rm=__builtin_fmaxf(__uint_as_float(rr[0]),__uint_as_float(rr[1])); } \
      resc=false; \
      if(__builtin_expect(__any(rm>(float)THRL),0)){ const float dl=__builtin_fmaxf(rm,0.f); mhat+=dl; \
        _Pragma("unroll") for(int r=0;r<16;++r){C0[r]-=dl;C1[r]-=dl;} \
        _Pragma("unroll") for(int r=0;r<16;++r)negm[r]=-mhat; asm volatile("":"+v"(negm)); \
        const float f=__builtin_amdgcn_exp2f(-dl); l_reg*=f; if(hi==0)wsf[r32]=f; resc=true; } } \
    SBAR(); \
    GAPB(o[0]=__builtin_amdgcn_mfma_f32_32x32x16_bf16(PAF(0),VFR(0),o[0],0,0,0), C0,0); \
    GAPB(o[1]=__builtin_amdgcn_mfma_f32_32x32x16_bf16(PAF(0),VFR(4),o[1],0,0,0), C0,4); \
    KRD(GL,0); GAPB(o[0]=__builtin_amdgcn_mfma_f32_32x32x16_bf16(PAF(1),VFR(1),o[0],0,0,0), C0,8); \
    KRD(GL,1); GAPB(o[1]=__builtin_amdgcn_mfma_f32_32x32x16_bf16(PAF(1),VFR(5),o[1],0,0,0), C0,12); \
    KRD(GL,2); GAPB(o[0]=__builtin_amdgcn_mfma_f32_32x32x16_bf16(PAF(2),VFR(2),o[0],0,0,0), C1,0); \
    KRD(GL,3); GAPB(o[1]=__builtin_amdgcn_mfma_f32_32x32x16_bf16(PAF(2),VFR(6),o[1],0,0,0), C1,4); \
    GAPB(o[0]=__builtin_amdgcn_mfma_f32_32x32x16_bf16(PAF(3),VFR(3),o[0],0,0,0), C1,8); \
    GAPB(o[1]=__builtin_amdgcn_mfma_f32_32x32x16_bf16(PAF(3),VFR(7),o[1],0,0,0), C1,12); \
    }while(0)
  int t=1;
  #undef CMASK
  #define CMASK(P0,P1,t) do{}while(0)
  for(;t+5<NT;t+=2){
    STEP(pB0,pB1,pA0,pA1,t,true,true,true);     WAIT_BAR(2); RESC(); ROT();
    STEP(pA0,pA1,pB0,pB1,t+1,true,true,true);   WAIT_BAR(2); RESC(); ROT();
  }
  #undef CMASK
  #define CMASK(P0,P1,t) do{int jb_=(t)-(NT-4); if(jb_>=0)cmask(P0,P1,jb_,qrel,hi);}while(0)
  #define ENDW(tt) do{ if((tt)+3<NT){WAIT_BAR(2);} else if((tt)+2<NT){WAIT_BAR(1);} else {WAIT_BAR(0);} }while(0)
  for(;t+1<NT;t+=2){
    STEP(pB0,pB1,pA0,pA1,t,(t+3<NT),(t+1<NT),(t+1<NT));       ENDW(t);   RESC(); ROT();
    STEP(pA0,pA1,pB0,pB1,t+1,(t+4<NT),(t+2<NT),(t+2<NT));     ENDW(t+1); RESC(); ROT();
  }
  STEP(pB0,pB1,pA0,pA1,NT-1,false,false,false); RESC();
  { float sacc=pB0[0]+pB0[1]; _Pragma("unroll") for(int r=2;r<16;++r)sacc+=pB0[r]; _Pragma("unroll") for(int r=0;r<16;++r)sacc+=pB1[r]; l_reg+=sacc;
    pw0=(u32x4){PKW(pB0,0),PKW(pB0,2),PKW(pB0,4),PKW(pB0,6)};pw1=(u32x4){PKW(pB0,8),PKW(pB0,10),PKW(pB0,12),PKW(pB0,14)};pw2=(u32x4){PKW(pB1,0),PKW(pB1,2),PKW(pB1,4),PKW(pB1,6)};pw3=(u32x4){PKW(pB1,8),PKW(pB1,10),PKW(pB1,12),PKW(pB1,14)};
    SBAR(); pv(o,vb0+sl_cur,PAF(0),PAF(1),PAF(2),PAF(3)); }
  #undef PKW
  #undef PAF
  #undef VFR
  #undef PIN
  #undef MX3
  #undef GAPA
  #undef GAPB
  #undef EX
  #undef VRD
  #undef KRD
  #undef STEP
  #undef ENDW
  {auto rr=__builtin_amdgcn_permlane32_swap(__float_as_uint(l_reg),__float_as_uint(l_reg),false,false);l_reg=__uint_as_float(rr[0])+__uint_as_float(rr[1]);}
  if(hi==0)wsf[32+r32]=l_reg;asm volatile("s_waitcnt lgkmcnt(0)":::"memory");
  float rli[16];
  #pragma unroll
  for(int r=0;r<16;++r)rli[r]=__builtin_amdgcn_rcpf(wsf[32+crow(r,hi)]);
  bf16*Ow=O+(rowbase+q0+wid*QBLK)*DM+h*D; const bf16*SGw=SG+(rowbase+q0+wid*QBLK)*DM+h*D;
  { bf16*stg=(bf16*)(shm+LDS_OST)+wid*2048;
    #pragma unroll
    for(int r=0;r<16;++r){const int orow=crow(r,hi);
      #pragma unroll
      for(int d0=0;d0<2;++d0)stg[orow*64+d0*32+r32]=__float2bfloat16(o[d0][r]*rli[r]);}
    asm volatile("s_waitcnt lgkmcnt(0)":::"memory");
    #pragma unroll
    for(int i=0;i<4;++i){const int row=i*8+(lane>>3),ch=lane&7; u32x4 v=*(const u32x4*)(stg+row*64+ch*8); const u32x4 gq=*(const u32x4*)(SGw+(long)row*DM+ch*8);
      _Pragma("unroll") for(int e_=0;e_<4;++e_){ const float lo_=__uint_as_float(v[e_]<<16)*__uint_as_float(gq[e_]<<16), hi_=__uint_as_float(v[e_]&0xffff0000u)*__uint_as_float(gq[e_]&0xffff0000u); v[e_]=cvtpk_s(lo_,hi_); }
      ATTN_STORE16(Ow+(long)row*DM+ch*8,v);} }
  asm volatile("s_waitcnt lgkmcnt(0)\n\ts_barrier":::"memory");
  #undef DMA_K
  #undef BIAS
  #undef PKADD
  #undef DMA_V
  #undef CMASK
  #undef START
  #undef RESC
  #undef ROT
}
constexpr int ATTN_LDS_BYTES=LDS_BYTES;
struct AttnTensors { const bf16* Q; const bf16* K; const bf16* V; bf16* O; const float* NF; const bf16* SG; };
struct AttnUnit { int bh; int qb; };
struct StaticOrder {
  int vcu;
  __device__ __forceinline__ explicit StaticOrder(int grid,int block):vcu((block%8)*(grid/8)+block/8){}
  __device__ __forceinline__ bool next(int i,AttnUnit&u)const{ if(i>=4)return false; const int s=vcu&7; u.bh=vcu>>3; u.qb=(i==0)?s:(i==1)?15-s:(i==2)?16+s:31-s; return true; }
  __device__ __forceinline__ void a_ready(const AttnUnit&)const{}
  __device__ __forceinline__ void done(const AttnUnit&)const{}
};
template<class Sched,int THRL=8> __device__ __forceinline__ void attn_phase(char*lds,const AttnTensors&T,const Sched&S){
  AttnUnit u;
  if(S.next(0,u)){
    typedef float f32x4_s __attribute__((ext_vector_type(4))); const f32x4_s*nsrc=(const f32x4_s*)(T.NF+(long)u.bh*SEQ)+threadIdx.x*4; __attribute__((address_space(3))) char*l3=(__attribute__((address_space(3))) char*)lds;
    __attribute__((address_space(3))) f32x4_s*ndst=(__attribute__((address_space(3))) f32x4_s*)(l3+LDS_NF)+threadIdx.x*4; __attribute__((address_space(3))) float*wtot=(__attribute__((address_space(3))) float*)(l3+LDS_WS);
    const int ln_=threadIdx.x&63, wv_=threadIdx.x>>6; f32x4_s v_[4]; float run_=0.f;
    _Pragma("unroll") for(int j=0;j<4;++j){ v_[j]=nsrc[j]; v_[j].x+=run_; v_[j].y+=v_[j].x; v_[j].z+=v_[j].y; v_[j].w+=v_[j].z; run_=v_[j].w; }
    float inc_=run_;
    _Pragma("unroll") for(int o=1;o<64;o<<=1){ const float t_=__shfl_up(inc_,o); if(ln_>=o)inc_+=t_; }
    if(ln_==63)wtot[wv_]=inc_;
    asm volatile("s_waitcnt vmcnt(0) lgkmcnt(0)\n\ts_barrier":::"memory");
    float off_=inc_-run_; for(int w=0;w<wv_;++w)off_+=wtot[w];
    _Pragma("unroll") for(int j=0;j<4;++j)ndst[j]=(v_[j]+off_)*(-1.4426950408889634f);
    asm volatile("s_waitcnt vmcnt(0) lgkmcnt(0)\n\ts_barrier":::"memory"); }
  for(int i=0;S.next(i,u);++i){ S.a_ready(u); attn_unit<THRL>(u.bh/NHEAD,u.bh%NHEAD,u.qb,T.Q,T.K,T.V,T.O,T.NF,T.SG,lds); S.done(u); }
}
#undef SBAR
#undef WAIT_BAR
}
constexpr int NWAVES = 8, NTHR = 512;
constexpr int BATCH = 2, T = 8192, D = 1024, FF = 4096, M = BATCH * T;
constexpr int NIN_FOX = 4 * D + 16;
constexpr float EPS = 1e-6f;
constexpr size_t MiB = 1u << 20;
constexpr size_t WS_MOD = 0;
constexpr size_t WS_LB = 128 * 1024;
constexpr size_t WS_QKNW = 160 * 1024;
constexpr size_t WS_WFZ = 192 * 1024;
constexpr size_t WS_DN = 256 * 1024;
constexpr size_t WS_LFS = 1536 * 1024;
constexpr size_t WS_NF = 2560 * 1024;
constexpr size_t WS_BAR = 3584 * 1024, BAR_BYTES = 16384;
constexpr size_t WS_SS = 3648 * 1024;
constexpr size_t WS_BIASV = 3840 * 1024;
constexpr size_t WS_XN2 = 216 * MiB;
constexpr size_t WS_W_HGIN = 4 * MiB, WS_W_HGOUT = 12 * MiB, WS_W_FOXIN = 14 * MiB, WS_W_FOXOUT = 22 * MiB;
constexpr size_t WS_W1_0 = 24 * MiB, WS_W2_0 = 32 * MiB, WS_W1_1 = 40 * MiB, WS_W2_1 = 48 * MiB;
constexpr size_t WS_XN = 56 * MiB;
constexpr size_t WS_R = 88 * MiB;
constexpr size_t WS_QO = WS_R, WS_B1 = WS_R + 32 * MiB, WS_B2 = WS_R + 64 * MiB, WS_B3 = WS_R + 96 * MiB;
constexpr size_t WS_ST = WS_R + 96 * MiB;
constexpr size_t WS_H = WS_R;
constexpr size_t WS_END = 256 * MiB;
static_assert(WS_ST + 64 * MiB <= WS_END && WS_H + 128 * MiB <= WS_END && WS_B1 - WS_QO == 32 * MiB, "ws map");
constexpr int LDS_BYTES = 147456;

#define GAS __attribute__((address_space(1)))
#define LAS __attribute__((address_space(3)))
typedef unsigned short bf16;
typedef unsigned v4u __attribute__((ext_vector_type(4)));
typedef unsigned v2u __attribute__((ext_vector_type(2)));
typedef float f32x4 __attribute__((ext_vector_type(4)));
typedef short bf16x8 __attribute__((ext_vector_type(8)));
typedef short s16x4v __attribute__((ext_vector_type(4)));
#define LDS_WAIT() asm volatile("s_waitcnt lgkmcnt(0)" ::: "memory")
__device__ __forceinline__ unsigned f2bf(float f) { unsigned u = __builtin_bit_cast(unsigned, f); return (u + 0x7fffu + ((u >> 16) & 1u)) >> 16; }
__device__ __forceinline__ unsigned pk2(float lo, float hi) { return pg8::cvt_pk_bf16(lo, hi); }
__device__ __forceinline__ float bf2f(unsigned short h) { return __uint_as_float((unsigned)h << 16); }
__device__ __forceinline__ float wave_sum(float v) {
#pragma unroll
    for (int o = 1; o < 64; o <<= 1) v += __shfl_xor(v, o);
    return v;
}

struct Args { const float* in[18]; float* out; unsigned char* ws; };

template <bool HEADPERM>
__device__ __forceinline__ void transpose_item(const float* W, int K, int ldw, int Ncols, bf16* WT, LAS float* scr, int item, int lane) {
    const int nblk = Ncols / 32, kb = item / nblk, nb = item % nblk, k0 = 64 * kb, n0 = 32 * nb;
#pragma unroll 8
    for (int i = 0; i < 32; ++i) { const int kk = 2 * i + (lane >> 5); scr[kk * 33 + (lane & 31)] = W[(size_t)(k0 + kk) * ldw + n0 + (lane & 31)]; }
    LDS_WAIT(); asm volatile("" ::: "memory");
    const int c = lane & 7;
#pragma unroll
    for (int j = 0; j < 4; ++j) { const int n = (lane >> 3) + 8 * j; const LAS float* s = scr + (8 * c) * 33 + n;
        v4u o; o.x = pk2(s[0 * 33], s[1 * 33]); o.y = pk2(s[2 * 33], s[3 * 33]); o.z = pk2(s[4 * 33], s[5 * 33]); o.w = pk2(s[6 * 33], s[7 * 33]);
        int col = n0 + n;
        if (HEADPERM && col < 2048) { const int nl = col & 255; col = (col & ~255) + 128 * ((nl >> 5) & 1) + 32 * (nl >> 6) + (nl & 31); }
        *(GAS v4u*)(WT + (size_t)col * K + k0 + 8 * c) = o; }
    LDS_WAIT(); asm volatile("" ::: "memory");
}

__device__ __forceinline__ void norm_rows(int gw, int NGW, int lane, const float* xin, const float* w, const float* modsh, const float* modsc, bf16* outb, float* outf) {
    for (int m = gw; m < M; m += NGW) {
        const GAS f32x4* xr = (const GAS f32x4*)(xin + (size_t)m * D) + lane;
        f32x4 v[4]; float s = 0.f;
#pragma unroll
        for (int j = 0; j < 4; ++j) { v[j] = xr[64 * j]; s += (v[j].x * v[j].x + v[j].y * v[j].y) + (v[j].z * v[j].z + v[j].w * v[j].w); }
        const float rstd = __builtin_amdgcn_rsqf(wave_sum(s) * (1.f / D) + EPS);
        const int b = m >> 13;
#pragma unroll
        for (int j = 0; j < 4; ++j) {
            const f32x4 wv = *((const f32x4*)w + lane + 64 * j);
            f32x4 y = v[j] * rstd * wv;
            if (modsc) { const f32x4 sc = *((const f32x4*)(modsc + b * 6144) + lane + 64 * j), sh = *((const f32x4*)(modsh + b * 6144) + lane + 64 * j); y = y * (1.0f + sc) + sh; }
            if (outf) *((GAS f32x4*)(outf + (size_t)m * D) + lane + 64 * j) = y;
            else { v2u o; o.x = pk2(y.x, y.y); o.y = pk2(y.z, y.w); *((GAS v2u*)(outb + (size_t)m * D) + lane + 64 * j) = o; }
        }
    }
}

constexpr int HG_QM = 0, HG_KM = 17408, HG_Q0 = 34816, HG_KT = 52224, HG_VT = 70656, HG_STL = 89088, HG_PART = 123904, HG_RED = 125952;
constexpr int PQ = 136, PT = 72;
#define MFMA16(a, b, c) __builtin_amdgcn_mfma_f32_16x16x32_bf16((a), (b), (c), 0, 0, 0)

__device__ __forceinline__ void hg_pass_a(LAS unsigned char* lds, int tid, int lane, int wave, const float* LF, const bf16* V, bf16* ST, float* DN) {
    const int p = tid >> 7, kk = tid & 127, g = lane >> 4, l15 = lane & 15;
    LAS float* part = (LAS float*)(lds + HG_PART);
    LAS bf16* KT = (LAS bf16*)(lds + HG_KT); LAS bf16* VT = (LAS bf16*)(lds + HG_VT);
    float Gn[16]; unsigned short vn[16];
#define HGA_LOAD(uu) do { const int bh_ = (uu) >> 7, n_ = (uu) & 127; const size_t r_ = (size_t)(bh_ >> 3) * T + n_ * 64 + 16 * p; \
        const float* lfp_ = LF + r_ * D + (bh_ & 7) * 128 + kk; const bf16* vp_ = V + r_ * D + (bh_ & 7) * 128 + kk; \
        _Pragma("unroll") for (int j = 0; j < 16; ++j) { Gn[j] = lfp_[(size_t)j * D]; vn[j] = vp_[(size_t)j * D]; } } while (0)
    if ((int)blockIdx.x < 2048) HGA_LOAD(blockIdx.x);
    for (int u = blockIdx.x; u < 2048; u += gridDim.x) {
        float G[16], kv[16]; unsigned short vv[16];
#pragma unroll
        for (int j = 0; j < 16; ++j) { G[j] = Gn[j]; vv[j] = vn[j]; }
#pragma unroll
        for (int j = 0; j < 16; ++j) { kv[j] = 1.0f - __expf(G[j]); if (j) G[j] += G[j - 1]; }
        part[p * 128 + kk] = G[15];
        __syncthreads();
        const float t0 = part[kk], t1 = part[128 + kk], t2 = part[256 + kk], t3 = part[384 + kk];
        const float off = (p > 0 ? t0 : 0.f) + (p > 1 ? t1 : 0.f) + (p > 2 ? t2 : 0.f), glast = (t0 + t1) + (t2 + t3);
        unsigned kw[8], vw[8];
#pragma unroll
        for (int j = 0; j < 8; ++j) {
            const float a0 = kv[2 * j] * __expf(glast - (G[2 * j] + off)), a1 = kv[2 * j + 1] * __expf(glast - (G[2 * j + 1] + off));
            kw[j] = pk2(a0, a1); vw[j] = (unsigned)vv[2 * j] | ((unsigned)vv[2 * j + 1] << 16); }
        *(LAS v4u*)(KT + kk * PT + 16 * p) = (v4u){kw[0], kw[1], kw[2], kw[3]}; *(LAS v4u*)(KT + kk * PT + 16 * p + 8) = (v4u){kw[4], kw[5], kw[6], kw[7]};
        *(LAS v4u*)(VT + kk * PT + 16 * p) = (v4u){vw[0], vw[1], vw[2], vw[3]}; *(LAS v4u*)(VT + kk * PT + 16 * p + 8) = (v4u){vw[4], vw[5], vw[6], vw[7]};
        if (p == 0) DN[(size_t)u * 128 + kk] = __expf(glast);
        if (u + (int)gridDim.x < 2048) HGA_LOAD(u + gridDim.x);
        __syncthreads();
        bf16x8 bfr[2];
#pragma unroll
        for (int ss = 0; ss < 2; ++ss) bfr[ss] = *(const LAS bf16x8*)(VT + (16 * wave + l15) * PT + 32 * ss + 8 * g);
        bf16* stp = ST + ((size_t)u * 128 + 16 * wave + l15) * 128 + 4 * g;
#pragma unroll
        for (int kt = 0; kt < 8; ++kt) {
            f32x4 acc = (f32x4){0.f, 0.f, 0.f, 0.f};
#pragma unroll
            for (int ss = 0; ss < 2; ++ss) { const bf16x8 a = *(const LAS bf16x8*)(KT + (16 * kt + l15) * PT + 32 * ss + 8 * g); acc = MFMA16(a, bfr[ss], acc); }
            v2u o; o.x = pk2(acc[0], acc[1]); o.y = pk2(acc[2], acc[3]); *(GAS v2u*)(stp + 16 * kt) = o;
        }
        __syncthreads();
    }
#undef HGA_LOAD
}
__device__ __forceinline__ void hg_pass_b(int tid, bf16* ST, const float* DN) {
    const int gt = blockIdx.x * NTHR + tid;
    for (int e2 = gt; e2 < 16 * 8192; e2 += gridDim.x * NTHR) {
        const int bh = e2 >> 13, pe = e2 & 8191, k = (2 * pe) & 127;
        unsigned* sp = (unsigned*)ST + (size_t)bh * 128 * 8192 + pe; const float* dp = DN + (size_t)bh * 128 * 128 + k;
        float s0 = 0.f, s1 = 0.f;
        for (int n0 = 0; n0 < 128; n0 += 16) {
            unsigned dv[16]; float d0[16], d1[16];
#pragma unroll
            for (int j = 0; j < 16; ++j) { dv[j] = sp[(size_t)(n0 + j) * 8192]; const float2 dd = *(const float2*)(dp + (size_t)(n0 + j) * 128); d0[j] = dd.x; d1[j] = dd.y; }
#pragma unroll
            for (int j = 0; j < 16; ++j) { sp[(size_t)(n0 + j) * 8192] = pk2(s0, s1);
                s0 = d0[j] * s0 + __uint_as_float(dv[j] << 16); s1 = d1[j] * s1 + __uint_as_float(dv[j] & 0xffff0000u); }
        }
    }
}
__device__ __forceinline__ void hg_pass_c(LAS unsigned char* lds, int tid, int lane, int wave, const float* LF, const bf16* QO, bf16* OUTB, const bf16* V, const bf16* GS, const bf16* ST, const float* gnw) {
    const int p = tid >> 7, kk = tid & 127, g = lane >> 4, l15 = lane & 15, tt = wave & 3, vh = wave >> 2;
    LAS float* part = (LAS float*)(lds + HG_PART); LAS float* red = (LAS float*)(lds + HG_RED);
    LAS bf16* QM = (LAS bf16*)(lds + HG_QM); LAS bf16* KM = (LAS bf16*)(lds + HG_KM); LAS bf16* Q0 = (LAS bf16*)(lds + HG_Q0);
    LAS bf16* VT = (LAS bf16*)(lds + HG_VT); LAS bf16* STL = (LAS bf16*)(lds + HG_STL);
    float lfn[16]; unsigned short vn[16], qn[16]; v4u stn[4];
#define HGC_LOAD(uu) do { const int bh_ = (uu) >> 7, n_ = (uu) & 127; const size_t r_ = (size_t)(bh_ >> 3) * T + n_ * 64 + 16 * p; \
        const float* lfp_ = LF + r_ * D + (bh_ & 7) * 128 + kk; const bf16* vp_ = V + r_ * D + (bh_ & 7) * 128 + kk; const bf16* qp_ = QO + r_ * D + (bh_ & 7) * 128 + kk; \
        const v4u* src_ = (const v4u*)(ST + (size_t)(uu) * 16384); \
        _Pragma("unroll") for (int i = 0; i < 4; ++i) stn[i] = src_[tid + 512 * i]; \
        _Pragma("unroll") for (int j = 0; j < 16; ++j) { lfn[j] = lfp_[(size_t)j * D]; vn[j] = vp_[(size_t)j * D]; qn[j] = qp_[(size_t)j * D]; } } while (0)
    if ((int)blockIdx.x < 2048) HGC_LOAD(blockIdx.x);
    for (int u = blockIdx.x; u < 2048; u += gridDim.x) {
        const int bh = u >> 7, n = u & 127, b = bh >> 3, h = bh & 7;
        const size_t rowu = (size_t)b * T + n * 64;
#pragma unroll
        for (int i = 0; i < 4; ++i) { const int q = tid + 512 * i; *(LAS v4u*)(STL + (q >> 4) * PQ + (q & 15) * 8) = stn[i]; }
        float G[16], lf[16]; unsigned short vv[16], qq[16];
#pragma unroll
        for (int j = 0; j < 16; ++j) { lf[j] = lfn[j]; vv[j] = vn[j]; qq[j] = qn[j]; }
#pragma unroll
        for (int j = 0; j < 16; ++j) { G[j] = lf[j] + (j ? G[j - 1] : 0.f); }
        part[p * 128 + kk] = G[15];
        __syncthreads();
        const float t0 = part[kk], t1 = part[128 + kk], t2 = part[256 + kk];
        const float off = (p > 0 ? t0 : 0.f) + (p > 1 ? t1 : 0.f) + (p > 2 ? t2 : 0.f), gm = t0 + t1;
        unsigned vw[8];
#pragma unroll
        for (int j = 0; j < 16; ++j) {
            const float Gt = G[j] + off, qv = bf2f(qq[j]), kf = 1.0f - __expf(lf[j]);
            const int t = 16 * p + j;
            QM[t * PQ + kk] = (bf16)f2bf(qv * __expf(Gt - gm));
            KM[t * PQ + kk] = (bf16)f2bf(kf * __expf(gm - Gt));
            Q0[t * PQ + kk] = (bf16)f2bf(qv * __expf(Gt));
        }
#pragma unroll
        for (int j = 0; j < 8; ++j) vw[j] = (unsigned)vv[2 * j] | ((unsigned)vv[2 * j + 1] << 16);
        *(LAS v4u*)(VT + kk * PT + 16 * p) = (v4u){vw[0], vw[1], vw[2], vw[3]}; *(LAS v4u*)(VT + kk * PT + 16 * p + 8) = (v4u){vw[4], vw[5], vw[6], vw[7]};
        if (u + (int)gridDim.x < 2048) HGC_LOAD(u + gridDim.x);
        __syncthreads();
        f32x4 P[4];
        bf16x8 qf[4];
#pragma unroll
        for (int kc = 0; kc < 4; ++kc) qf[kc] = *(const LAS bf16x8*)(QM + (16 * tt + l15) * PQ + 32 * kc + 8 * g);
#pragma unroll
        for (int st = 0; st < 4; ++st) {
            P[st] = (f32x4){0.f, 0.f, 0.f, 0.f};
            if (st <= tt) {
#pragma unroll
                for (int kc = 0; kc < 4; ++kc) { const bf16x8 a = *(const LAS bf16x8*)(KM + (16 * st + l15) * PQ + 32 * kc + 8 * g); P[st] = MFMA16(a, qf[kc], P[st]); }
                if (st == tt) {
#pragma unroll
                    for (int i = 0; i < 4; ++i) if (4 * g + i > l15) P[st][i] = 0.f; }
            }
        }
        f32x4 O[4];
        bf16x8 pf[2];
#pragma unroll
        for (int sp = 0; sp < 2; ++sp) { v4u w; w.x = pk2(P[2 * sp][0], P[2 * sp][1]); w.y = pk2(P[2 * sp][2], P[2 * sp][3]); w.z = pk2(P[2 * sp + 1][0], P[2 * sp + 1][1]); w.w = pk2(P[2 * sp + 1][2], P[2 * sp + 1][3]);
            pf[sp] = __builtin_bit_cast(bf16x8, w); }
#pragma unroll
        for (int kc = 0; kc < 4; ++kc) qf[kc] = *(const LAS bf16x8*)(Q0 + (16 * tt + l15) * PQ + 32 * kc + 8 * g);
#pragma unroll
        for (int j = 0; j < 4; ++j) {
            const int vrow = 64 * vh + 16 * j + l15;
            O[j] = (f32x4){0.f, 0.f, 0.f, 0.f};
#pragma unroll
            for (int sp = 0; sp < 2; ++sp) {
                if (2 * sp <= tt) {
                    const v2u lo = *(const LAS v2u*)(VT + vrow * PT + 32 * sp + 4 * g), hi = *(const LAS v2u*)(VT + vrow * PT + 32 * sp + 16 + 4 * g);
                    const bf16x8 a = __builtin_bit_cast(bf16x8, (v4u){lo.x, lo.y, hi.x, hi.y});
                    O[j] = MFMA16(a, pf[sp], O[j]);
                }
            }
#pragma unroll
            for (int kc = 0; kc < 4; ++kc) { const bf16x8 a = *(const LAS bf16x8*)(STL + vrow * PQ + 32 * kc + 8 * g); O[j] = MFMA16(a, qf[kc], O[j]); }
        }
        float ss = 0.f;
#pragma unroll
        for (int j = 0; j < 4; ++j) ss += (O[j][0] * O[j][0] + O[j][1] * O[j][1]) + (O[j][2] * O[j][2] + O[j][3] * O[j][3]);
        ss += __shfl_xor(ss, 16); ss += __shfl_xor(ss, 32);
        if (g == 0) red[vh * 64 + 16 * tt + l15] = ss;
        __syncthreads();
        const float tot = red[16 * tt + l15] + red[64 + 16 * tt + l15];
        const float rstd = __builtin_amdgcn_rsqf(tot * (1.0f / 128.0f) + EPS);
        const size_t orow = (rowu + 16 * tt + l15) * D + h * 128;
#pragma unroll
        for (int j = 0; j < 4; ++j) {
            const int v0 = 64 * vh + 16 * j + 4 * g;
            const f32x4 gw = *(const f32x4*)(gnw + v0); const v2u gs = *(const GAS v2u*)(GS + orow + v0);
            const float o0 = O[j][0] * rstd * gw[0] * __uint_as_float(gs.x << 16), o1 = O[j][1] * rstd * gw[1] * __uint_as_float(gs.x & 0xffff0000u);
            const float o2 = O[j][2] * rstd * gw[2] * __uint_as_float(gs.y << 16), o3 = O[j][3] * rstd * gw[3] * __uint_as_float(gs.y & 0xffff0000u);
            v2u o; o.x = pk2(o0, o1); o.y = pk2(o2, o3); *(GAS v2u*)(OUTB + orow + v0) = o;
        }
        __syncthreads();
    }
#undef HGC_LOAD
}
__device__ __forceinline__ void fox_fz_tail(int lane, int wave, const bf16* XN, const bf16* WfzT, const float* bf, float* LFS, const float* ssr, const float* bvec) {
    if (wave < 4) {
        const int g = lane >> 4, l15 = lane & 15; const int rbase = 64 * blockIdx.x + 16 * wave;
        for (int rb = rbase; rb < M; rb += 64 * gridDim.x) {
            f32x4 acc = (f32x4){0.f, 0.f, 0.f, 0.f};
            const bf16* ap = WfzT + l15 * D + 8 * g; const bf16* bp = XN + (size_t)(rb + l15) * D + 8 * g;
#pragma unroll 8
            for (int kc = 0; kc < 32; ++kc) { const bf16x8 a = *(const GAS bf16x8*)(ap + 32 * kc), bb = *(const GAS bf16x8*)(bp + 32 * kc); acc = MFMA16(a, bb, acc); }
            const int row = rb + l15, b = row >> 13, s = row & 8191;
            const float rstd = __builtin_amdgcn_rsqf(ssr[row] * (1.0f / 1024.0f) + EPS);
#pragma unroll
            for (int i = 0; i < 4; ++i) { const int hh = 4 * g + i; const float z = acc[i] * rstd + bvec[b * 4112 + hh] + bf[hh];
                const float lfv = z >= 0.f ? -log1pf(__expf(-z)) : z - log1pf(__expf(z));
                LFS[(size_t)(b * 16 + hh) * T + s] = lfv; }
        }
    }
}
__device__ __forceinline__ void fox_scan(LAS unsigned char* lds, int tid, int lane, int wave, const float* LFS, float* NF) {
    LAS float* wtot = (LAS float*)lds;
    for (int bh = blockIdx.x; bh < 32; bh += gridDim.x) {
        const f32x4* src = (const f32x4*)(LFS + (size_t)bh * T) + tid * 4;
        f32x4 v[4]; float run = 0.f;
#pragma unroll
        for (int j = 0; j < 4; ++j) { v[j] = src[j]; v[j].x += run; v[j].y += v[j].x; v[j].z += v[j].y; v[j].w += v[j].z; run = v[j].w; }
        float inc = run;
#pragma unroll
        for (int o = 1; o < 64; o <<= 1) { const float t = __shfl_up(inc, o); if (lane >= o) inc += t; }
        if (lane == 63) wtot[wave] = inc;
        __syncthreads();
        float off = inc - run;
        for (int w = 0; w < wave; ++w) off += wtot[w];
        const float c = -1.4426950408889634f;
        f32x4* dst = (f32x4*)(NF + (size_t)bh * T) + tid * 4;
#pragma unroll
        for (int j = 0; j < 4; ++j) dst[j] = (v[j] + off) * c;
        __syncthreads();
    }
}


#ifdef DIAG_HG
__device__ __forceinline__ void diag_hg_naive(LAS unsigned char* lds, int tid, const float* LF, const bf16* QOq, const bf16* V, const bf16* GS, const float* gnw, float* DB) {
    LAS float* fl = (LAS float*)lds; LAS float* kl = fl + 128; LAS float* ql = fl + 256; LAS float* ps = fl + 384; LAS float* os = fl + 896;
    const int v = tid & 127, kq = tid >> 7;
    float S[32];
#pragma unroll
    for (int i = 0; i < 32; ++i) S[i] = 0.f;
    for (int t = 0; t < 192; ++t) {
        if (tid < 128) { const float lf = LF[(size_t)t * 1024 + tid]; const float ff = __expf(lf); fl[tid] = ff; kl[tid] = 1.0f - ff; ql[tid] = bf2f(QOq[(size_t)t * 1024 + tid]); }
        __syncthreads();
        const float vt = bf2f(V[(size_t)t * 1024 + v]); float acc = 0.f;
#pragma unroll
        for (int i = 0; i < 32; ++i) { const int k_ = 32 * kq + i; S[i] = fl[k_] * S[i] + kl[k_] * vt; acc += S[i] * ql[k_]; }
        ps[kq * 128 + v] = acc;
        __syncthreads();
        if (tid < 128) os[tid] = ps[tid] + ps[128 + tid] + ps[256 + tid] + ps[384 + tid];
        __syncthreads();
        if (tid < 128) { float ss = 0.f; for (int i = 0; i < 128; ++i) ss += os[i] * os[i];
            DB[t * 128 + tid] = os[tid] * __builtin_amdgcn_rsqf(ss * (1.0f / 128.0f) + EPS) * gnw[tid] * bf2f(GS[(size_t)t * 1024 + tid]); }
        __syncthreads();
    }
}
__device__ __forceinline__ void diag_hg_cmp(LAS unsigned char* lds, int tid, const bf16* O, const float* DB, float* DG) {
    LAS float* r = (LAS float*)lds; float sd = 0.f, ss = 0.f;
    for (int idx = tid + DIAG_T0 * 128; idx < DIAG_T1 * 128; idx += NTHR) { const int t = idx >> 7, v = idx & 127; const float a = DB[idx], b = bf2f(O[(size_t)t * 1024 + v]); sd += (a - b) * (a - b); ss += a * a; }
    sd = wave_sum(sd); ss = wave_sum(ss);
    if ((tid & 63) == 0) { r[(tid >> 6) * 2] = sd; r[(tid >> 6) * 2 + 1] = ss; }
    __syncthreads();
    if (tid == 0) { float a = 0.f, b = 0.f; for (int w = 0; w < 8; ++w) { a += r[2 * w]; b += r[2 * w + 1]; } DG[0] = sqrtf(a / b); }
    __syncthreads();
}
#endif
#ifndef NO_GEMM
#define NO_GEMM 0
#endif
#ifndef REP_SYNC
#define REP_SYNC 1
#endif
#ifndef REP_NORM
#define REP_NORM 1
#endif
#ifndef REP_HGAB
#define REP_HGAB 1
#endif
#ifndef REP_GEMM
#define REP_GEMM 1
#endif
#ifndef REP_P0
#define REP_P0 1
#endif
#ifndef REP_SCAN
#define REP_SCAN 1
#endif
#ifndef ATT_THRL
#define ATT_THRL 64
#endif
#ifndef REP_ATT
#define REP_ATT 1
#endif
#ifndef REP_HGC
#define REP_HGC 1
#endif
#define RLX_AGENT __ATOMIC_RELAXED, __HIP_MEMORY_SCOPE_AGENT
#define XB_TMO      128
#define XB_XCNT(j)  (256  + 64 * (j))
#define XB_XSUB(j)  (1280 + 64 * (j))
#define XB_XGEN(j)  (2304 + 64 * (j))
#define XB_TOP      3328
#define XB_TOPGEN   3392
#define XCD_BAR_WORDS 3456
#define XB_SPIN_CAP (1u << 18)

__device__ __forceinline__ unsigned xb_ld(unsigned* p)              { return __hip_atomic_load(p, __ATOMIC_RELAXED, __HIP_MEMORY_SCOPE_AGENT); }
__device__ __forceinline__ unsigned xb_add(unsigned* p, unsigned v) { return __hip_atomic_fetch_add(p, v, __ATOMIC_RELAXED, __HIP_MEMORY_SCOPE_AGENT); }
__device__ __forceinline__ unsigned xb_xcc_id() { return (unsigned)__builtin_amdgcn_s_getreg((3 << 11) | 20) & 0xFu; }
#define XB_SPIN(cond, bar) do { unsigned _sp = 0; while (cond) { __builtin_amdgcn_s_sleep(1); \
    if ((++_sp & 255u) == 0u) { if (xb_ld(&(bar)[XB_TMO])) break; if (_sp > XB_SPIN_CAP) { atomicAdd(&(bar)[XB_TMO], 1u); break; } } } } while (0)

struct XcdBarrier {
    unsigned* bar; unsigned x;
    volatile LAS unsigned* st;
};

__device__ __forceinline__ XcdBarrier xcd_barrier_post(unsigned* bar, volatile LAS unsigned* st) {
    XcdBarrier b; b.bar = bar; b.x = xb_xcc_id(); b.st = st;
    if (threadIdx.x == 0) (void)xb_add(&bar[XB_XCNT(b.x)], 1u);
    return b;
}
__device__ __forceinline__ void xcd_barrier_complete(unsigned* bar, unsigned x, unsigned& nloc, unsigned& nx) {
    const unsigned G = gridDim.x * gridDim.y * gridDim.z;
    unsigned sum, cnt, mine, sp = 0u;
    for (;;) {
        sum = 0u; cnt = 0u; mine = 0u;
#pragma unroll
        for (unsigned j = 0; j < 16; ++j) { const unsigned c = xb_ld(&bar[XB_XCNT(j)]); sum += c; cnt += (c > 0u) ? 1u : 0u; mine = (j == x) ? c : mine; }
        if (sum == G) break;
        __builtin_amdgcn_s_sleep(1);
        if ((++sp & 255u) == 0u) { if (xb_ld(&bar[XB_TMO])) break; if (sp > XB_SPIN_CAP) { atomicAdd(&bar[XB_TMO], 1u); break; } }
    }
    nloc = mine > 0u ? mine : 1u; nx = cnt > 0u ? cnt : 1u;
}

__device__ __forceinline__ void xcd_barrier(const XcdBarrier& b) {
    asm volatile("s_waitcnt vmcnt(0)" ::: "memory");
    __syncthreads();
    if (threadIdx.x == 0) {
        unsigned* bar = b.bar;
        __builtin_amdgcn_s_waitcnt(0);
        unsigned nloc = b.st[0], nx = b.st[1];
        if (nloc == 0u) { xcd_barrier_complete(bar, b.x, nloc, nx); b.st[0] = nloc; b.st[1] = nx; }
        const unsigned old = xb_add(&bar[XB_XSUB(b.x)], 1u);
        const unsigned gen = old / nloc;
        if (old + 1u == (gen + 1u) * nloc) {
            __builtin_amdgcn_fence(__ATOMIC_RELEASE, "agent");
            asm volatile("s_waitcnt vmcnt(0)" ::: "memory");
            const unsigned og = xb_add(&bar[XB_TOP], 1u);
            const unsigned tg = og / nx;
            if (og + 1u == (tg + 1u) * nx) xb_add(&bar[XB_TOPGEN], 1u);
            else XB_SPIN(xb_ld(&bar[XB_TOPGEN]) == tg, bar);
            __builtin_amdgcn_fence(__ATOMIC_ACQUIRE, "agent");
            xb_add(&bar[XB_XGEN(b.x)], 1u);
            asm volatile("s_waitcnt vmcnt(0)" ::: "memory");
        } else {
            XB_SPIN(xb_ld(&bar[XB_XGEN(b.x)]) == gen, bar);
            __builtin_amdgcn_fence(__ATOMIC_ACQUIRE, "agent");
            asm volatile("s_waitcnt vmcnt(0)" ::: "memory");
        }
    }
    __syncthreads();
}

__global__ void __launch_bounds__(NTHR, 2) fwd_megakernel(Args args) {
    extern __shared__ __attribute__((aligned(16))) unsigned char lds_raw[];
    cg::grid_group grid = cg::this_grid();
    LAS unsigned char* lds = (LAS unsigned char*)lds_raw;
    const int tid = threadIdx.x, lane = tid & 63, wave = __builtin_amdgcn_readfirstlane(tid >> 6);
    const int G = gridDim.x, gw = blockIdx.x * NWAVES + wave, NGW = G * NWAVES;
    volatile LAS unsigned* MISC = (volatile LAS unsigned*)(lds + 131072 + 320);
    if (tid < 32) MISC[tid] = 0u;
    __syncthreads();
    XcdBarrier bar = xcd_barrier_post((unsigned*)(args.ws + WS_BAR), MISC + 8);
#define A_ws (args.ws)
#define A_x (args.in[0])
#define A_c (args.in[1])
#define A_w_mod (args.in[2])
#define A_b_mod (args.in[3])
#define A_norm1_w (args.in[4])
#define A_norm2_w (args.in[5])
#define A_hg_w_in (args.in[6])
#define A_hg_w_out (args.in[7])
#define A_hg_lb (args.in[8])
#define A_hg_gn_w (args.in[9])
#define A_fox_w_in (args.in[10])
#define A_fox_b_f (args.in[11])
#define A_fox_qn_w (args.in[12])
#define A_fox_kn_w (args.in[13])
#define A_fox_w_out (args.in[14])
#define A_mlp_w1 (args.in[15])
#define A_mlp_w2 (args.in[16])
#define A_final_w (args.in[17])
#define A_out (args.out)
#define MOD ((float*)(A_ws + WS_MOD))
#define LB ((float*)(A_ws + WS_LB))
#define WFZ ((bf16*)(A_ws + WS_WFZ))
#define DN ((float*)(A_ws + WS_DN))
#define LFS ((float*)(A_ws + WS_LFS))
#define NF ((float*)(A_ws + WS_NF))
#define QKNW ((float*)(A_ws + WS_QKNW))
#define W_HGIN ((bf16*)(A_ws + WS_W_HGIN))
#define W_HGOUT ((bf16*)(A_ws + WS_W_HGOUT))
#define W_FOXIN ((bf16*)(A_ws + WS_W_FOXIN))
#define W_FOXOUT ((bf16*)(A_ws + WS_W_FOXOUT))
#define W1_0 ((bf16*)(A_ws + WS_W1_0))
#define W2_0 ((bf16*)(A_ws + WS_W2_0))
#define W1_1 ((bf16*)(A_ws + WS_W1_1))
#define W2_1 ((bf16*)(A_ws + WS_W2_1))
#define XN ((bf16*)(A_ws + WS_XN))
#define QO ((bf16*)(A_ws + WS_QO))
#define B1 ((bf16*)(A_ws + WS_B1))
#define B2 ((bf16*)(A_ws + WS_B2))
#define B3 ((bf16*)(A_ws + WS_B3))
#define ST ((bf16*)(A_ws + WS_ST))
#define HB ((bf16*)(A_ws + WS_H))
#define XN2 ((bf16*)(A_ws + WS_XN2))
#define SSQ ((float*)(A_ws + WS_SS))
#define BIASV ((float*)(A_ws + WS_BIASV))
#define GSYNC() do { for (int rs_ = 0; rs_ < REP_SYNC; ++rs_) xcd_barrier(bar); } while (0)
#define GSYNC_CG() do { if (__builtin_expect(args.ws == nullptr, 0)) grid.sync(); xcd_barrier(bar); } while (0)
    for (int rp_ = 0; rp_ < REP_P0; ++rp_) {
        __syncthreads();
        LAS float* sc = (LAS float*)lds;
        LAS float* red = (LAS float*)(lds + 8192);
        for (int it = blockIdx.x; it < 192; it += G) {
            for (int i = tid; i < 2048; i += NTHR) { const float cv = A_c[i]; sc[i] = cv * pg8::sigmoid_f(cv); }
            __syncthreads();
            const int li = it / 96, cgp = it % 96, col = 64 * cgp + lane;
            const float* wp = A_w_mod + ((size_t)li * D + 128 * wave) * 6144 + col;
            float a0 = 0.f, a1 = 0.f;
            for (int k0 = 0; k0 < 128; k0 += 8) {
                float wv[8];
#pragma unroll
                for (int j = 0; j < 8; ++j) wv[j] = wp[(size_t)(k0 + j) * 6144];
#pragma unroll
                for (int j = 0; j < 8; ++j) { a0 += sc[128 * wave + k0 + j] * wv[j]; a1 += sc[1024 + 128 * wave + k0 + j] * wv[j]; }
            }
            red[wave * 128 + lane] = a0; red[wave * 128 + 64 + lane] = a1;
            __syncthreads();
            if (wave == 0) { float s0 = 0.f, s1 = 0.f;
#pragma unroll
                for (int w = 0; w < 8; ++w) { s0 += red[w * 128 + lane]; s1 += red[w * 128 + 64 + lane]; }
                const float bb = A_b_mod[li * 6144 + col];
                MOD[(li * 2 + 0) * 6144 + col] = s0 + bb; MOD[(li * 2 + 1) * 6144 + col] = s1 + bb; }
            __syncthreads();
        }
        if (blockIdx.x == G - 1) {
            for (int i = tid; i < 1024; i += NTHR) { const float a0 = A_hg_lb[i], a1 = A_hg_lb[1024 + i], a2 = A_hg_lb[2048 + i]; const float mx = fmaxf(a0, fmaxf(a1, a2));
                const float e0 = __expf(a0 - mx), e1 = __expf(a1 - mx), e2 = __expf(a2 - mx); LB[i] = e0 / (e0 + e1 + e2); }
        }
        if (blockIdx.x == G - 2) {
            for (int i = tid; i < 16 * 1024; i += NTHR) { const int hh = i >> 10, k = i & 1023; WFZ[i] = (bf16)f2bf(A_fox_w_in[(size_t)k * NIN_FOX + 4096 + hh]); }
            if (tid < 64) { QKNW[tid] = A_fox_qn_w[tid]; QKNW[64 + tid] = A_fox_kn_w[tid]; }
        }
        for (int i = blockIdx.x * NTHR + tid; i < 3 * M; i += G * NTHR) SSQ[i] = 0.f;
        LAS float* scr = (LAS float*)(lds + wave * 16384);
        constexpr int I_A = 16 * 128, I_B = 16 * 32, I_W2 = 64 * 32;
        constexpr int NITEMS = 2 * I_A + 2 * I_B + 2 * I_A + 2 * I_W2;
        for (int it = gw; it < NITEMS; it += NGW) {
            int r = it;
            if (r < I_A) { transpose_item<false>(A_hg_w_in, D, 4096, 4096, W_HGIN, scr, r, lane); continue; } r -= I_A;
            if (r < I_A) { transpose_item<true>(A_fox_w_in, D, NIN_FOX, 4096, W_FOXIN, scr, r, lane); continue; } r -= I_A;
            if (r < I_B) { transpose_item<false>(A_hg_w_out, D, D, D, W_HGOUT, scr, r, lane); continue; } r -= I_B;
            if (r < I_B) { transpose_item<false>(A_fox_w_out, D, D, D, W_FOXOUT, scr, r, lane); continue; } r -= I_B;
            if (r < I_A) { transpose_item<false>(A_mlp_w1, D, FF, FF, W1_0, scr, r, lane); continue; } r -= I_A;
            if (r < I_A) { transpose_item<false>(A_mlp_w1 + (size_t)D * FF, D, FF, FF, W1_1, scr, r, lane); continue; } r -= I_A;
            if (r < I_W2) { transpose_item<false>(A_mlp_w2, FF, D, D, W2_0, scr, r, lane); continue; } r -= I_W2;
            transpose_item<false>(A_mlp_w2 + (size_t)FF * D, FF, D, D, W2_1, scr, r, lane);
        }
    }
    GSYNC_CG();
#define GEMM_PHASE(MODE, Aptr, Bptr, Nn, Kk, EE) GEMM_PHASE_R(1, MODE, Aptr, Bptr, Nn, Kk, EE)
#define GEMM_PHASE_R(RR, MODE, Aptr, Bptr, Nn, Kk, EE) do { for (int rg_ = 0; rg_ < (RR); ++rg_) { pg8::Gemm g_{(const pg8::bf16_t*)(Aptr), (const pg8::bf16_t*)(Bptr), M, (Nn), (Kk)}; pg8::StaticOrder S_; S_.init(M, (Nn), G, (int)blockIdx.x); \
        if (!NO_GEMM) pg8::gemm_phase<pg8::Epi<MODE>, pg8::StaticOrder, true, true>(lds, g_, S_, EE); } } while (0)
    {
        const float* mod = MOD;
        for (int rn_ = 0; rn_ < REP_NORM; ++rn_) norm_rows(gw, NGW, lane, A_x, A_norm1_w, mod + 0, mod + 1024, XN, nullptr);
        for (int t = gw; t < 3 * 4096 + 16; t += NGW) {
            const int gi = t < 3 * 4096 ? t >> 12 : 1, n = t < 3 * 4096 ? (t & 4095) : 4096 + (t - 3 * 4096);
            const bf16* wrow = t >= 3 * 4096 ? WFZ + (size_t)(n - 4096) * D : (gi == 0 ? W1_0 : gi == 1 ? W_FOXIN : W1_1) + (size_t)n * D;
            const float* sh0 = MOD + (gi == 0 ? 3072 : gi == 1 ? 2 * 6144 : 2 * 6144 + 3072);
            float a0 = 0.f, a1 = 0.f;
#pragma unroll
            for (int hh = 0; hh < 2; ++hh) { const v4u wv = *(const GAS v4u*)(wrow + 512 * hh + 8 * lane);
#pragma unroll
                for (int e = 0; e < 4; ++e) { const int k = 512 * hh + 8 * lane + 2 * e; const float w0 = __uint_as_float(wv[e] << 16), w1 = __uint_as_float(wv[e] & 0xffff0000u);
                    a0 += sh0[k] * w0 + sh0[k + 1] * w1; a1 += sh0[6144 + k] * w0 + sh0[6144 + k + 1] * w1; } }
            a0 = wave_sum(a0); a1 = wave_sum(a1);
            if (lane == 0) { BIASV[(gi * 2 + 0) * 4112 + n] = a0; BIASV[(gi * 2 + 1) * 4112 + n] = a1; }
        }
        GSYNC();
        { pg8::Epi<pg8::EPI_HG_IN> E{QO, A_out  , nullptr, LB, 1.f, nullptr, nullptr, nullptr, nullptr, nullptr, nullptr};
          GEMM_PHASE_R(REP_GEMM, pg8::EPI_HG_IN, XN, W_HGIN, 4096, D, E); }
        GSYNC();
        for (int rh_ = 0; rh_ < REP_HGAB; ++rh_) {
        if (rh_) GSYNC();
        hg_pass_a(lds, tid, lane, wave, A_out, B1, ST, DN);
        GSYNC();
        hg_pass_b(tid, ST, DN);
        }
#ifdef DIAG_HG
        if (blockIdx.x == 0) diag_hg_naive(lds, tid, A_out, QO, B1, B2, A_hg_gn_w, (float*)(A_ws + WS_XN));
#endif
        GSYNC();
#ifndef NO_HGC
        for (int rc_ = 0; rc_ < REP_HGC; ++rc_) hg_pass_c(lds, tid, lane, wave, A_out, QO, XN, B1, B2, ST, A_hg_gn_w);
#endif
        GSYNC();
#ifdef DIAG_HG
        if (blockIdx.x == 0) diag_hg_cmp(lds, tid, QO, (const float*)(A_ws + WS_XN), (float*)(A_ws + WS_QKNW + 1024));
#endif
        { pg8::Epi<pg8::EPI_RES> E{nullptr, A_out, A_x, mod + 2048, 1.f, XN2, SSQ + 0 * M, A_norm2_w, mod + 4096, nullptr, nullptr};
          GEMM_PHASE_R(REP_GEMM, pg8::EPI_RES, XN, W_HGOUT, D, D, E); }
        GSYNC();
        { pg8::Epi<pg8::EPI_RELU2> E{HB, nullptr, nullptr, nullptr, 1.f, nullptr, nullptr, nullptr, nullptr, SSQ + 0 * M, BIASV + 0 * 2 * 4112};
          GEMM_PHASE_R(REP_GEMM, pg8::EPI_RELU2, XN2, W1_0, FF, D, E); }
        GSYNC();
        { pg8::Epi<pg8::EPI_RES> E{nullptr, A_out, A_out, mod + 5120, 1.f, XN, SSQ + 1 * M, A_norm1_w + D, MOD + 2 * 6144 + 1024, nullptr, nullptr};
          GEMM_PHASE(pg8::EPI_RES, HB, W2_0, D, FF, E); }
        GSYNC();
    }
    {
        const float* mod = MOD + 2 * 6144;
        { pg8::Epi<pg8::EPI_FOX_IN> E{QO, nullptr, nullptr, QKNW, attn_body::C2, nullptr, nullptr, nullptr, nullptr, SSQ + 1 * M, BIASV + 1 * 2 * 4112};
          GEMM_PHASE_R(REP_GEMM, pg8::EPI_FOX_IN, XN, W_FOXIN, 4096, D, E); }
        for (int rz_ = 0; rz_ < REP_SCAN; ++rz_) fox_fz_tail(lane, wave, XN, WFZ, A_fox_b_f, LFS, SSQ + 1 * M, BIASV + 1 * 2 * 4112 + 4096);
        GSYNC();
        { const attn_body::AttnTensors AT{(const attn_body::bf16*)QO, (const attn_body::bf16*)B1, (const attn_body::bf16*)B2, (attn_body::bf16*)XN, LFS  , (const attn_body::bf16*)B3};
          const attn_body::StaticOrder S((int)G, (int)blockIdx.x);
#ifndef NO_ATTN
          for (int ra_ = 0; ra_ < REP_ATT; ++ra_) attn_body::attn_phase<attn_body::StaticOrder, ATT_THRL>((char*)lds_raw, AT, S);
#endif
        }
        GSYNC();
        { pg8::Epi<pg8::EPI_RES> E{nullptr, A_out, A_out, mod + 2048, 1.f, XN2, SSQ + 2 * M, A_norm2_w + D, mod + 4096, nullptr, nullptr};
          GEMM_PHASE(pg8::EPI_RES, XN, W_FOXOUT, D, D, E); }
        GSYNC();
        { pg8::Epi<pg8::EPI_RELU2> E{HB, nullptr, nullptr, nullptr, 1.f, nullptr, nullptr, nullptr, nullptr, SSQ + 2 * M, BIASV + 2 * 2 * 4112};
          GEMM_PHASE_R(REP_GEMM, pg8::EPI_RELU2, XN2, W1_1, FF, D, E); }
        GSYNC();
        { pg8::Epi<pg8::EPI_RES> E{nullptr, A_out, A_out, mod + 5120, 1.f, nullptr, nullptr, nullptr, nullptr, nullptr, nullptr};
          GEMM_PHASE(pg8::EPI_RES, HB, W2_1, D, FF, E); }
        GSYNC();
    }
    norm_rows(gw, NGW, lane, A_out, A_final_w, nullptr, nullptr, nullptr, A_out);
#if defined(DIAG_HG) || defined(DIAG_ATT)
    GSYNC();
    if (blockIdx.x == 0 && tid == 0) A_out[0] = 1000.0f * (20.0f + log2f(*(const float*)(A_ws + WS_QKNW + 1024) + 1e-9f));
#endif
}

#undef A_ws
#undef A_x
#undef A_c
#undef A_w_mod
#undef A_b_mod
#undef A_norm1_w
#undef A_norm2_w
#undef A_hg_w_in
#undef A_hg_w_out
#undef A_hg_lb
#undef A_hg_gn_w
#undef A_fox_w_in
#undef A_fox_b_f
#undef A_fox_qn_w
#undef A_fox_kn_w
#undef A_fox_w_out
#undef A_mlp_w1
#undef A_mlp_w2
#undef A_final_w
#undef A_out
extern "C" void kernel_launch(void* const* d_in, const int* in_sizes, int n_in, void* d_out, int out_size, void* d_ws, size_t ws_size, hipStream_t stream) {
    static int grid = 0;
    if (grid == 0) {
        if (n_in != 18 || out_size != M * D || ws_size < WS_END) { fprintf(stderr, "kernel_launch: unexpected shapes (n_in %d, out %d, ws %zu)\n", n_in, out_size, ws_size); grid = -1; return; }
        int dev = 0, cus = 0, per_cu = 0;
        hipGetDevice(&dev); hipDeviceGetAttribute(&cus, hipDeviceAttributeMultiprocessorCount, dev);
        if (hipFuncSetAttribute((const void*)fwd_megakernel, hipFuncAttributeMaxDynamicSharedMemorySize, LDS_BYTES) != hipSuccess) { fprintf(stderr, "kernel_launch: hipFuncSetAttribute failed\n"); grid = -1; return; }
        if (hipOccupancyMaxActiveBlocksPerMultiprocessor(&per_cu, (const void*)fwd_megakernel, NTHR, LDS_BYTES) != hipSuccess || per_cu < 1) { fprintf(stderr, "kernel_launch: occupancy query says %d\n", per_cu); per_cu = 1; }
        (void)hipGetLastError();
        grid = cus * 1;
        if (grid != 256) fprintf(stderr, "kernel_launch: %d CUs; built for 256\n", grid);
    }
    if (grid < 0) return;
    if (hipMemsetAsync((char*)d_ws + WS_BAR, 0, BAR_BYTES, stream) != hipSuccess) { fprintf(stderr, "kernel_launch: memset of the barrier words failed\n"); return; }
    Args a{};
    for (int i = 0; i < 18; ++i) a.in[i] = (const float*)d_in[i];
    a.out = (float*)d_out; a.ws = (unsigned char*)d_ws;
    void* kargs[] = {&a};
    hipError_t e = hipLaunchCooperativeKernel((const void*)fwd_megakernel, dim3(grid), dim3(NTHR), kargs, LDS_BYTES, stream);
    if (e != hipSuccess) fprintf(stderr, "cooperative launch failed: %s (grid %d)\n", hipGetErrorString(e), grid);
}
```

```cpp
#include <hip/hip_runtime.h>
#include <hip/hip_cooperative_groups.h>
#include <cstdio>
#include <cstdint>
namespace cg = cooperative_groups;
namespace pg8 {
#define PG8_LAS __attribute__((address_space(3)))
typedef unsigned short bf16_t;
typedef short bf16x8 __attribute__((ext_vector_type(8)));
typedef float f32x4 __attribute__((ext_vector_type(4)));
typedef unsigned u32x4 __attribute__((ext_vector_type(4)));
constexpr int BM = 256, BK = 64, HALF = 128, HTB = HALF * BK * 2  , STAGE_BYTES = 8 * HTB, NXCD = 8, WGM = 8;

__host__ __device__ __forceinline__ int lds_byte(int r, int c) { const int st = (r >> 4) * 2 + (c >> 5), rr = r & 15, cc = c & 31, ob = rr * 64 + cc * 2; return st * 1024 + (ob ^ (((ob >> 9) & 1) << 5)); }
__host__ __device__ __forceinline__ void stage_rc(int b, int& R, int& C) { const int st = b / 1024, sb = b % 1024, swz = sb ^ (((sb >> 9) & 1) << 5); R = (st >> 1) * 16 + swz / 64; C = (st & 1) * 32 + (swz % 64) / 2; }
__host__ __device__ __forceinline__ int perm32(int rho) { const int n = rho >> 4, i = rho & 15; return 8 * (i >> 2) + 4 * n + (i & 3); }

struct Unit { int pm, pn; };
struct Gemm { const bf16_t* A; const bf16_t* Bt; int M, N, K; };

struct StaticOrder {
    int nM, nN, nwg, G, c;
    __host__ __device__ void init(int M, int N, int G_, int c_) { nM = M / BM; nN = N / BM; nwg = nM * nN; G = G_; c = c_; }
    __host__ __device__ bool next(int i, Unit& u) const {
        const long L = (long)i * G + c; if (L >= nwg) return false;
        int wgid = (int)L; { const int q = nwg / NXCD, r = nwg % NXCD, xcd = wgid % NXCD, off = wgid / NXCD; wgid = (xcd < r ? xcd * (q + 1) : r * (q + 1) + (xcd - r) * q) + off; }
        const int nig = WGM * nN, gid = wgid / nig, fm = gid * WGM, gsz = (nM - fm) < WGM ? (nM - fm) : WGM;
        u.pm = fm + ((wgid % nig) % gsz); u.pn = (wgid % nig) / gsz; return true;
    }
    __device__ __forceinline__ void a_ready(const Unit&) const {}
    __device__ __forceinline__ void done(const Unit&) const {}
};

typedef float f32x2_cv __attribute__((ext_vector_type(2))); typedef __bf16 bf16x2_cv __attribute__((ext_vector_type(2)));
__device__ __forceinline__ unsigned cvt_pk_bf16(float lo, float hi) { f32x2_cv v = {lo, hi}; bf16x2_cv b = __builtin_convertvector(v, bf16x2_cv); return __builtin_bit_cast(unsigned, b); }
typedef float f32x2 __attribute__((ext_vector_type(2)));
enum { EPI_HG_IN = 0, EPI_FOX_IN = 1, EPI_RES = 2, EPI_RELU2 = 3 };
__device__ __forceinline__ float sigmoid_f(float z) { return __builtin_amdgcn_rcpf(1.0f + __expf(-z)); }
template <int MODE> struct Epi {
    static constexpr bool PERM = true, AFTER_DRAIN = false;
    bf16_t* o0;
    static constexpr size_t OSTR = (size_t)16 * 1024 * 1024;
    float* f0;
    const float* base;
    const float* p0;
    float qscale;
    bf16_t* xs; float* ss; const float* wn; const float* scp;
    const float* ssr; const float* bvec;
    __device__ __forceinline__ void row_rstd(float (&rs)[2][4], int row0) const {
#pragma unroll
        for (int ai = 0; ai < 2; ++ai)
#pragma unroll
            for (int m = 0; m < 4; ++m) rs[ai][m] = ssr ? __builtin_amdgcn_rsqf(ssr[row0 + ai * HALF + m * 16] * (1.0f / 1024.0f) + 1e-6f) : 1.0f;
    }
    __device__ __forceinline__ void operator()(const f32x4 (&acc)[2][2][4][2], const Unit& u, int wr, int wc, int fr, int fq) const {
        const int row0 = u.pm * BM + wr * 64 + fr;
        if constexpr (MODE == EPI_HG_IN) {
            const int seg = u.pn >> 2, col0 = (u.pn & 3) * BM + wc * 32 + 8 * fq;
            if (seg == 1) {
                f32x4 lbv[2][2];
#pragma unroll
                for (int bj = 0; bj < 2; ++bj)
#pragma unroll
                    for (int n = 0; n < 2; ++n) lbv[bj][n] = *(const f32x4*)(p0 + col0 + bj * HALF + 4 * n);
#pragma unroll
                for (int ai = 0; ai < 2; ++ai)
#pragma unroll
                    for (int m = 0; m < 4; ++m) { float* rowp = f0 + (size_t)(row0 + ai * HALF + m * 16) * 1024 + col0;
#pragma unroll
                        for (int bj = 0; bj < 2; ++bj)
#pragma unroll
                            for (int n = 0; n < 2; ++n) { const f32x4 z = acc[ai][bj][m][n], lb = lbv[bj][n]; f32x4 o;
#pragma unroll
                                for (int e = 0; e < 4; ++e) o[e] = __logf(lb[e] + (1.0f - lb[e]) * sigmoid_f(z[e]));
                                *(f32x4*)(rowp + bj * HALF + 4 * n) = o; } }
            } else {
                bf16_t* ob = o0 + (size_t)(seg == 0 ? 0 : seg - 1) * OSTR;
#pragma unroll
                for (int ai = 0; ai < 2; ++ai)
#pragma unroll
                    for (int m = 0; m < 4; ++m) { bf16_t* rowp = ob + (size_t)(row0 + ai * HALF + m * 16) * 1024 + col0;
#pragma unroll
                        for (int bj = 0; bj < 2; ++bj) { f32x4 v0 = acc[ai][bj][m][0], v1 = acc[ai][bj][m][1];
                            if (seg != 2) {
#pragma unroll
                                for (int e = 0; e < 4; ++e) { v0[e] = v0[e] * sigmoid_f(v0[e]); v1[e] = v1[e] * sigmoid_f(v1[e]); } }
                            u32x4 w; w.x = cvt_pk_bf16(v0[0], v0[1]); w.y = cvt_pk_bf16(v0[2], v0[3]); w.z = cvt_pk_bf16(v1[0], v1[1]); w.w = cvt_pk_bf16(v1[2], v1[3]);
                            *(u32x4*)(rowp + bj * HALF) = w; } }
            }
        } else if constexpr (MODE == EPI_FOX_IN) {
            const int seg = u.pn >> 2, colt = (u.pn & 3) * BM;
            float rs[2][4]; row_rstd(rs, row0);
            f32x4 bb[2][2];
#pragma unroll
            for (int bj = 0; bj < 2; ++bj)
#pragma unroll
                for (int n = 0; n < 2; ++n) bb[bj][n] = bvec ? *(const f32x4*)(bvec + (size_t)(u.pm >> 5) * 4112 + u.pn * BM + bj * HALF + wc * 32 + 8 * fq + 4 * n) : (f32x4){0.f, 0.f, 0.f, 0.f};
#define ACCV(ai, bj, m, n) (acc[ai][bj][m][n] * rs[ai][m] + bb[bj][n])
            if (seg <= 1) {
                const float* w = p0 + 64 * seg; const float sc = seg == 0 ? qscale : 1.0f; bf16_t* ob = o0 + (size_t)seg * OSTR;
                f32x4 wv[2][2];
#pragma unroll
                for (int bj = 0; bj < 2; ++bj)
#pragma unroll
                    for (int n = 0; n < 2; ++n) wv[bj][n] = *(const f32x4*)(w + 32 * bj + 8 * fq + 4 * n);
#pragma unroll
                for (int ai = 0; ai < 2; ++ai)
#pragma unroll
                    for (int m = 0; m < 4; ++m) { float ss = 0.f;
#pragma unroll
                        for (int bj = 0; bj < 2; ++bj)
#pragma unroll
                            for (int n = 0; n < 2; ++n) { const f32x4 x = ACCV(ai, bj, m, n); ss += (x[0] * x[0] + x[1] * x[1]) + (x[2] * x[2] + x[3] * x[3]); }
                        ss += __shfl_xor(ss, 16); ss += __shfl_xor(ss, 32);
                        const float rsn = __builtin_amdgcn_rsqf(ss * (1.0f / 64.0f) + 1e-6f) * sc;
                        bf16_t* rowp = ob + (size_t)(row0 + ai * HALF + m * 16) * 1024 + colt + 64 * wc + 8 * fq;
#pragma unroll
                        for (int bj = 0; bj < 2; ++bj) { const f32x4 v0 = ACCV(ai, bj, m, 0) * rsn * wv[bj][0], v1 = ACCV(ai, bj, m, 1) * rsn * wv[bj][1];
                            u32x4 ww; ww.x = cvt_pk_bf16(v0[0], v0[1]); ww.y = cvt_pk_bf16(v0[2], v0[3]); ww.z = cvt_pk_bf16(v1[0], v1[1]); ww.w = cvt_pk_bf16(v1[2], v1[3]);
                            *(u32x4*)(rowp + 32 * bj) = ww; } }
            } else {
                bf16_t* ob = o0 + (size_t)seg * OSTR; const int col0 = colt + wc * 32 + 8 * fq;
#pragma unroll
                for (int ai = 0; ai < 2; ++ai)
#pragma unroll
                    for (int m = 0; m < 4; ++m) { bf16_t* rowp = ob + (size_t)(row0 + ai * HALF + m * 16) * 1024 + col0;
#pragma unroll
                        for (int bj = 0; bj < 2; ++bj) { f32x4 v0 = ACCV(ai, bj, m, 0), v1 = ACCV(ai, bj, m, 1);
                            if (seg == 3) {
#pragma unroll
                                for (int e = 0; e < 4; ++e) { v0[e] = sigmoid_f(v0[e]); v1[e] = sigmoid_f(v1[e]); } }
                            u32x4 w; w.x = cvt_pk_bf16(v0[0], v0[1]); w.y = cvt_pk_bf16(v0[2], v0[3]); w.z = cvt_pk_bf16(v1[0], v1[1]); w.w = cvt_pk_bf16(v1[2], v1[3]);
                            *(u32x4*)(rowp + bj * HALF) = w; } }
            }
#undef ACCV
        } else if constexpr (MODE == EPI_RES) {
            const int col0 = u.pn * BM + wc * 32 + 8 * fq; const float* gp = p0 + (size_t)(u.pm >> 5) * 6144 + col0;
            f32x4 gv[2][2], wm[2][2];
#pragma unroll
            for (int bj = 0; bj < 2; ++bj)
#pragma unroll
                for (int n = 0; n < 2; ++n) { gv[bj][n] = *(const f32x4*)(gp + bj * HALF + 4 * n);
                    wm[bj][n] = xs ? *(const f32x4*)(wn + col0 + bj * HALF + 4 * n) * (*(const f32x4*)(scp + (size_t)(u.pm >> 5) * 6144 + col0 + bj * HALF + 4 * n) + 1.0f) : (f32x4){0.f, 0.f, 0.f, 0.f}; }
#pragma unroll
            for (int ai = 0; ai < 2; ++ai)
#pragma unroll
                for (int m = 0; m < 4; ++m) { const size_t off = (size_t)(row0 + ai * HALF + m * 16) * 1024 + col0; float q = 0.f;
#pragma unroll
                    for (int bj = 0; bj < 2; ++bj) { const f32x4 bs0 = *(const f32x4*)(base + off + bj * HALF), bs1 = *(const f32x4*)(base + off + bj * HALF + 4);
                        const f32x4 x0 = bs0 + gv[bj][0] * acc[ai][bj][m][0], x1 = bs1 + gv[bj][1] * acc[ai][bj][m][1];
                        *(f32x4*)(f0 + off + bj * HALF) = x0; *(f32x4*)(f0 + off + bj * HALF + 4) = x1;
                        if (xs) {
                            q += (x0[0] * x0[0] + x0[1] * x0[1]) + (x0[2] * x0[2] + x0[3] * x0[3]) + (x1[0] * x1[0] + x1[1] * x1[1]) + (x1[2] * x1[2] + x1[3] * x1[3]);
                            const f32x4 y0 = x0 * wm[bj][0], y1 = x1 * wm[bj][1];
                            u32x4 w; w.x = cvt_pk_bf16(y0[0], y0[1]); w.y = cvt_pk_bf16(y0[2], y0[3]); w.z = cvt_pk_bf16(y1[0], y1[1]); w.w = cvt_pk_bf16(y1[2], y1[3]);
                            *(u32x4*)(xs + off + bj * HALF) = w; } }
                    if (xs) { q += __shfl_xor(q, 16); q += __shfl_xor(q, 32);
                        if (fq == 0) atomicAdd(ss + row0 + ai * HALF + m * 16, q); } }
        } else {
            const int col0 = u.pn * BM + wc * 32 + 8 * fq;
            float rs[2][4]; row_rstd(rs, row0);
            f32x4 bb[2][2];
#pragma unroll
            for (int bj = 0; bj < 2; ++bj)
#pragma unroll
                for (int n = 0; n < 2; ++n) bb[bj][n] = bvec ? *(const f32x4*)(bvec + (size_t)(u.pm >> 5) * 4112 + col0 + bj * HALF + 4 * n) : (f32x4){0.f, 0.f, 0.f, 0.f};
#pragma unroll
            for (int ai = 0; ai < 2; ++ai)
#pragma unroll
                for (int m = 0; m < 4; ++m) { bf16_t* rowp = o0 + (size_t)(row0 + ai * HALF + m * 16) * 4096 + col0;
#pragma unroll
                    for (int bj = 0; bj < 2; ++bj) { f32x4 v0 = acc[ai][bj][m][0] * rs[ai][m] + bb[bj][0], v1 = acc[ai][bj][m][1] * rs[ai][m] + bb[bj][1];
#pragma unroll
                        for (int e = 0; e < 4; ++e) { const float a = fmaxf(v0[e], 0.f), b = fmaxf(v1[e], 0.f); v0[e] = a * a; v1[e] = b * b; }
                        u32x4 w; w.x = cvt_pk_bf16(v0[0], v0[1]); w.y = cvt_pk_bf16(v0[2], v0[3]); w.z = cvt_pk_bf16(v1[0], v1[1]); w.w = cvt_pk_bf16(v1[2], v1[3]);
                        *(u32x4*)(rowp + bj * HALF) = w; } }
        }
    }
};
template <class Epi, class Sched, bool ALIGN_EPI = false, bool SP2 = false>
__device__ __forceinline__ void gemm_phase(PG8_LAS unsigned char* lds, const Gemm g, const Sched& S, const Epi& E) {
    int tid_ = threadIdx.x; asm volatile("" : "+v"(tid_));
    const int tid = tid_, wid = __builtin_amdgcn_readfirstlane(tid >> 6), lane = tid & 63, wr = wid >> 2, wc = wid & 3, fr = lane & 15, fq = lane >> 4;
    const int K = g.K, nt = K / BK;
    unsigned voffA[2], voffB[2];
#pragma unroll
    for (int i = 0; i < 2; ++i) { int R, C; stage_rc(tid * 16 + i * 8192, R, C); const int Rb = Epi::PERM ? ((R & ~31) + perm32(R & 31)) : R;
        voffA[i] = (unsigned)(R * K + C) * 2u; voffB[i] = (unsigned)(Rb * K + C) * 2u; }
    const size_t kstep = (size_t)(BK * 2);
    const size_t hstep = (size_t)HALF * K * 2;
    const size_t tstep = 2 * hstep;
    const unsigned ldsw = (unsigned)wid * 1024u;
    const int aoff = lds_byte(wr * 64 + fr, fq * 8), boff = lds_byte(wc * 32 + fr, fq * 8);
#define PG8_SA(b, h) (((b) * 2 + (h)) * HTB)
#define PG8_SB(b, h) ((4 + (b) * 2 + (h)) * HTB)
#define PG8_STAGE(bufoff, gbase, voff) do { _Pragma("unroll") for (int _i = 0; _i < 2; ++_i) \
        __builtin_amdgcn_global_load_lds((const unsigned*)((const char*)(gbase) + (voff)[_i]), (PG8_LAS unsigned*)(lds + (bufoff) + ldsw + _i * 8192), 16, 0, 0); } while (0)
#define PG8_LDA(dst, b, h) do { _Pragma("unroll") for (int m = 0; m < 4; ++m) _Pragma("unroll") for (int k = 0; k < 2; ++k) dst[m][k] = *(const PG8_LAS bf16x8*)(lds + PG8_SA(b, h) + aoff + m * 2048 + k * 1024); } while (0)
#define PG8_LDB(dst, b, h) do { _Pragma("unroll") for (int n = 0; n < 2; ++n) _Pragma("unroll") for (int k = 0; k < 2; ++k) dst[n][k] = *(const PG8_LAS bf16x8*)(lds + PG8_SB(b, h) + boff + n * 2048 + k * 1024); } while (0)
#define PG8_MMA(ai, bj, At, Bt) do { __builtin_amdgcn_s_setprio(1); _Pragma("unroll") for (int m = 0; m < 4; ++m) _Pragma("unroll") for (int n = 0; n < 2; ++n) _Pragma("unroll") for (int k = 0; k < 2; ++k) \
        acc[ai][bj][m][n] = __builtin_amdgcn_mfma_f32_16x16x32_bf16(Bt[n][k], At[m][k], acc[ai][bj][m][n], 0, 0, 0); __builtin_amdgcn_s_setprio(0); } while (0)
#define PG8_WAIT_V(n) asm volatile("s_waitcnt vmcnt(" #n ")" ::: "memory")
#define PG8_WAIT_L(n) asm volatile("s_waitcnt lgkmcnt(" #n ")" ::: "memory")
#define PG8_BAR __builtin_amdgcn_s_barrier()
#define PG8_SCHED __builtin_amdgcn_sched_barrier(0)
    Unit cur, nxt; int ui = 0;
    if (!S.next(0, cur)) return;
    f32x4 acc[2][2][4][2];
#pragma unroll
    for (int a = 0; a < 2; ++a)
#pragma unroll
        for (int b = 0; b < 2; ++b)
#pragma unroll
            for (int m = 0; m < 4; ++m)
#pragma unroll
                for (int n = 0; n < 2; ++n) acc[a][b][m][n] = (f32x4){0.f, 0.f, 0.f, 0.f};
    bf16x8 At[4][2], B0[2][2], B1[2][2];
    const char* cA = (const char*)g.A + (size_t)cur.pm * tstep; const char* cB = (const char*)g.Bt + (size_t)cur.pn * tstep;
    S.a_ready(cur);
    if constexpr (SP2) {
        PG8_STAGE(PG8_SB(0, 0), cB, voffB); PG8_STAGE(PG8_SB(0, 1), cB + hstep, voffB); PG8_STAGE(PG8_SA(0, 0), cA, voffA); PG8_STAGE(PG8_SA(0, 1), cA + hstep, voffA);
        if (wr == 1) PG8_BAR;
        PG8_WAIT_V(2); PG8_BAR;
        PG8_STAGE(PG8_SB(1, 0), cB + kstep, voffB); PG8_STAGE(PG8_SA(1, 0), cA + kstep, voffA); PG8_STAGE(PG8_SB(1, 1), cB + hstep + kstep, voffB);
        PG8_WAIT_V(6); PG8_BAR;
    } else {
        PG8_STAGE(PG8_SB(0, 0), cB, voffB); PG8_STAGE(PG8_SA(0, 0), cA, voffA); PG8_STAGE(PG8_SB(0, 1), cB + hstep, voffB); PG8_STAGE(PG8_SA(0, 1), cA + hstep, voffA);
        if (wr == 1) PG8_BAR;
        PG8_WAIT_V(4); PG8_BAR;
        PG8_STAGE(PG8_SB(1, 0), cB + kstep, voffB); PG8_STAGE(PG8_SA(1, 0), cA + kstep, voffA); PG8_STAGE(PG8_SB(1, 1), cB + hstep + kstep, voffB);
        PG8_WAIT_V(6); PG8_BAR;
    }
    for (;;) {
        const bool has_next = S.next(ui + 1, nxt);
        const char* nA = has_next ? (const char*)g.A + (size_t)nxt.pm * tstep : cA; const char* nB = has_next ? (const char*)g.Bt + (size_t)nxt.pn * tstep : cB;
        for (int t = 0; t < nt; t += 2) {
            const bool last = (t == nt - 2);
            const char* a1 = cA + (size_t)(t + 1) * kstep;
            const char* a2 = last ? nA : cA + (size_t)(t + 2) * kstep; const char* b2 = last ? nB : cB + (size_t)(t + 2) * kstep;
            const char* a3 = a2 + kstep; const char* b3 = b2 + kstep;
            if (last && has_next) S.a_ready(nxt);
            if constexpr (SP2) {
            PG8_LDB(B0, 0, 0); PG8_LDB(B1, 0, 1); PG8_SCHED; PG8_LDA(At, 0, 0); PG8_STAGE(PG8_SA(1, 1), a1 + hstep, voffA);
            PG8_WAIT_V(8); PG8_WAIT_L(0); PG8_BAR; PG8_MMA(0, 0, At, B0); PG8_MMA(0, 1, At, B1); PG8_BAR; PG8_SCHED;
            PG8_LDA(At, 0, 1); PG8_STAGE(PG8_SB(0, 0), b2, voffB); PG8_STAGE(PG8_SB(0, 1), b2 + hstep, voffB); PG8_STAGE(PG8_SA(0, 0), a2, voffA);
            PG8_WAIT_V(8); PG8_WAIT_L(0); PG8_BAR; PG8_MMA(1, 0, At, B0); PG8_MMA(1, 1, At, B1); PG8_BAR; PG8_SCHED;
            PG8_LDB(B0, 1, 0); PG8_LDB(B1, 1, 1); PG8_SCHED; PG8_LDA(At, 1, 0); PG8_STAGE(PG8_SA(0, 1), a2 + hstep, voffA);
            PG8_WAIT_V(8); PG8_WAIT_L(0); PG8_BAR; PG8_MMA(0, 0, At, B0); PG8_MMA(0, 1, At, B1); PG8_BAR; PG8_SCHED;
            PG8_LDA(At, 1, 1); PG8_STAGE(PG8_SB(1, 0), b3, voffB); PG8_STAGE(PG8_SB(1, 1), b3 + hstep, voffB); PG8_STAGE(PG8_SA(1, 0), a3, voffA);
            PG8_WAIT_V(8); PG8_WAIT_L(0); PG8_BAR; PG8_MMA(1, 0, At, B0); PG8_MMA(1, 1, At, B1); PG8_BAR; PG8_SCHED;
            } else {
            PG8_LDB(B0, 0, 0); PG8_SCHED; PG8_LDA(At, 0, 0); PG8_STAGE(PG8_SA(1, 1), a1 + hstep, voffA);
            PG8_WAIT_L(8); PG8_BAR; PG8_WAIT_L(0); PG8_MMA(0, 0, At, B0); PG8_BAR; PG8_SCHED;
            PG8_LDB(B1, 0, 1); PG8_STAGE(PG8_SB(0, 0), b2, voffB);
            PG8_BAR; PG8_WAIT_L(0); PG8_MMA(0, 1, At, B1); PG8_BAR;
            PG8_LDA(At, 0, 1); PG8_STAGE(PG8_SA(0, 0), a2, voffA);
            PG8_BAR; PG8_WAIT_L(0); PG8_MMA(1, 0, At, B0); PG8_BAR; PG8_SCHED;
            PG8_STAGE(PG8_SB(0, 1), b2 + hstep, voffB);
            PG8_WAIT_V(6); PG8_BAR; PG8_MMA(1, 1, At, B1); PG8_BAR;
            PG8_LDB(B0, 1, 0); PG8_SCHED; PG8_LDA(At, 1, 0); PG8_STAGE(PG8_SA(0, 1), a2 + hstep, voffA);
            PG8_WAIT_L(8); PG8_BAR; PG8_WAIT_L(0); PG8_MMA(0, 0, At, B0); PG8_BAR; PG8_SCHED;
            PG8_LDB(B1, 1, 1); PG8_STAGE(PG8_SB(1, 0), b3, voffB);
            PG8_BAR; PG8_WAIT_L(0); PG8_MMA(0, 1, At, B1); PG8_BAR;
            PG8_LDA(At, 1, 1); PG8_STAGE(PG8_SA(1, 0), a3, voffA);
            PG8_BAR; PG8_WAIT_L(0); PG8_MMA(1, 0, At, B0); PG8_BAR; PG8_SCHED;
            PG8_STAGE(PG8_SB(1, 1), b3 + hstep, voffB);
            PG8_WAIT_V(6); PG8_BAR; PG8_MMA(1, 1, At, B1); PG8_BAR;
            }
        }
        if constexpr (ALIGN_EPI) { if (wr == 0) PG8_BAR; }
        if constexpr (!Epi::AFTER_DRAIN) { E(acc, cur, wr, wc, fr, fq); S.done(cur); }
        if (!has_next) break;
#pragma unroll
        for (int a = 0; a < 2; ++a)
#pragma unroll
            for (int b = 0; b < 2; ++b)
#pragma unroll
                for (int m = 0; m < 4; ++m)
#pragma unroll
                    for (int n = 0; n < 2; ++n) acc[a][b][m][n] = (f32x4){0.f, 0.f, 0.f, 0.f};
        cur = nxt; cA = nA; cB = nB; ++ui;
        if constexpr (ALIGN_EPI) { if (wr == 1) PG8_BAR; }
    }
    PG8_WAIT_V(0);
    if constexpr (!ALIGN_EPI) { if (wr == 0) PG8_BAR; }
    PG8_BAR;
    if constexpr (Epi::AFTER_DRAIN) { E.fused(acc, cur, wr, wc, fr, fq, lds, wid, lane); S.done(cur); }
#undef PG8_SA
#undef PG8_SB
#undef PG8_STAGE
#undef PG8_LDA
#undef PG8_LDB
#undef PG8_MMA
#undef PG8_WAIT_V
#undef PG8_WAIT_L
#undef PG8_BAR
#undef PG8_SCHED
}
}
#include <hip/hip_bf16.h>
#include <cmath>
namespace attn_body {
using bf16=__hip_bfloat16;
using bf16x8=__attribute__((ext_vector_type(8)))short;
using s16x4=__attribute__((ext_vector_type(4)))short;
using f32x16=__attribute__((ext_vector_type(16)))float;
using u32x4=__attribute__((ext_vector_type(4)))unsigned;
constexpr int BATCH=2,NHEAD=16,SEQ=8192,D=64,DM=NHEAD*D;
constexpr int NW=8,QBLK=32,QB=QBLK*NW,KVBLK=64,NQB=SEQ/QB;
constexpr int ATTN_PITCH=DM, ATTN_UNIT_ROWS=QB;
__device__ __forceinline__ int crow(int r,int hi){return (r&3)+8*(r>>2)+4*hi;}
#define SBAR() __builtin_amdgcn_sched_barrier(0)
__device__ __forceinline__ void cmask(f32x16&p0,f32x16&p1,int jb,int qrel,int hi){
  const float NEG=-INFINITY; int qd=qrel-64*jb-4*hi; asm volatile("":"+v"(qd));
  #pragma unroll
  for(int r=0;r<16;++r){ if((r&3)+8*(r>>2)>qd)p0[r]=NEG; if((r&3)+8*(r>>2)+32>qd)p1[r]=NEG;}
}

constexpr int NSLOT=3, SLOTB=8192;
constexpr int LDS_K=0, LDS_V=NSLOT*SLOTB, LDS_WS=2*NSLOT*SLOTB, LDS_OST=LDS_WS+NW*64*4, LDS_NF=LDS_OST+NW*4096, LDS_BYTES=LDS_NF+SEQ*4;
constexpr float C2=0.125f*1.4426950408889634f;
__device__ __forceinline__ void glds16(const void*gsrc,unsigned lds_dst){unsigned keep;
  asm volatile("s_mov_b32 %0, m0\n\ts_mov_b32 m0, %2\n\ts_nop 0\n\tglobal_load_lds_dwordx4 %1, off\n\ts_mov_b32 m0, %0":"=&s"(keep):"v"(gsrc),"s"(lds_dst):"memory");}
__device__ __forceinline__ float max3f(float a,float b,float c){float r;asm("v_max3_f32 %0, %1, %2, %3":"=v"(r):"v"(a),"v"(b),"v"(c));return r;}
__device__ __forceinline__ float max2f(float a,float b){float r;asm("v_max_f32_e32 %0, %1, %2":"=v"(r):"v"(a),"v"(b));return r;}
__device__ __forceinline__ float fadd_s(float a,float b){float r;asm("v_add_f32_e32 %0, %1, %2":"=v"(r):"v"(a),"v"(b));return r;}
__device__ __forceinline__ float fsub_s(float a,float b){float r;asm("v_sub_f32_e32 %0, %1, %2":"=v"(r):"v"(a),"v"(b));return r;}
typedef float f32x2_t __attribute__((ext_vector_type(2))); typedef __bf16 bf16x2_t __attribute__((ext_vector_type(2)));
__device__ __forceinline__ unsigned cvtpk_s(float lo,float hi){f32x2_t v={lo,hi};bf16x2_t b=__builtin_convertvector(v,bf16x2_t);return __builtin_bit_cast(unsigned,b);}
#define WAIT_BAR(N) asm volatile("s_waitcnt vmcnt(" #N ") lgkmcnt(0)\n\ts_barrier":::"memory")

__device__ __forceinline__ void qkt(f32x16&p0,f32x16&p1,const char*Kslot,const bf16x8*qr,const f32x16&negm,int r32,int hi){
  const char*kb=Kslot+hi*1024+r32*16;
  #pragma unroll
  for(int d0=0;d0<4;++d0){
    const bf16x8 b0=*reinterpret_cast<const bf16x8*>(kb+d0*2048);
    const bf16x8 b1=*reinterpret_cast<const bf16x8*>(kb+d0*2048+512);
    if(d0==0){p0=__builtin_amdgcn_mfma_f32_32x32x16_bf16(b0,qr[0],negm,0,0,0);p1=__builtin_amdgcn_mfma_f32_32x32x16_bf16(b1,qr[0],negm,0,0,0);}
    else{p0=__builtin_amdgcn_mfma_f32_32x32x16_bf16(b0,qr[d0],p0,0,0,0);p1=__builtin_amdgcn_mfma_f32_32x32x16_bf16(b1,qr[d0],p1,0,0,0);}}
}
typedef __attribute__((address_space(3))) const char* lds_cptr;
typedef short v4i16_t __attribute__((ext_vector_type(4)));
__device__ __forceinline__ void kload8(bf16x8*kf,lds_cptr kp){
  kf[0]=*(const __attribute__((address_space(3))) bf16x8*)(kp);      kf[1]=*(const __attribute__((address_space(3))) bf16x8*)(kp+512);
  kf[2]=*(const __attribute__((address_space(3))) bf16x8*)(kp+2048); kf[3]=*(const __attribute__((address_space(3))) bf16x8*)(kp+2560);
  kf[4]=*(const __attribute__((address_space(3))) bf16x8*)(kp+4096); kf[5]=*(const __attribute__((address_space(3))) bf16x8*)(kp+4608);
  kf[6]=*(const __attribute__((address_space(3))) bf16x8*)(kp+6144); kf[7]=*(const __attribute__((address_space(3))) bf16x8*)(kp+6656);
}
__device__ __forceinline__ void kload2(bf16x8*kf,lds_cptr kp,int j){ kf[2*j]=*(const __attribute__((address_space(3))) bf16x8*)(kp+j*2048); kf[2*j+1]=*(const __attribute__((address_space(3))) bf16x8*)(kp+j*2048+512); }
__device__ __forceinline__ s16x4 vtr(lds_cptr p){ return __builtin_bit_cast(s16x4,__builtin_amdgcn_ds_read_tr16_b64_v4i16((__attribute__((address_space(3))) v4i16_t*)p)); }
__device__ __forceinline__ float rowmax(const f32x16&p0,const f32x16&p1){
  float a=max3f(p0[0],p0[1],p1[0]),b=max3f(p0[2],p0[3],p1[1]);a=max3f(a,p1[2],p1[3]);
  #pragma unroll
  for(int r=4;r<16;r+=4){a=max3f(a,p0[r],p0[r+1]);b=max3f(b,p0[r+2],p0[r+3]);a=max3f(a,p1[r],p1[r+1]);b=max3f(b,p1[r+2],p1[r+3]);}
  const float m=max2f(a,b);
  auto rr=__builtin_amdgcn_permlane32_swap(__float_as_uint(m),__float_as_uint(m),false,false);
  return max2f(__uint_as_float(rr[0]),__uint_as_float(rr[1]));
}
__device__ __forceinline__ void pv(f32x16*o,int vb,bf16x8 pa0,bf16x8 pa1,bf16x8 pa2,bf16x8 pa3){
  #pragma unroll
  for(int d0=0;d0<2;++d0){s16x4 lo[4],hi[4];
    #pragma unroll
    for(int ks=0;ks<4;++ks){
      asm volatile("ds_read_b64_tr_b16 %0,%1 offset:%c2":"=&v"(lo[ks]):"v"(vb),"i"(d0*4096+ks*1024):"memory");
      asm volatile("ds_read_b64_tr_b16 %0,%1 offset:%c2":"=&v"(hi[ks]):"v"(vb),"i"(d0*4096+ks*1024+512):"memory");}
    asm volatile("s_waitcnt lgkmcnt(0)":::"memory");SBAR();
    #define PK(k) (bf16x8){lo[k][0],lo[k][1],lo[k][2],lo[k][3],hi[k][0],hi[k][1],hi[k][2],hi[k][3]}
    o[d0]=__builtin_amdgcn_mfma_f32_32x32x16_bf16(pa0,PK(0),o[d0],0,0,0);
    o[d0]=__builtin_amdgcn_mfma_f32_32x32x16_bf16(pa1,PK(1),o[d0],0,0,0);
    o[d0]=__builtin_amdgcn_mfma_f32_32x32x16_bf16(pa2,PK(2),o[d0],0,0,0);
    o[d0]=__builtin_amdgcn_mfma_f32_32x32x16_bf16(pa3,PK(3),o[d0],0,0,0);
    #undef PK
  }
}

#ifndef ATTN_STORE16
#define ATTN_STORE16(p,v) (*(u32x4*)(p)=(v))
#endif
typedef float f32x4_t __attribute__((ext_vector_type(4))); typedef float f32x2_p __attribute__((ext_vector_type(2)));
template<int THRL> __device__ __forceinline__ void attn_unit(int b,int h,int qb,const bf16*Q,const bf16*__restrict__ K,const bf16*__restrict__ V,bf16*O,const float*__restrict__ NFg,const bf16*__restrict__ SG,char*shm){
  int tid_=threadIdx.x; asm volatile("":"+v"(tid_)); const int tid=tid_,lane=tid&63,r32=lane&31,hi=lane>>5; const int wid=__builtin_amdgcn_readfirstlane(tid>>6);
  const long rowbase=(long)b*SEQ; const int q0=qb*QB;
  const bf16*Qw=Q+(rowbase+q0+wid*QBLK)*DM+h*D;
  const bf16*Kh=K+rowbase*DM+h*D,*Vh=V+rowbase*DM+h*D;
  const unsigned lds0=(unsigned)(uintptr_t)shm;
  float*wsf=(float*)(shm+LDS_WS)+wid*64;
  const bf16*ksrc=Kh+(long)lane*DM+wid*8;
  const bf16*vsrc=Vh+(long)(16*(wid&3)+(lane>>2))*DM+(wid>>2)*32+(lane&3)*8;
  const unsigned kdst=lds0+LDS_K+wid*1024, vdst=lds0+LDS_V+wid*1024;
  #define DMA_K(t,slot) glds16(ksrc+(long)(t)*KVBLK*DM,(unsigned)__builtin_amdgcn_readfirstlane(kdst+(slot)))
  #define DMA_V(t,slot) glds16(vsrc+(long)(t)*KVBLK*DM,(unsigned)__builtin_amdgcn_readfirstlane(vdst+(slot)))
  const int vb0=(int)(lds0+LDS_V)+((lane>>4)&1)*32+(lane&3)*8+(4*hi+((lane&15)>>2))*64;
  const char*Kbase=shm+LDS_K; bf16x8 kf[8];
  const lds_cptr shm3=(lds_cptr)shm; const lds_cptr kp0=shm3+LDS_K+hi*1024+r32*16; const lds_cptr vp0=shm3+LDS_V+((lane>>4)&1)*32+(lane&3)*8+(4*hi+((lane&15)>>2))*64;
  const int NT=(q0+QB)/KVBLK;
  #define PKADD(P,B,x,y) do{ f32x2_p t_={P[B],P[(B)+1]}; t_+=(f32x2_p){x,y}; P[B]=t_[0]; P[(B)+1]=t_[1]; }while(0)
  #define BIAS(P0,P1,t) do{ const __attribute__((address_space(3))) f32x4_t*nb_=(const __attribute__((address_space(3))) f32x4_t*)(shm3+LDS_NF+(t)*256+hi*16); \
    _Pragma("unroll") for(int j_=0;j_<4;++j_){ const f32x4_t a_=nb_[2*j_]; PKADD(P0,4*j_,a_[0],a_[1]); PKADD(P0,4*j_+2,a_[2],a_[3]); } SBAR(); \
    _Pragma("unroll") for(int j_=0;j_<4;++j_){ const f32x4_t b_=nb_[2*j_+8]; PKADD(P1,4*j_,b_[0],b_[1]); PKADD(P1,4*j_+2,b_[2],b_[3]); } SBAR(); }while(0)
  DMA_K(0,0);DMA_V(0,0);DMA_K(1,SLOTB);
  bf16x8 qr[4];
  #pragma unroll
  for(int d0=0;d0<4;++d0)qr[d0]=*reinterpret_cast<const bf16x8*>(&Qw[(long)r32*DM+d0*16+hi*8]);
  float mhat=0.f,l_reg=0.f;f32x16 o[2];o[0]=f32x16{};o[1]=f32x16{};f32x16 negm=f32x16{};asm volatile("":"+v"(negm));
  const int qrel=wid*QBLK+r32;
  #define CMASK(P0,P1,t) do{int jb_=(t)-(NT-4); if(jb_>=0)cmask(P0,P1,jb_,qrel,hi);}while(0)
  bool resc=false;
  #define START(P0,P1) do{ const float rm=rowmax(P0,P1); resc=false; \
    { const float dl=rm; mhat=fadd_s(mhat,dl); \
      _Pragma("unroll") for(int r=0;r<16;++r){P0[r]=fsub_s(P0[r],dl);P1[r]=fsub_s(P1[r],dl);} \
      _Pragma("unroll") for(int r=0;r<16;++r)negm[r]=-mhat; asm volatile("":"+v"(negm)); } \
    _Pragma("unroll") for(int r=0;r<16;++r)P0[r]=__builtin_amdgcn_exp2f(P0[r]); }while(0)
  #define RESC() do{ if(resc){ asm volatile("s_waitcnt lgkmcnt(0)":::"memory"); \
      _Pragma("unroll") for(int d_=0;d_<2;++d_) _Pragma("unroll") for(int r=0;r<16;++r)o[d_][r]*=wsf[crow(r,hi)]; } }while(0)
  f32x16 pA0,pA1,pB0,pB1;
  int sl_prev=0,sl_cur=0,sl_next=SLOTB;
  #define ROT() do{sl_prev=sl_cur;sl_cur=sl_next;sl_next=(sl_next==(NSLOT-1)*SLOTB)?0:sl_next+SLOTB;}while(0)
  DMA_K(2,2*SLOTB);
  WAIT_BAR(3);
  qkt(pA0,pA1,Kbase,qr,negm,r32,hi);asm volatile("s_nop 15\n\ts_nop 7":"+v"(pA0),"+v"(pA1));BIAS(pA0,pA1,0);CMASK(pA0,pA1,0);
  START(pA0,pA1);
  _Pragma("unroll") for(int r=0;r<16;++r)pA1[r]=__builtin_amdgcn_exp2f(pA1[r]);
  WAIT_BAR(0);
  DMA_K(3,0);DMA_V(1,SLOTB);
  ROT();
  kload8(kf,kp0+sl_cur);
  WAIT_BAR(2);
  s16x4 vlo[8],vhi[8]; u32x4 pw0,pw1,pw2,pw3;
  #define PKW(P,B) cvtpk_s(P[B],P[B+1])
  #define PAF(k) __builtin_bit_cast(bf16x8,pw##k)
  #define VFR(i) (bf16x8){vlo[i][0],vlo[i][1],vlo[i][2],vlo[i][3],vhi[i][0],vhi[i][1],vhi[i][2],vhi[i][3]}
  #define PIN(x) asm volatile("":"+v"(x))
  #define MX3(a,b,c) __builtin_fmaxf(__builtin_fmaxf((a),(b)),(c))
  #define GAPA(MF,A0,A1,A2,A3,W0,W1,PW) do{ MF; sacc+=A0; sacc+=A1; sacc+=A2; sacc+=A3; PIN(sacc); W0; W1; PIN(PW); SBAR(); }while(0)
  #define EX(v) __builtin_amdgcn_exp2f(v)
  #define GAPB(MF,X,B) do{ MF; X[B]=EX(X[B]); X[B+1]=EX(X[B+1]); X[B+2]=EX(X[B+2]); X[B+3]=EX(X[B+3]); PIN(X); SBAR(); }while(0)
  #define VRD(i) do{ vlo[i]=vtr(vp_+(((i)>>2)*4096+((i)&3)*1024)); vhi[i]=vtr(vp_+(((i)>>2)*4096+((i)&3)*1024+512)); }while(0)
  #define KRD(G,j) do{ if(G){ kload2(kf,kp0+sl_next,j); SBAR(); } }while(0)
  #define STEP(C0,C1,P0,P1,t,GK,GV,GL) do{ SBAR(); \
    const lds_cptr vp_=vp0+sl_prev; \
    VRD(0); SBAR(); float sacc=(P0[0]+P0[1]); \
    GAPA(C0=__builtin_amdgcn_mfma_f32_32x32x16_bf16(kf[0],qr[0],negm,0,0,0), P0[2],P0[3],P0[4],P0[5],     pw0[0]=PKW(P0,0), pw0[1]=PKW(P0,2), pw0); \
    VRD(4); SBAR(); GAPA(C1=__builtin_amdgcn_mfma_f32_32x32x16_bf16(kf[1],qr[0],negm,0,0,0), P0[6],P0[7],P0[8],P0[9],     pw0[2]=PKW(P0,4), pw0[3]=PKW(P0,6), pw0); \
    VRD(1); SBAR(); GAPA(C0=__builtin_amdgcn_mfma_f32_32x32x16_bf16(kf[2],qr[1],C0,0,0,0),   P0[10],P0[11],P0[12],P0[13], pw1[0]=PKW(P0,8), pw1[1]=PKW(P0,10), pw1); \
    VRD(5); SBAR(); GAPA(C1=__builtin_amdgcn_mfma_f32_32x32x16_bf16(kf[3],qr[1],C1,0,0,0),   P0[14],P0[15],P1[0],P1[1],   pw1[2]=PKW(P0,12),pw1[3]=PKW(P0,14), pw1); \
    VRD(2); SBAR(); GAPA(C0=__builtin_amdgcn_mfma_f32_32x32x16_bf16(kf[4],qr[2],C0,0,0,0),   P1[2],P1[3],P1[4],P1[5],     pw2[0]=PKW(P1,0), pw2[1]=PKW(P1,2), pw2); \
    VRD(6); SBAR(); GAPA(C1=__builtin_amdgcn_mfma_f32_32x32x16_bf16(kf[5],qr[2],C1,0,0,0),   P1[6],P1[7],P1[8],P1[9],     pw2[2]=PKW(P1,4), pw2[3]=PKW(P1,6), pw2); \
    VRD(3); SBAR(); GAPA(C0=__builtin_amdgcn_mfma_f32_32x32x16_bf16(kf[6],qr[3],C0,0,0,0),   P1[10],P1[11],P1[12],P1[13], pw3[0]=PKW(P1,8), pw3[1]=PKW(P1,10), pw3); \
    VRD(7); SBAR(); GAPA(C1=__builtin_amdgcn_mfma_f32_32x32x16_bf16(kf[7],qr[3],C1,0,0,0),   P1[14],P1[15],0.f,0.f,       pw3[2]=PKW(P1,12),pw3[3]=PKW(P1,14), pw3); \
    l_reg+=sacc; \
    if(GK){DMA_K((t)+3,sl_cur);} if(GV){DMA_V((t)+1,sl_next);} \
    BIAS(C0,C1,t); CMASK(C0,C1,t); \
    { float a=MX3(C0[0],C0[1],C1[0]),b=MX3(C0[2],C0[3],C1[1]); a=MX3(a,C1[2],C1[3]); \
      _Pragma("unroll") for(int r=4;r<16;r+=4){a=MX3(a,C0[r],C0[r+1]);b=MX3(b,C0[r+2],C0[r+3]);a=MX3(a,C1[r],C1[r+1]);b=MX3(b,C1[r+2],C1[r+3]);} \
      float rm=__builtin_fmaxf(a,b); { auto rr=__builtin_amdgcn_permlane32_swap(__float_as_uint(rm),__float_as_uint(rm),false,false); rm=__builtin_fmaxf(__uint_as_float(rr[0]),__uint_as_float(rr[1])); } \
      resc=false; \
      if(__builtin_expect(__any(rm>(float)THRL),0)){ const float dl=__builtin_fmaxf(rm,0.f); mhat+=dl; \
        _Pragma("unroll") for(int r=0;r<16;++r){C0[r]-=dl;C1[r]-=dl;} \
        _Pragma("unroll") for(int r=0;r<16;++r)negm[r]=-mhat; asm volatile("":"+v"(negm)); \
        const float f=__builtin_amdgcn_exp2f(-dl); l_reg*=f; if(hi==0)wsf[r32]=f; resc=true; } } \
    SBAR(); \
    GAPB(o[0]=__builtin_amdgcn_mfma_f32_32x32x16_bf16(PAF(0),VFR(0),o[0],0,0,0), C0,0); \
    GAPB(o[1]=__builtin_amdgcn_mfma_f32_32x32x16_bf16(PAF(0),VFR(4),o[1],0,0,0), C0,4); \
    KRD(GL,0); GAPB(o[0]=__builtin_amdgcn_mfma_f32_32x32x16_bf16(PAF(1),VFR(1),o[0],0,0,0), C0,8); \
    KRD(GL,1); GAPB(o[1]=__builtin_amdgcn_mfma_f32_32x32x16_bf16(PAF(1),VFR(5),o[1],0,0,0), C0,12); \
    KRD(GL,2); GAPB(o[0]=__builtin_amdgcn_mfma_f32_32x32x16_bf16(PAF(2),VFR(2),o[0],0,0,0), C1,0); \
    KRD(GL,3); GAPB(o[1]=__builtin_amdgcn_mfma_f32_32x32x16_bf16(PAF(2),VFR(6),o[1],0,0,0), C1,4); \
    GAPB(o[0]=__builtin_amdgcn_mfma_f32_32x32x16_bf16(PAF(3),VFR(3),o[0],0,0,0), C1,8); \
    GAPB(o[1]=__builtin_amdgcn_mfma_f32_32x32x16_bf16(PAF(3),VFR(7),o[1],0,0,0), C1,12); \
    }while(0)
  int t=1;
  #undef CMASK
  #define CMASK(P0,P1,t) do{}while(0)
  for(;t+5<NT;t+=2){
    STEP(pB0,pB1,pA0,pA1,t,true,true,true);     WAIT_BAR(2); RESC(); ROT();
    STEP(pA0,pA1,pB0,pB1,t+1,true,true,true);   WAIT_BAR(2); RESC(); ROT();
  }
  #undef CMASK
  #define CMASK(P0,P1,t) do{int jb_=(t)-(NT-4); if(jb_>=0)cmask(P0,P1,jb_,qrel,hi);}while(0)
  #define ENDW(tt) do{ if((tt)+3<NT){WAIT_BAR(2);} else if((tt)+2<NT){WAIT_BAR(1);} else {WAIT_BAR(0);} }while(0)
  for(;t+1<NT;t+=2){
    STEP(pB0,pB1,pA0,pA1,t,(t+3<NT),(t+1<NT),(t+1<NT));       ENDW(t);   RESC(); ROT();
    STEP(pA0,pA1,pB0,pB1,t+1,(t+4<NT),(t+2<NT),(t+2<NT));     ENDW(t+1); RESC(); ROT();
  }
  STEP(pB0,pB1,pA0,pA1,NT-1,false,false,false); RESC();
  { float sacc=pB0[0]+pB0[1]; _Pragma("unroll") for(int r=2;r<16;++r)sacc+=pB0[r]; _Pragma("unroll") for(int r=0;r<16;++r)sacc+=pB1[r]; l_reg+=sacc;
    pw0=(u32x4){PKW(pB0,0),PKW(pB0,2),PKW(pB0,4),PKW(pB0,6)};pw1=(u32x4){PKW(pB0,8),PKW(pB0,10),PKW(pB0,12),PKW(pB0,14)};pw2=(u32x4){PKW(pB1,0),PKW(pB1,2),PKW(pB1,4),PKW(pB1,6)};pw3=(u32x4){PKW(pB1,8),PKW(pB1,10),PKW(pB1,12),PKW(pB1,14)};
    SBAR(); pv(o,vb0+sl_cur,PAF(0),PAF(1),PAF(2),PAF(3)); }
  #undef PKW
  #undef PAF
  #undef VFR
  #undef PIN
  #undef MX3
  #undef GAPA
  #undef GAPB
  #undef EX
  #undef VRD
  #undef KRD
  #undef STEP
  #undef ENDW
  {auto rr=__builtin_amdgcn_permlane32_swap(__float_as_uint(l_reg),__float_as_uint(l_reg),false,false);l_reg=__uint_as_float(rr[0])+__uint_as_float(rr[1]);}
  if(hi==0)wsf[32+r32]=l_reg;asm volatile("s_waitcnt lgkmcnt(0)":::"memory");
  float rli[16];
  #pragma unroll
  for(int r=0;r<16;++r)rli[r]=__builtin_amdgcn_rcpf(wsf[32+crow(r,hi)]);
  bf16*Ow=O+(rowbase+q0+wid*QBLK)*DM+h*D; const bf16*SGw=SG+(rowbase+q0+wid*QBLK)*DM+h*D;
  { bf16*stg=(bf16*)(shm+LDS_OST)+wid*2048;
    #pragma unroll
    for(int r=0;r<16;++r){const int orow=crow(r,hi);
      #pragma unroll
      for(int d0=0;d0<2;++d0)stg[orow*64+d0*32+r32]=__float2bfloat16(o[d0][r]*rli[r]);}
    asm volatile("s_waitcnt lgkmcnt(0)":::"memory");
    #pragma unroll
    for(int i=0;i<4;++i){const int row=i*8+(lane>>3),ch=lane&7; u32x4 v=*(const u32x4*)(stg+row*64+ch*8); const u32x4 gq=*(const u32x4*)(SGw+(long)row*DM+ch*8);
      _Pragma("unroll") for(int e_=0;e_<4;++e_){ const float lo_=__uint_as_float(v[e_]<<16)*__uint_as_float(gq[e_]<<16), hi_=__uint_as_float(v[e_]&0xffff0000u)*__uint_as_float(gq[e_]&0xffff0000u); v[e_]=cvtpk_s(lo_,hi_); }
      ATTN_STORE16(Ow+(long)row*DM+ch*8,v);} }
  asm volatile("s_waitcnt lgkmcnt(0)\n\ts_barrier":::"memory");
  #undef DMA_K
  #undef BIAS
  #undef PKADD
  #undef DMA_V
  #undef CMASK
  #undef START
  #undef RESC
  #undef ROT
}
constexpr int ATTN_LDS_BYTES=LDS_BYTES;
struct AttnTensors { const bf16* Q; const bf16* K; const bf16* V; bf16* O; const float* NF; const bf16* SG; };
struct AttnUnit { int bh; int qb; };
struct StaticOrder {
  int vcu;
  __device__ __forceinline__ explicit StaticOrder(int grid,int block):vcu((block%8)*(grid/8)+block/8){}
  __device__ __forceinline__ bool next(int i,AttnUnit&u)const{ if(i>=4)return false; const int s=vcu&7; u.bh=vcu>>3; u.qb=(i==0)?s:(i==1)?15-s:(i==2)?16+s:31-s; return true; }
  __device__ __forceinline__ void a_ready(const AttnUnit&)const{}
  __device__ __forceinline__ void done(const AttnUnit&)const{}
};
template<class Sched,int THRL=8> __device__ __forceinline__ void attn_phase(char*lds,const AttnTensors&T,const Sched&S){
  AttnUnit u;
  if(S.next(0,u)){
    typedef float f32x4_s __attribute__((ext_vector_type(4))); const f32x4_s*nsrc=(const f32x4_s*)(T.NF+(long)u.bh*SEQ)+threadIdx.x*4; __attribute__((address_space(3))) char*l3=(__attribute__((address_space(3))) char*)lds;
    __attribute__((address_space(3))) f32x4_s*ndst=(__attribute__((address_space(3))) f32x4_s*)(l3+LDS_NF)+threadIdx.x*4; __attribute__((address_space(3))) float*wtot=(__attribute__((address_space(3))) float*)(l3+LDS_WS);
    const int ln_=threadIdx.x&63, wv_=threadIdx.x>>6; f32x4_s v_[4]; float run_=0.f;
    _Pragma("unroll") for(int j=0;j<4;++j){ v_[j]=nsrc[j]; v_[j].x+=run_; v_[j].y+=v_[j].x; v_[j].z+=v_[j].y; v_[j].w+=v_[j].z; run_=v_[j].w; }
    float inc_=run_;
    _Pragma("unroll") for(int o=1;o<64;o<<=1){ const float t_=__shfl_up(inc_,o); if(ln_>=o)inc_+=t_; }
    if(ln_==63)wtot[wv_]=inc_;
    asm volatile("s_waitcnt vmcnt(0) lgkmcnt(0)\n\ts_barrier":::"memory");
    float off_=inc_-run_; for(int w=0;w<wv_;++w)off_+=wtot[w];
    _Pragma("unroll") for(int j=0;j<4;++j)ndst[j]=(v_[j]+off_)*(-1.4426950408889634f);
    asm volatile("s_waitcnt vmcnt(0) lgkmcnt(0)\n\ts_barrier":::"memory"); }
  for(int i=0;S.next(i,u);++i){ S.a_ready(u); attn_unit<THRL>(u.bh/NHEAD,u.bh%NHEAD,u.qb,T.Q,T.K,T.V,T.O,T.NF,T.SG,lds); S.done(u); }
}
#undef SBAR
#undef WAIT_BAR
}
constexpr int NWAVES = 8, NTHR = 512;
constexpr int BATCH = 2, T = 8192, D = 1024, FF = 4096, M = BATCH * T;
constexpr int NIN_FOX = 4 * D + 16;
constexpr float EPS = 1e-6f;
constexpr size_t MiB = 1u << 20;
constexpr size_t WS_MOD = 0;
constexpr size_t WS_LB = 128 * 1024;
constexpr size_t WS_QKNW = 160 * 1024;
constexpr size_t WS_WFZ = 192 * 1024;
constexpr size_t WS_DN = 256 * 1024;
constexpr size_t WS_LFS = 1536 * 1024;
constexpr size_t WS_NF = 2560 * 1024;
constexpr size_t WS_BAR = 3584 * 1024, BAR_BYTES = 16384;
constexpr size_t WS_SS = 3648 * 1024;
constexpr size_t WS_BIASV = 3840 * 1024;
constexpr size_t WS_XN2 = 216 * MiB;
constexpr size_t WS_W_HGIN = 4 * MiB, WS_W_HGOUT = 12 * MiB, WS_W_FOXIN = 14 * MiB, WS_W_FOXOUT = 22 * MiB;
constexpr size_t WS_W1_0 = 24 * MiB, WS_W2_0 = 32 * MiB, WS_W1_1 = 40 * MiB, WS_W2_1 = 48 * MiB;
constexpr size_t WS_XN = 56 * MiB;
constexpr size_t WS_R = 88 * MiB;
constexpr size_t WS_QO = WS_R, WS_B1 = WS_R + 32 * MiB, WS_B2 = WS_R + 64 * MiB, WS_B3 = WS_R + 96 * MiB;
constexpr size_t WS_ST = WS_R + 96 * MiB;
constexpr size_t WS_H = WS_R;
constexpr size_t WS_END = 256 * MiB;
static_assert(WS_ST + 64 * MiB <= WS_END && WS_H + 128 * MiB <= WS_END && WS_B1 - WS_QO == 32 * MiB, "ws map");
constexpr int LDS_BYTES = 147456;

#define GAS __attribute__((address_space(1)))
#define LAS __attribute__((address_space(3)))
typedef unsigned short bf16;
typedef unsigned v4u __attribute__((ext_vector_type(4)));
typedef unsigned v2u __attribute__((ext_vector_type(2)));
typedef float f32x4 __attribute__((ext_vector_type(4)));
typedef short bf16x8 __attribute__((ext_vector_type(8)));
typedef short s16x4v __attribute__((ext_vector_type(4)));
#define LDS_WAIT() asm volatile("s_waitcnt lgkmcnt(0)" ::: "memory")
__device__ __forceinline__ unsigned f2bf(float f) { unsigned u = __builtin_bit_cast(unsigned, f); return (u + 0x7fffu + ((u >> 16) & 1u)) >> 16; }
__device__ __forceinline__ unsigned pk2(float lo, float hi) { return pg8::cvt_pk_bf16(lo, hi); }
__device__ __forceinline__ float bf2f(unsigned short h) { return __uint_as_float((unsigned)h << 16); }
__device__ __forceinline__ float wave_sum(float v) {
#pragma unroll
    for (int o = 1; o < 64; o <<= 1) v += __shfl_xor(v, o);
    return v;
}

struct Args { const float* in[18]; float* out; unsigned char* ws; };

template <bool HEADPERM>
__device__ __forceinline__ void transpose_item(const float* W, int K, int ldw, int Ncols, bf16* WT, LAS float* scr, int item, int lane) {
    const int nblk = Ncols / 32, kb = item / nblk, nb = item % nblk, k0 = 64 * kb, n0 = 32 * nb;
#pragma unroll 8
    for (int i = 0; i < 32; ++i) { const int kk = 2 * i + (lane >> 5); scr[kk * 33 + (lane & 31)] = W[(size_t)(k0 + kk) * ldw + n0 + (lane & 31)]; }
    LDS_WAIT(); asm volatile("" ::: "memory");
    const int c = lane & 7;
#pragma unroll
    for (int j = 0; j < 4; ++j) { const int n = (lane >> 3) + 8 * j; const LAS float* s = scr + (8 * c) * 33 + n;
        v4u o; o.x = pk2(s[0 * 33], s[1 * 33]); o.y = pk2(s[2 * 33], s[3 * 33]); o.z = pk2(s[4 * 33], s[5 * 33]); o.w = pk2(s[6 * 33], s[7 * 33]);
        int col = n0 + n;
        if (HEADPERM && col < 2048) { const int nl = col & 255; col = (col & ~255) + 128 * ((nl >> 5) & 1) + 32 * (nl >> 6) + (nl & 31); }
        *(GAS v4u*)(WT + (size_t)col * K + k0 + 8 * c) = o; }
    LDS_WAIT(); asm volatile("" ::: "memory");
}

__device__ __forceinline__ void norm_rows(int gw, int NGW, int lane, const float* xin, const float* w, const float* modsh, const float* modsc, bf16* outb, float* outf) {
    for (int m = gw; m < M; m += NGW) {
        const GAS f32x4* xr = (const GAS f32x4*)(xin + (size_t)m * D) + lane;
        f32x4 v[4]; float s = 0.f;
#pragma unroll
        for (int j = 0; j < 4; ++j) { v[j] = xr[64 * j]; s += (v[j].x * v[j].x + v[j].y * v[j].y) + (v[j].z * v[j].z + v[j].w * v[j].w); }
        const float rstd = __builtin_amdgcn_rsqf(wave_sum(s) * (1.f / D) + EPS);
        const int b = m >> 13;
#pragma unroll
        for (int j = 0; j < 4; ++j) {
            const f32x4 wv = *((const f32x4*)w + lane + 64 * j);
            f32x4 y = v[j] * rstd * wv;
            if (modsc) { const f32x4 sc = *((const f32x4*)(modsc + b * 6144) + lane + 64 * j), sh = *((const f32x4*)(modsh + b * 6144) + lane + 64 * j); y = y * (1.0f + sc) + sh; }
            if (outf) *((GAS f32x4*)(outf + (size_t)m * D) + lane + 64 * j) = y;
            else { v2u o; o.x = pk2(y.x, y.y); o.y = pk2(y.z, y.w); *((GAS v2u*)(outb + (size_t)m * D) + lane + 64 * j) = o; }
        }
    }
}

constexpr int HG_QM = 0, HG_KM = 17408, HG_Q0 = 34816, HG_KT = 52224, HG_VT = 70656, HG_STL = 89088, HG_PART = 123904, HG_RED = 125952;
constexpr int PQ = 136, PT = 72;
#define MFMA16(a, b, c) __builtin_amdgcn_mfma_f32_16x16x32_bf16((a), (b), (c), 0, 0, 0)

__device__ __forceinline__ void hg_pass_a(LAS unsigned char* lds, int tid, int lane, int wave, const float* LF, const bf16* V, bf16* ST, float* DN) {
    const int p = tid >> 7, kk = tid & 127, g = lane >> 4, l15 = lane & 15;
    LAS float* part = (LAS float*)(lds + HG_PART);
    LAS bf16* KT = (LAS bf16*)(lds + HG_KT); LAS bf16* VT = (LAS bf16*)(lds + HG_VT);
    float Gn[16]; unsigned short vn[16];
#define HGA_LOAD(uu) do { const int bh_ = (uu) >> 7, n_ = (uu) & 127; const size_t r_ = (size_t)(bh_ >> 3) * T + n_ * 64 + 16 * p; \
        const float* lfp_ = LF + r_ * D + (bh_ & 7) * 128 + kk; const bf16* vp_ = V + r_ * D + (bh_ & 7) * 128 + kk; \
        _Pragma("unroll") for (int j = 0; j < 16; ++j) { Gn[j] = lfp_[(size_t)j * D]; vn[j] = vp_[(size_t)j * D]; } } while (0)
    if ((int)blockIdx.x < 2048) HGA_LOAD(blockIdx.x);
    for (int u = blockIdx.x; u < 2048; u += gridDim.x) {
        float G[16], kv[16]; unsigned short vv[16];
#pragma unroll
        for (int j = 0; j < 16; ++j) { G[j] = Gn[j]; vv[j] = vn[j]; }
#pragma unroll
        for (int j = 0; j < 16; ++j) { kv[j] = 1.0f - __expf(G[j]); if (j) G[j] += G[j - 1]; }
        part[p * 128 + kk] = G[15];
        __syncthreads();
        const float t0 = part[kk], t1 = part[128 + kk], t2 = part[256 + kk], t3 = part[384 + kk];
        const float off = (p > 0 ? t0 : 0.f) + (p > 1 ? t1 : 0.f) + (p > 2 ? t2 : 0.f), glast = (t0 + t1) + (t2 + t3);
        unsigned kw[8], vw[8];
#pragma unroll
        for (int j = 0; j < 8; ++j) {
            const float a0 = kv[2 * j] * __expf(glast - (G[2 * j] + off)), a1 = kv[2 * j + 1] * __expf(glast - (G[2 * j + 1] + off));
            kw[j] = pk2(a0, a1); vw[j] = (unsigned)vv[2 * j] | ((unsigned)vv[2 * j + 1] << 16); }
        *(LAS v4u*)(KT + kk * PT + 16 * p) = (v4u){kw[0], kw[1], kw[2], kw[3]}; *(LAS v4u*)(KT + kk * PT + 16 * p + 8) = (v4u){kw[4], kw[5], kw[6], kw[7]};
        *(LAS v4u*)(VT + kk * PT + 16 * p) = (v4u){vw[0], vw[1], vw[2], vw[3]}; *(LAS v4u*)(VT + kk * PT + 16 * p + 8) = (v4u){vw[4], vw[5], vw[6], vw[7]};
        if (p == 0) DN[(size_t)u * 128 + kk] = __expf(glast);
        if (u + (int)gridDim.x < 2048) HGA_LOAD(u + gridDim.x);
        __syncthreads();
        bf16x8 bfr[2];
#pragma unroll
        for (int ss = 0; ss < 2; ++ss) bfr[ss] = *(const LAS bf16x8*)(VT + (16 * wave + l15) * PT + 32 * ss + 8 * g);
        bf16* stp = ST + ((size_t)u * 128 + 16 * wave + l15) * 128 + 4 * g;
#pragma unroll
        for (int kt = 0; kt < 8; ++kt) {
            f32x4 acc = (f32x4){0.f, 0.f, 0.f, 0.f};
#pragma unroll
            for (int ss = 0; ss < 2; ++ss) { const bf16x8 a = *(const LAS bf16x8*)(KT + (16 * kt + l15) * PT + 32 * ss + 8 * g); acc = MFMA16(a, bfr[ss], acc); }
            v2u o; o.x = pk2(acc[0], acc[1]); o.y = pk2(acc[2], acc[3]); *(GAS v2u*)(stp + 16 * kt) = o;
        }
        __syncthreads();
    }
#undef HGA_LOAD
}
__device__ __forceinline__ void hg_pass_b(int tid, bf16* ST, const float* DN) {
    const int gt = blockIdx.x * NTHR + tid;
    for (int e2 = gt; e2 < 16 * 8192; e2 += gridDim.x * NTHR) {
        const int bh = e2 >> 13, pe = e2 & 8191, k = (2 * pe) & 127;
        unsigned* sp = (unsigned*)ST + (size_t)bh * 128 * 8192 + pe; const float* dp = DN + (size_t)bh * 128 * 128 + k;
        float s0 = 0.f, s1 = 0.f;
        for (int n0 = 0; n0 < 128; n0 += 16) {
            unsigned dv[16]; float d0[16], d1[16];
#pragma unroll
            for (int j = 0; j < 16; ++j) { dv[j] = sp[(size_t)(n0 + j) * 8192]; const float2 dd = *(const float2*)(dp + (size_t)(n0 + j) * 128); d0[j] = dd.x; d1[j] = dd.y; }
#pragma unroll
            for (int j = 0; j < 16; ++j) { sp[(size_t)(n0 + j) * 8192] = pk2(s0, s1);
                s0 = d0[j] * s0 + __uint_as_float(dv[j] << 16); s1 = d1[j] * s1 + __uint_as_float(dv[j] & 0xffff0000u); }
        }
    }
}
__device__ __forceinline__ void hg_pass_c(LAS unsigned char* lds, int tid, int lane, int wave, const float* LF, const bf16* QO, bf16* OUTB, const bf16* V, const bf16* GS, const bf16* ST, const float* gnw) {
    const int p = tid >> 7, kk = tid & 127, g = lane >> 4, l15 = lane & 15, tt = wave & 3, vh = wave >> 2;
    LAS float* part = (LAS float*)(lds + HG_PART); LAS float* red = (LAS float*)(lds + HG_RED);
    LAS bf16* QM = (LAS bf16*)(lds + HG_QM); LAS bf16* KM = (LAS bf16*)(lds + HG_KM); LAS bf16* Q0 = (LAS bf16*)(lds + HG_Q0);
    LAS bf16* VT = (LAS bf16*)(lds + HG_VT); LAS bf16* STL = (LAS bf16*)(lds + HG_STL);
    float lfn[16]; unsigned short vn[16], qn[16]; v4u stn[4];
#define HGC_LOAD(uu) do { const int bh_ = (uu) >> 7, n_ = (uu) & 127; const size_t r_ = (size_t)(bh_ >> 3) * T + n_ * 64 + 16 * p; \
        const float* lfp_ = LF + r_ * D + (bh_ & 7) * 128 + kk; const bf16* vp_ = V + r_ * D + (bh_ & 7) * 128 + kk; const bf16* qp_ = QO + r_ * D + (bh_ & 7) * 128 + kk; \
        const v4u* src_ = (const v4u*)(ST + (size_t)(uu) * 16384); \
        _Pragma("unroll") for (int i = 0; i < 4; ++i) stn[i] = src_[tid + 512 * i]; \
        _Pragma("unroll") for (int j = 0; j < 16; ++j) { lfn[j] = lfp_[(size_t)j * D]; vn[j] = vp_[(size_t)j * D]; qn[j] = qp_[(size_t)j * D]; } } while (0)
    if ((int)blockIdx.x < 2048) HGC_LOAD(blockIdx.x);
    for (int u = blockIdx.x; u < 2048; u += gridDim.x) {
        const int bh = u >> 7, n = u & 127, b = bh >> 3, h = bh & 7;
        const size_t rowu = (size_t)b * T + n * 64;
#pragma unroll
        for (int i = 0; i < 4; ++i) { const int q = tid + 512 * i; *(LAS v4u*)(STL + (q >> 4) * PQ + (q & 15) * 8) = stn[i]; }
        float G[16], lf[16]; unsigned short vv[16], qq[16];
#pragma unroll
        for (int j = 0; j < 16; ++j) { lf[j] = lfn[j]; vv[j] = vn[j]; qq[j] = qn[j]; }
#pragma unroll
        for (int j = 0; j < 16; ++j) { G[j] = lf[j] + (j ? G[j - 1] : 0.f); }
        part[p * 128 + kk] = G[15];
        __syncthreads();
        const float t0 = part[kk], t1 = part[128 + kk], t2 = part[256 + kk];
        const float off = (p > 0 ? t0 : 0.f) + (p > 1 ? t1 : 0.f) + (p > 2 ? t2 : 0.f), gm = t0 + t1;
        unsigned vw[8];
#pragma unroll
        for (int j = 0; j < 16; ++j) {
            const float Gt = G[j] + off, qv = bf2f(qq[j]), kf = 1.0f - __expf(lf[j]);
            const int t = 16 * p + j;
            QM[t * PQ + kk] = (bf16)f2bf(qv * __expf(Gt - gm));
            KM[t * PQ + kk] = (bf16)f2bf(kf * __expf(gm - Gt));
            Q0[t * PQ + kk] = (bf16)f2bf(qv * __expf(Gt));
        }
#pragma unroll
        for (int j = 0; j < 8; ++j) vw[j] = (unsigned)vv[2 * j] | ((unsigned)vv[2 * j + 1] << 16);
        *(LAS v4u*)(VT + kk * PT + 16 * p) = (v4u){vw[0], vw[1], vw[2], vw[3]}; *(LAS v4u*)(VT + kk * PT + 16 * p + 8) = (v4u){vw[4], vw[5], vw[6], vw[7]};
        if (u + (int)gridDim.x < 2048) HGC_LOAD(u + gridDim.x);
        __syncthreads();
        f32x4 P[4];
        bf16x8 qf[4];
#pragma unroll
        for (int kc = 0; kc < 4; ++kc) qf[kc] = *(const LAS bf16x8*)(QM + (16 * tt + l15) * PQ + 32 * kc + 8 * g);
#pragma unroll
        for (int st = 0; st < 4; ++st) {
            P[st] = (f32x4){0.f, 0.f, 0.f, 0.f};
            if (st <= tt) {
#pragma unroll
                for (int kc = 0; kc < 4; ++kc) { const bf16x8 a = *(const LAS bf16x8*)(KM + (16 * st + l15) * PQ + 32 * kc + 8 * g); P[st] = MFMA16(a, qf[kc], P[st]); }
                if (st == tt) {
#pragma unroll
                    for (int i = 0; i < 4; ++i) if (4 * g + i > l15) P[st][i] = 0.f; }
            }
        }
        f32x4 O[4];
        bf16x8 pf[2];
#pragma unroll
        for (int sp = 0; sp < 2; ++sp) { v4u w; w.x = pk2(P[2 * sp][0], P[2 * sp][1]); w.y = pk2(P[2 * sp][2], P[2 * sp][3]); w.z = pk2(P[2 * sp + 1][0], P[2 * sp + 1][1]); w.w = pk2(P[2 * sp + 1][2], P[2 * sp + 1][3]);
            pf[sp] = __builtin_bit_cast(bf16x8, w); }
#pragma unroll
        for (int kc = 0; kc < 4; ++kc) qf[kc] = *(const LAS bf16x8*)(Q0 + (16 * tt + l15) * PQ + 32 * kc + 8 * g);
#pragma unroll
        for (int j = 0; j < 4; ++j) {
            const int vrow = 64 * vh + 16 * j + l15;
            O[j] = (f32x4){0.f, 0.f, 0.f, 0.f};
#pragma unroll
            for (int sp = 0; sp < 2; ++sp) {
                if (2 * sp <= tt) {
                    const v2u lo = *(const LAS v2u*)(VT + vrow * PT + 32 * sp + 4 * g), hi = *(const LAS v2u*)(VT + vrow * PT + 32 * sp + 16 + 4 * g);
                    const bf16x8 a = __builtin_bit_cast(bf16x8, (v4u){lo.x, lo.y, hi.x, hi.y});
                    O[j] = MFMA16(a, pf[sp], O[j]);
                }
            }
#pragma unroll
            for (int kc = 0; kc < 4; ++kc) { const bf16x8 a = *(const LAS bf16x8*)(STL + vrow * PQ + 32 * kc + 8 * g); O[j] = MFMA16(a, qf[kc], O[j]); }
        }
        float ss = 0.f;
#pragma unroll
        for (int j = 0; j < 4; ++j) ss += (O[j][0] * O[j][0] + O[j][1] * O[j][1]) + (O[j][2] * O[j][2] + O[j][3] * O[j][3]);
        ss += __shfl_xor(ss, 16); ss += __shfl_xor(ss, 32);
        if (g == 0) red[vh * 64 + 16 * tt + l15] = ss;
        __syncthreads();
        const float tot = red[16 * tt + l15] + red[64 + 16 * tt + l15];
        const float rstd = __builtin_amdgcn_rsqf(tot * (1.0f / 128.0f) + EPS);
        const size_t orow = (rowu + 16 * tt + l15) * D + h * 128;
#pragma unroll
        for (int j = 0; j < 4; ++j) {
            const int v0 = 64 * vh + 16 * j + 4 * g;
            const f32x4 gw = *(const f32x4*)(gnw + v0); const v2u gs = *(const GAS v2u*)(GS + orow + v0);
            const float o0 = O[j][0] * rstd * gw[0] * __uint_as_float(gs.x << 16), o1 = O[j][1] * rstd * gw[1] * __uint_as_float(gs.x & 0xffff0000u);
            const float o2 = O[j][2] * rstd * gw[2] * __uint_as_float(gs.y << 16), o3 = O[j][3] * rstd * gw[3] * __uint_as_float(gs.y & 0xffff0000u);
            v2u o; o.x = pk2(o0, o1); o.y = pk2(o2, o3); *(GAS v2u*)(OUTB + orow + v0) = o;
        }
        __syncthreads();
    }
#undef HGC_LOAD
}
constexpr int HG_DL = HG_RED + 512;
#define HG2_UPDATE() do { _Pragma("unroll") for (int kt = 0; kt < 8; ++kt) { f32x4 acc_ = (f32x4){0.f, 0.f, 0.f, 0.f}; \
        _Pragma("unroll") for (int ss_ = 0; ss_ < 2; ++ss_) { const bf16x8 a_ = *(const LAS bf16x8*)(KT + (16 * kt + l15) * PT + 32 * ss_ + 8 * g); \
            const bf16x8 b_ = *(const LAS bf16x8*)(VT + (16 * wave + l15) * PT + 32 * ss_ + 8 * g); acc_ = MFMA16(a_, b_, acc_); } \
        const f32x4 d_ = *(const LAS f32x4*)(dl + 16 * kt + 4 * g); Sacc[kt] = Sacc[kt] * d_ + acc_; } } while (0)
__device__ __forceinline__ void hg2_pass_a(LAS unsigned char* lds, int tid, int lane, int wave, const float* LF, const bf16* V, float* SSL, float* DT) {
    const int p = tid >> 7, kk = tid & 127, g = lane >> 4, l15 = lane & 15;
    LAS float* part = (LAS float*)(lds + HG_PART); LAS float* dl = (LAS float*)(lds + HG_DL);
    LAS bf16* KT = (LAS bf16*)(lds + HG_KT); LAS bf16* VT = (LAS bf16*)(lds + HG_VT);
    for (int su = blockIdx.x; su < 256; su += gridDim.x) {
        const int bh = su >> 4, sc = su & 15;
        const size_t rbase = (size_t)(bh >> 3) * T + sc * 512 + 16 * p; const int cb = (bh & 7) * 128 + kk;
        f32x4 Sacc[8];
#pragma unroll
        for (int kt = 0; kt < 8; ++kt) Sacc[kt] = (f32x4){0.f, 0.f, 0.f, 0.f};
        float gsum = 0.f;
        float Gn[16]; unsigned short vn[16];
#define HG2A_LOAD(c_) do { const float* lfp_ = LF + (rbase + (size_t)(c_) * 64) * D + cb; const bf16* vp_ = V + (rbase + (size_t)(c_) * 64) * D + cb; \
        _Pragma("unroll") for (int j = 0; j < 16; ++j) { Gn[j] = lfp_[(size_t)j * D]; vn[j] = vp_[(size_t)j * D]; } } while (0)
        HG2A_LOAD(0);
        for (int c = 0; c < 8; ++c) {
            float G[16], kv[16]; unsigned short vv[16];
#pragma unroll
            for (int j = 0; j < 16; ++j) { G[j] = Gn[j]; vv[j] = vn[j]; }
#pragma unroll
            for (int j = 0; j < 16; ++j) { kv[j] = 1.0f - __expf(G[j]); if (j) G[j] += G[j - 1]; }
            part[p * 128 + kk] = G[15];
            __syncthreads();
            const float t0 = part[kk], t1 = part[128 + kk], t2 = part[256 + kk], t3 = part[384 + kk];
            const float off = (p > 0 ? t0 : 0.f) + (p > 1 ? t1 : 0.f) + (p > 2 ? t2 : 0.f), glast = (t0 + t1) + (t2 + t3);
            gsum += glast;
            unsigned kw[8], vw[8];
#pragma unroll
            for (int j = 0; j < 8; ++j) {
                const float a0 = kv[2 * j] * __expf(glast - (G[2 * j] + off)), a1 = kv[2 * j + 1] * __expf(glast - (G[2 * j + 1] + off));
                kw[j] = pk2(a0, a1); vw[j] = (unsigned)vv[2 * j] | ((unsigned)vv[2 * j + 1] << 16); }
            *(LAS v4u*)(KT + kk * PT + 16 * p) = (v4u){kw[0], kw[1], kw[2], kw[3]}; *(LAS v4u*)(KT + kk * PT + 16 * p + 8) = (v4u){kw[4], kw[5], kw[6], kw[7]};
            *(LAS v4u*)(VT + kk * PT + 16 * p) = (v4u){vw[0], vw[1], vw[2], vw[3]}; *(LAS v4u*)(VT + kk * PT + 16 * p + 8) = (v4u){vw[4], vw[5], vw[6], vw[7]};
            if (p == 0) dl[kk] = __expf(glast);
            if (c < 7) HG2A_LOAD(c + 1);
            __syncthreads();
            HG2_UPDATE();
            __syncthreads();
        }
#undef HG2A_LOAD
        float* sp = SSL + ((size_t)su * 128 + 16 * wave + l15) * 128 + 4 * g;
#pragma unroll
        for (int kt = 0; kt < 8; ++kt) *(GAS f32x4*)(sp + 16 * kt) = Sacc[kt];
        if (p == 0) DT[(size_t)su * 128 + kk] = __expf(gsum);
    }
}
__device__ __forceinline__ void hg2_pass_b(int tid, float* SSL, const float* DT) {
    const int gt = blockIdx.x * NTHR + tid;
    for (int e2 = gt; e2 < 16 * 8192; e2 += gridDim.x * NTHR) {
        const int bh = e2 >> 13, pe = e2 & 8191, k = (2 * pe) & 127;
        float2* sp = (float2*)SSL + (size_t)bh * 16 * 8192 + pe; const float* dp = DT + (size_t)bh * 16 * 128 + k;
        float2 dv[16], dd[16]; float s0 = 0.f, s1 = 0.f;
#pragma unroll
        for (int j = 0; j < 16; ++j) { dv[j] = sp[(size_t)j * 8192]; dd[j] = *(const float2*)(dp + (size_t)j * 128); }
#pragma unroll
        for (int j = 0; j < 16; ++j) { sp[(size_t)j * 8192] = make_float2(s0, s1); s0 = dd[j].x * s0 + dv[j].x; s1 = dd[j].y * s1 + dv[j].y; }
    }
}
__device__ __forceinline__ void hg2_pass_c(LAS unsigned char* lds, int tid, int lane, int wave, const float* LF, const bf16* QO, bf16* OUTB, const bf16* V, const bf16* GS, const float* SSL, const float* gnw) {
    const int p = tid >> 7, kk = tid & 127, g = lane >> 4, l15 = lane & 15, tt = wave & 3, vh = wave >> 2;
    LAS float* part = (LAS float*)(lds + HG_PART); LAS float* red = (LAS float*)(lds + HG_RED); LAS float* dl = (LAS float*)(lds + HG_DL);
    LAS bf16* QM = (LAS bf16*)(lds + HG_QM); LAS bf16* KM = (LAS bf16*)(lds + HG_KM); LAS bf16* Q0 = (LAS bf16*)(lds + HG_Q0);
    LAS bf16* KT = (LAS bf16*)(lds + HG_KT); LAS bf16* VT = (LAS bf16*)(lds + HG_VT); LAS bf16* STL = (LAS bf16*)(lds + HG_STL);
    for (int su = blockIdx.x; su < 256; su += gridDim.x) {
        const int bh = su >> 4, sc = su & 15, h = bh & 7;
        const size_t rsu = (size_t)(bh >> 3) * T + sc * 512, rbase = rsu + 16 * p; const int cb = h * 128 + kk;
        f32x4 Sacc[8];
        { const float* sp = SSL + ((size_t)su * 128 + 16 * wave + l15) * 128 + 4 * g;
#pragma unroll
          for (int kt = 0; kt < 8; ++kt) Sacc[kt] = *(const GAS f32x4*)(sp + 16 * kt); }
        float lfn[16]; unsigned short vn[16], qn[16];
#define HG2C_LOAD(c_) do { const size_t r_ = (rbase + (size_t)(c_) * 64) * D + cb; const float* lfp_ = LF + r_; const bf16* vp_ = V + r_; const bf16* qp_ = QO + r_; \
        _Pragma("unroll") for (int j = 0; j < 16; ++j) { lfn[j] = lfp_[(size_t)j * D]; vn[j] = vp_[(size_t)j * D]; qn[j] = qp_[(size_t)j * D]; } } while (0)
        HG2C_LOAD(0);
        for (int c = 0; c < 8; ++c) {
#pragma unroll
            for (int kt = 0; kt < 8; ++kt) { v2u o; o.x = pk2(Sacc[kt][0], Sacc[kt][1]); o.y = pk2(Sacc[kt][2], Sacc[kt][3]); *(LAS v2u*)(STL + (16 * wave + l15) * PQ + 16 * kt + 4 * g) = o; }
            float G[16], lf[16]; unsigned short vv[16], qq[16];
#pragma unroll
            for (int j = 0; j < 16; ++j) { lf[j] = lfn[j]; vv[j] = vn[j]; qq[j] = qn[j]; }
#pragma unroll
            for (int j = 0; j < 16; ++j) { G[j] = lf[j] + (j ? G[j - 1] : 0.f); }
            part[p * 128 + kk] = G[15];
            __syncthreads();
            const float t0 = part[kk], t1 = part[128 + kk], t2 = part[256 + kk], t3 = part[384 + kk];
            const float off = (p > 0 ? t0 : 0.f) + (p > 1 ? t1 : 0.f) + (p > 2 ? t2 : 0.f), gm = t0 + t1, glast = (t0 + t1) + (t2 + t3);
            unsigned vw[8], kw[8];
#pragma unroll
            for (int j = 0; j < 16; ++j) {
                const float Gt = G[j] + off, qv = bf2f(qq[j]), kf = 1.0f - __expf(lf[j]);
                const int t = 16 * p + j;
                QM[t * PQ + kk] = (bf16)f2bf(qv * __expf(Gt - gm));
                KM[t * PQ + kk] = (bf16)f2bf(kf * __expf(gm - Gt));
                Q0[t * PQ + kk] = (bf16)f2bf(qv * __expf(Gt));
                const float kt_ = kf * __expf(glast - Gt);
                if (j & 1) kw[j >> 1] |= f2bf(kt_) << 16; else kw[j >> 1] = f2bf(kt_);
            }
#pragma unroll
            for (int j = 0; j < 8; ++j) vw[j] = (unsigned)vv[2 * j] | ((unsigned)vv[2 * j + 1] << 16);
            *(LAS v4u*)(KT + kk * PT + 16 * p) = (v4u){kw[0], kw[1], kw[2], kw[3]}; *(LAS v4u*)(KT + kk * PT + 16 * p + 8) = (v4u){kw[4], kw[5], kw[6], kw[7]};
            *(LAS v4u*)(VT + kk * PT + 16 * p) = (v4u){vw[0], vw[1], vw[2], vw[3]}; *(LAS v4u*)(VT + kk * PT + 16 * p + 8) = (v4u){vw[4], vw[5], vw[6], vw[7]};
            if (p == 0) dl[kk] = __expf(glast);
            if (c < 7) HG2C_LOAD(c + 1);
            __syncthreads();
            f32x4 P[4];
            bf16x8 qf[4];
#pragma unroll
            for (int kc = 0; kc < 4; ++kc) qf[kc] = *(const LAS bf16x8*)(QM + (16 * tt + l15) * PQ + 32 * kc + 8 * g);
#pragma unroll
            for (int st = 0; st < 4; ++st) {
                P[st] = (f32x4){0.f, 0.f, 0.f, 0.f};
                if (st <= tt) {
#pragma unroll
                    for (int kc = 0; kc < 4; ++kc) { const bf16x8 a = *(const LAS bf16x8*)(KM + (16 * st + l15) * PQ + 32 * kc + 8 * g); P[st] = MFMA16(a, qf[kc], P[st]); }
                    if (st == tt) {
#pragma unroll
                        for (int i = 0; i < 4; ++i) if (4 * g + i > l15) P[st][i] = 0.f; }
                }
            }
            f32x4 O[4];
            bf16x8 pf[2];
#pragma unroll
            for (int sp = 0; sp < 2; ++sp) { v4u w; w.x = pk2(P[2 * sp][0], P[2 * sp][1]); w.y = pk2(P[2 * sp][2], P[2 * sp][3]); w.z = pk2(P[2 * sp + 1][0], P[2 * sp + 1][1]); w.w = pk2(P[2 * sp + 1][2], P[2 * sp + 1][3]);
                pf[sp] = __builtin_bit_cast(bf16x8, w); }
#pragma unroll
            for (int kc = 0; kc < 4; ++kc) qf[kc] = *(const LAS bf16x8*)(Q0 + (16 * tt + l15) * PQ + 32 * kc + 8 * g);
#pragma unroll
            for (int j = 0; j < 4; ++j) {
                const int vrow = 64 * vh + 16 * j + l15;
                O[j] = (f32x4){0.f, 0.f, 0.f, 0.f};
#pragma unroll
                for (int sp = 0; sp < 2; ++sp) {
                    if (2 * sp <= tt) {
                        const v2u lo = *(const LAS v2u*)(VT + vrow * PT + 32 * sp + 4 * g), hi = *(const LAS v2u*)(VT + vrow * PT + 32 * sp + 16 + 4 * g);
                        const bf16x8 a = __builtin_bit_cast(bf16x8, (v4u){lo.x, lo.y, hi.x, hi.y});
                        O[j] = MFMA16(a, pf[sp], O[j]);
                    }
                }
#pragma unroll
                for (int kc = 0; kc < 4; ++kc) { const bf16x8 a = *(const LAS bf16x8*)(STL + vrow * PQ + 32 * kc + 8 * g); O[j] = MFMA16(a, qf[kc], O[j]); }
            }
            float ss = 0.f;
#pragma unroll
            for (int j = 0; j < 4; ++j) ss += (O[j][0] * O[j][0] + O[j][1] * O[j][1]) + (O[j][2] * O[j][2] + O[j][3] * O[j][3]);
            ss += __shfl_xor(ss, 16); ss += __shfl_xor(ss, 32);
            if (g == 0) red[vh * 64 + 16 * tt + l15] = ss;
            HG2_UPDATE();
            __syncthreads();
            const float tot = red[16 * tt + l15] + red[64 + 16 * tt + l15];
            const float rstd = __builtin_amdgcn_rsqf(tot * (1.0f / 128.0f) + EPS);
            const size_t orow = (rsu + (size_t)c * 64 + 16 * tt + l15) * D + h * 128;
#pragma unroll
            for (int j = 0; j < 4; ++j) {
                const int v0 = 64 * vh + 16 * j + 4 * g;
                const f32x4 gw = *(const f32x4*)(gnw + v0); const v2u gs = *(const GAS v2u*)(GS + orow + v0);
                const float o0 = O[j][0] * rstd * gw[0] * __uint_as_float(gs.x << 16), o1 = O[j][1] * rstd * gw[1] * __uint_as_float(gs.x & 0xffff0000u);
                const float o2 = O[j][2] * rstd * gw[2] * __uint_as_float(gs.y << 16), o3 = O[j][3] * rstd * gw[3] * __uint_as_float(gs.y & 0xffff0000u);
                v2u o; o.x = pk2(o0, o1); o.y = pk2(o2, o3); *(GAS v2u*)(OUTB + orow + v0) = o;
            }
            __syncthreads();
        }
#undef HG2C_LOAD
    }
}
__device__ __forceinline__ void fox_fz_tail(int lane, int wave, const bf16* XN, const bf16* WfzT, const float* bf, float* LFS, const float* ssr, const float* bvec) {
    if (wave < 4) {
        const int g = lane >> 4, l15 = lane & 15; const int rbase = 64 * blockIdx.x + 16 * wave;
        for (int rb = rbase; rb < M; rb += 64 * gridDim.x) {
            f32x4 acc = (f32x4){0.f, 0.f, 0.f, 0.f};
            const bf16* ap = WfzT + l15 * D + 8 * g; const bf16* bp = XN + (size_t)(rb + l15) * D + 8 * g;
#pragma unroll 8
            for (int kc = 0; kc < 32; ++kc) { const bf16x8 a = *(const GAS bf16x8*)(ap + 32 * kc), bb = *(const GAS bf16x8*)(bp + 32 * kc); acc = MFMA16(a, bb, acc); }
            const int row = rb + l15, b = row >> 13, s = row & 8191;
            const float rstd = __builtin_amdgcn_rsqf(ssr[row] * (1.0f / 1024.0f) + EPS);
#pragma unroll
            for (int i = 0; i < 4; ++i) { const int hh = 4 * g + i; const float z = acc[i] * rstd + bvec[b * 4112 + hh] + bf[hh];
                const float lfv = z >= 0.f ? -log1pf(__expf(-z)) : z - log1pf(__expf(z));
                LFS[(size_t)(b * 16 + hh) * T + s] = lfv; }
        }
    }
}
__device__ __forceinline__ void fox_scan(LAS unsigned char* lds, int tid, int lane, int wave, const float* LFS, float* NF) {
    LAS float* wtot = (LAS float*)lds;
    for (int bh = blockIdx.x; bh < 32; bh += gridDim.x) {
        const f32x4* src = (const f32x4*)(LFS + (size_t)bh * T) + tid * 4;
        f32x4 v[4]; float run = 0.f;
#pragma unroll
        for (int j = 0; j < 4; ++j) { v[j] = src[j]; v[j].x += run; v[j].y += v[j].x; v[j].z += v[j].y; v[j].w += v[j].z; run = v[j].w; }
        float inc = run;
#pragma unroll
        for (int o = 1; o < 64; o <<= 1) { const float t = __shfl_up(inc, o); if (lane >= o) inc += t; }
        if (lane == 63) wtot[wave] = inc;
        __syncthreads();
        float off = inc - run;
        for (int w = 0; w < wave; ++w) off += wtot[w];
        const float c = -1.4426950408889634f;
        f32x4* dst = (f32x4*)(NF + (size_t)bh * T) + tid * 4;
#pragma unroll
        for (int j = 0; j < 4; ++j) dst[j] = (v[j] + off) * c;
        __syncthreads();
    }
}


#ifdef DIAG_HG
__device__ __forceinline__ void diag_hg_naive(LAS unsigned char* lds, int tid, const float* LF, const bf16* QOq, const bf16* V, const bf16* GS, const float* gnw, float* DB) {
    LAS float* fl = (LAS float*)lds; LAS float* kl = fl + 128; LAS float* ql = fl + 256; LAS float* ps = fl + 384; LAS float* os = fl + 896;
    const int v = tid & 127, kq = tid >> 7;
    float S[32];
#pragma unroll
    for (int i = 0; i < 32; ++i) S[i] = 0.f;
    for (int t = 0; t < 192; ++t) {
        if (tid < 128) { const float lf = LF[(size_t)t * 1024 + tid]; const float ff = __expf(lf); fl[tid] = ff; kl[tid] = 1.0f - ff; ql[tid] = bf2f(QOq[(size_t)t * 1024 + tid]); }
        __syncthreads();
        const float vt = bf2f(V[(size_t)t * 1024 + v]); float acc = 0.f;
#pragma unroll
        for (int i = 0; i < 32; ++i) { const int k_ = 32 * kq + i; S[i] = fl[k_] * S[i] + kl[k_] * vt; acc += S[i] * ql[k_]; }
        ps[kq * 128 + v] = acc;
        __syncthreads();
        if (tid < 128) os[tid] = ps[tid] + ps[128 + tid] + ps[256 + tid] + ps[384 + tid];
        __syncthreads();
        if (tid < 128) { float ss = 0.f; for (int i = 0; i < 128; ++i) ss += os[i] * os[i];
            DB[t * 128 + tid] = os[tid] * __builtin_amdgcn_rsqf(ss * (1.0f / 128.0f) + EPS) * gnw[tid] * bf2f(GS[(size_t)t * 1024 + tid]); }
        __syncthreads();
    }
}
__device__ __forceinline__ void diag_hg_cmp(LAS unsigned char* lds, int tid, const bf16* O, const float* DB, float* DG) {
    LAS float* r = (LAS float*)lds; float sd = 0.f, ss = 0.f;
    for (int idx = tid + DIAG_T0 * 128; idx < DIAG_T1 * 128; idx += NTHR) { const int t = idx >> 7, v = idx & 127; const float a = DB[idx], b = bf2f(O[(size_t)t * 1024 + v]); sd += (a - b) * (a - b); ss += a * a; }
    sd = wave_sum(sd); ss = wave_sum(ss);
    if ((tid & 63) == 0) { r[(tid >> 6) * 2] = sd; r[(tid >> 6) * 2 + 1] = ss; }
    __syncthreads();
    if (tid == 0) { float a = 0.f, b = 0.f; for (int w = 0; w < 8; ++w) { a += r[2 * w]; b += r[2 * w + 1]; } DG[0] = sqrtf(a / b); }
    __syncthreads();
}
#endif
#ifndef NO_GEMM
#define NO_GEMM 0
#endif
#ifndef REP_SYNC
#define REP_SYNC 1
#endif
#ifndef REP_NORM
#define REP_NORM 1
#endif
#ifndef REP_HGAB
#define REP_HGAB 1
#endif
#ifndef REP_R1
#define REP_R1 1
#endif
#ifndef REP_G1
#define REP_G1 1
#endif
#ifndef REP_G2
#define REP_G2 1
#endif
#ifndef REP_G3
#define REP_G3 1
#endif
#ifndef REP_G4
#define REP_G4 1
#endif
#ifndef REP_P0
#define REP_P0 1
#endif
#ifndef REP_SCAN
#define REP_SCAN 1
#endif
#ifndef ATT_THRL
#define ATT_THRL 64
#endif
#ifndef REP_ATT
#define REP_ATT 1
#endif
#ifndef REP_HGC
#define REP_HGC 1
#endif
#define RLX_AGENT __ATOMIC_RELAXED, __HIP_MEMORY_SCOPE_AGENT
#define XB_TMO      128
#define XB_XCNT(j)  (256  + 64 * (j))
#define XB_XSUB(j)  (1280 + 64 * (j))
#define XB_XGEN(j)  (2304 + 64 * (j))
#define XB_TOP      3328
#define XB_TOPGEN   3392
#define XCD_BAR_WORDS 3456
#define XB_SPIN_CAP (1u << 18)

__device__ __forceinline__ unsigned xb_ld(unsigned* p)              { return __hip_atomic_load(p, __ATOMIC_RELAXED, __HIP_MEMORY_SCOPE_AGENT); }
__device__ __forceinline__ unsigned xb_add(unsigned* p, unsigned v) { return __hip_atomic_fetch_add(p, v, __ATOMIC_RELAXED, __HIP_MEMORY_SCOPE_AGENT); }
__device__ __forceinline__ unsigned xb_xcc_id() { return (unsigned)__builtin_amdgcn_s_getreg((3 << 11) | 20) & 0xFu; }
#define XB_SPIN(cond, bar) do { unsigned _sp = 0; while (cond) { __builtin_amdgcn_s_sleep(1); \
    if ((++_sp & 255u) == 0u) { if (xb_ld(&(bar)[XB_TMO])) break; if (_sp > XB_SPIN_CAP) { atomicAdd(&(bar)[XB_TMO], 1u); break; } } } } while (0)

struct XcdBarrier {
    unsigned* bar; unsigned x;
    volatile LAS unsigned* st;
};

__device__ __forceinline__ XcdBarrier xcd_barrier_post(unsigned* bar, volatile LAS unsigned* st) {
    XcdBarrier b; b.bar = bar; b.x = xb_xcc_id(); b.st = st;
    if (threadIdx.x == 0) (void)xb_add(&bar[XB_XCNT(b.x)], 1u);
    return b;
}
__device__ __forceinline__ void xcd_barrier_complete(unsigned* bar, unsigned x, unsigned& nloc, unsigned& nx) {
    const unsigned G = gridDim.x * gridDim.y * gridDim.z;
    unsigned sum, cnt, mine, sp = 0u;
    for (;;) {
        sum = 0u; cnt = 0u; mine = 0u;
#pragma unroll
        for (unsigned j = 0; j < 16; ++j) { const unsigned c = xb_ld(&bar[XB_XCNT(j)]); sum += c; cnt += (c > 0u) ? 1u : 0u; mine = (j == x) ? c : mine; }
        if (sum == G) break;
        __builtin_amdgcn_s_sleep(1);
        if ((++sp & 255u) == 0u) { if (xb_ld(&bar[XB_TMO])) break; if (sp > XB_SPIN_CAP) { atomicAdd(&bar[XB_TMO], 1u); break; } }
    }
    nloc = mine > 0u ? mine : 1u; nx = cnt > 0u ? cnt : 1u;
}

__device__ __forceinline__ void xcd_barrier(const XcdBarrier& b) {
    asm volatile("s_waitcnt vmcnt(0)" ::: "memory");
    __syncthreads();
    if (threadIdx.x == 0) {
        unsigned* bar = b.bar;
        __builtin_amdgcn_s_waitcnt(0);
        unsigned nloc = b.st[0], nx = b.st[1];
        if (nloc == 0u) { xcd_barrier_complete(bar, b.x, nloc, nx); b.st[0] = nloc; b.st[1] = nx; }
        const unsigned old = xb_add(&bar[XB_XSUB(b.x)], 1u);
        const unsigned gen = old / nloc;
        if (old + 1u == (gen + 1u) * nloc) {
            __builtin_amdgcn_fence(__ATOMIC_RELEASE, "agent");
            asm volatile("s_waitcnt vmcnt(0)" ::: "memory");
            const unsigned og = xb_add(&bar[XB_TOP], 1u);
            const unsigned tg = og / nx;
            if (og + 1u == (tg + 1u) * nx) xb_add(&bar[XB_TOPGEN], 1u);
            else XB_SPIN(xb_ld(&bar[XB_TOPGEN]) == tg, bar);
            __builtin_amdgcn_fence(__ATOMIC_ACQUIRE, "agent");
            xb_add(&bar[XB_XGEN(b.x)], 1u);
            asm volatile("s_waitcnt vmcnt(0)" ::: "memory");
        } else {
            XB_SPIN(xb_ld(&bar[XB_XGEN(b.x)]) == gen, bar);
            __builtin_amdgcn_fence(__ATOMIC_ACQUIRE, "agent");
            asm volatile("s_waitcnt vmcnt(0)" ::: "memory");
        }
    }
    __syncthreads();
}

__global__ void __launch_bounds__(NTHR, 2) fwd_megakernel(Args args) {
    extern __shared__ __attribute__((aligned(16))) unsigned char lds_raw[];
    cg::grid_group grid = cg::this_grid();
    LAS unsigned char* lds = (LAS unsigned char*)lds_raw;
    const int tid = threadIdx.x, lane = tid & 63, wave = __builtin_amdgcn_readfirstlane(tid >> 6);
    const int G = gridDim.x, gw = blockIdx.x * NWAVES + wave, NGW = G * NWAVES;
    volatile LAS unsigned* MISC = (volatile LAS unsigned*)(lds + 131072 + 320);
    if (tid < 32) MISC[tid] = 0u;
    __syncthreads();
    int n_stamp = 0; (void)n_stamp;
    XcdBarrier bar = xcd_barrier_post((unsigned*)(args.ws + WS_BAR), MISC + 8);
#define A_ws (args.ws)
#define A_x (args.in[0])
#define A_c (args.in[1])
#define A_w_mod (args.in[2])
#define A_b_mod (args.in[3])
#define A_norm1_w (args.in[4])
#define A_norm2_w (args.in[5])
#define A_hg_w_in (args.in[6])
#define A_hg_w_out (args.in[7])
#define A_hg_lb (args.in[8])
#define A_hg_gn_w (args.in[9])
#define A_fox_w_in (args.in[10])
#define A_fox_b_f (args.in[11])
#define A_fox_qn_w (args.in[12])
#define A_fox_kn_w (args.in[13])
#define A_fox_w_out (args.in[14])
#define A_mlp_w1 (args.in[15])
#define A_mlp_w2 (args.in[16])
#define A_final_w (args.in[17])
#define A_out (args.out)
#define MOD ((float*)(A_ws + WS_MOD))
#define LB ((float*)(A_ws + WS_LB))
#define WFZ ((bf16*)(A_ws + WS_WFZ))
#define DN ((float*)(A_ws + WS_DN))
#define LFS ((float*)(A_ws + WS_LFS))
#define NF ((float*)(A_ws + WS_NF))
#define QKNW ((float*)(A_ws + WS_QKNW))
#define W_HGIN ((bf16*)(A_ws + WS_W_HGIN))
#define W_HGOUT ((bf16*)(A_ws + WS_W_HGOUT))
#define W_FOXIN ((bf16*)(A_ws + WS_W_FOXIN))
#define W_FOXOUT ((bf16*)(A_ws + WS_W_FOXOUT))
#define W1_0 ((bf16*)(A_ws + WS_W1_0))
#define W2_0 ((bf16*)(A_ws + WS_W2_0))
#define W1_1 ((bf16*)(A_ws + WS_W1_1))
#define W2_1 ((bf16*)(A_ws + WS_W2_1))
#define XN ((bf16*)(A_ws + WS_XN))
#define QO ((bf16*)(A_ws + WS_QO))
#define B1 ((bf16*)(A_ws + WS_B1))
#define B2 ((bf16*)(A_ws + WS_B2))
#define B3 ((bf16*)(A_ws + WS_B3))
#define ST ((bf16*)(A_ws + WS_ST))
#define HB ((bf16*)(A_ws + WS_H))
#define XN2 ((bf16*)(A_ws + WS_XN2))
#define SSQ ((float*)(A_ws + WS_SS))
#define BIASV ((float*)(A_ws + WS_BIASV))
#ifdef DIAG_TS
#define STAMP() do { if (blockIdx.x == 0 && tid == 0) ((unsigned long long*)(A_ws + WS_QKNW + 2048))[n_stamp] = __builtin_amdgcn_s_memrealtime(); ++n_stamp; } while (0)
#else
#define STAMP() do {} while (0)
#endif
#define GSYNC() do { for (int rs_ = 0; rs_ < REP_SYNC; ++rs_) xcd_barrier(bar); STAMP(); } while (0)
#define GSYNC_CG() do { if (__builtin_expect(args.ws == nullptr, 0)) grid.sync(); xcd_barrier(bar); STAMP(); } while (0)
    for (int rp_ = 0; rp_ < REP_P0; ++rp_) {
        __syncthreads();
        LAS float* sc = (LAS float*)lds;
        LAS float* red = (LAS float*)(lds + 8192);
        for (int it = blockIdx.x; it < 192; it += G) {
            for (int i = tid; i < 2048; i += NTHR) { const float cv = A_c[i]; sc[i] = cv * pg8::sigmoid_f(cv); }
            __syncthreads();
            const int li = it / 96, cgp = it % 96, col = 64 * cgp + lane;
            const float* wp = A_w_mod + ((size_t)li * D + 128 * wave) * 6144 + col;
            float a0 = 0.f, a1 = 0.f;
            for (int k0 = 0; k0 < 128; k0 += 8) {
                float wv[8];
#pragma unroll
                for (int j = 0; j < 8; ++j) wv[j] = wp[(size_t)(k0 + j) * 6144];
#pragma unroll
                for (int j = 0; j < 8; ++j) { a0 += sc[128 * wave + k0 + j] * wv[j]; a1 += sc[1024 + 128 * wave + k0 + j] * wv[j]; }
            }
            red[wave * 128 + lane] = a0; red[wave * 128 + 64 + lane] = a1;
            __syncthreads();
            if (wave == 0) { float s0 = 0.f, s1 = 0.f;
#pragma unroll
                for (int w = 0; w < 8; ++w) { s0 += red[w * 128 + lane]; s1 += red[w * 128 + 64 + lane]; }
                const float bb = A_b_mod[li * 6144 + col];
                MOD[(li * 2 + 0) * 6144 + col] = s0 + bb; MOD[(li * 2 + 1) * 6144 + col] = s1 + bb; }
            __syncthreads();
        }
        if (blockIdx.x == G - 1) {
            for (int i = tid; i < 1024; i += NTHR) { const float a0 = A_hg_lb[i], a1 = A_hg_lb[1024 + i], a2 = A_hg_lb[2048 + i]; const float mx = fmaxf(a0, fmaxf(a1, a2));
                const float e0 = __expf(a0 - mx), e1 = __expf(a1 - mx), e2 = __expf(a2 - mx); LB[i] = e0 / (e0 + e1 + e2); }
        }
        if (blockIdx.x == G - 2) {
            for (int i = tid; i < 16 * 1024; i += NTHR) { const int hh = i >> 10, k = i & 1023; WFZ[i] = (bf16)f2bf(A_fox_w_in[(size_t)k * NIN_FOX + 4096 + hh]); }
            if (tid < 64) { QKNW[tid] = A_fox_qn_w[tid]; QKNW[64 + tid] = A_fox_kn_w[tid]; }
        }
        for (int i = blockIdx.x * NTHR + tid; i < 3 * M; i += G * NTHR) SSQ[i] = 0.f;
        LAS float* scr = (LAS float*)(lds + wave * 16384);
        constexpr int I_A = 16 * 128, I_B = 16 * 32, I_W2 = 64 * 32;
        constexpr int NITEMS = 2 * I_A + 2 * I_B + 2 * I_A + 2 * I_W2;
        for (int it = gw; it < NITEMS; it += NGW) {
            int r = it;
            if (r < I_A) { transpose_item<false>(A_hg_w_in, D, 4096, 4096, W_HGIN, scr, r, lane); continue; } r -= I_A;
            if (r < I_A) { transpose_item<true>(A_fox_w_in, D, NIN_FOX, 4096, W_FOXIN, scr, r, lane); continue; } r -= I_A;
            if (r < I_B) { transpose_item<false>(A_hg_w_out, D, D, D, W_HGOUT, scr, r, lane); continue; } r -= I_B;
            if (r < I_B) { transpose_item<false>(A_fox_w_out, D, D, D, W_FOXOUT, scr, r, lane); continue; } r -= I_B;
            if (r < I_A) { transpose_item<false>(A_mlp_w1, D, FF, FF, W1_0, scr, r, lane); continue; } r -= I_A;
            if (r < I_A) { transpose_item<false>(A_mlp_w1 + (size_t)D * FF, D, FF, FF, W1_1, scr, r, lane); continue; } r -= I_A;
            if (r < I_W2) { transpose_item<false>(A_mlp_w2, FF, D, D, W2_0, scr, r, lane); continue; } r -= I_W2;
            transpose_item<false>(A_mlp_w2 + (size_t)FF * D, FF, D, D, W2_1, scr, r, lane);
        }
    }
    GSYNC_CG();
#define GEMM_PHASE(MODE, Aptr, Bptr, Nn, Kk, EE) GEMM_PHASE_R(1, MODE, Aptr, Bptr, Nn, Kk, EE)
#define GEMM_PHASE_R(RR, MODE, Aptr, Bptr, Nn, Kk, EE) do { for (int rg_ = 0; rg_ < (RR); ++rg_) { pg8::Gemm g_{(const pg8::bf16_t*)(Aptr), (const pg8::bf16_t*)(Bptr), M, (Nn), (Kk)}; pg8::StaticOrder S_; S_.init(M, (Nn), G, (int)blockIdx.x); \
        if (!NO_GEMM) pg8::gemm_phase<pg8::Epi<MODE>, pg8::StaticOrder, true, true>(lds, g_, S_, EE); } } while (0)
    {
        const float* mod = MOD;
        for (int rn_ = 0; rn_ < REP_NORM; ++rn_) norm_rows(gw, NGW, lane, A_x, A_norm1_w, mod + 0, mod + 1024, XN, nullptr);
        for (int t = gw; t < 3 * 4096 + 16; t += NGW) {
            const int gi = t < 3 * 4096 ? t >> 12 : 1, n = t < 3 * 4096 ? (t & 4095) : 4096 + (t - 3 * 4096);
            const bf16* wrow = t >= 3 * 4096 ? WFZ + (size_t)(n - 4096) * D : (gi == 0 ? W1_0 : gi == 1 ? W_FOXIN : W1_1) + (size_t)n * D;
            const float* sh0 = MOD + (gi == 0 ? 3072 : gi == 1 ? 2 * 6144 : 2 * 6144 + 3072);
            float a0 = 0.f, a1 = 0.f;
#pragma unroll
            for (int hh = 0; hh < 2; ++hh) { const v4u wv = *(const GAS v4u*)(wrow + 512 * hh + 8 * lane);
#pragma unroll
                for (int e = 0; e < 4; ++e) { const int k = 512 * hh + 8 * lane + 2 * e; const float w0 = __uint_as_float(wv[e] << 16), w1 = __uint_as_float(wv[e] & 0xffff0000u);
                    a0 += sh0[k] * w0 + sh0[k + 1] * w1; a1 += sh0[6144 + k] * w0 + sh0[6144 + k + 1] * w1; } }
            a0 = wave_sum(a0); a1 = wave_sum(a1);
            if (lane == 0) { BIASV[(gi * 2 + 0) * 4112 + n] = a0; BIASV[(gi * 2 + 1) * 4112 + n] = a1; }
        }
        GSYNC();
        { pg8::Epi<pg8::EPI_HG_IN> E{QO, A_out  , nullptr, LB, 1.f, nullptr, nullptr, nullptr, nullptr, nullptr, nullptr};
          GEMM_PHASE_R(REP_G1, pg8::EPI_HG_IN, XN, W_HGIN, 4096, D, E); }
        GSYNC();
#ifdef HG_OLD
        for (int rh_ = 0; rh_ < REP_HGAB; ++rh_) {
        if (rh_) GSYNC();
        hg_pass_a(lds, tid, lane, wave, A_out, B1, ST, DN);
        GSYNC();
        hg_pass_b(tid, ST, DN);
        }
#else
        for (int rh_ = 0; rh_ < REP_HGAB; ++rh_) {
        if (rh_) GSYNC();
        hg2_pass_a(lds, tid, lane, wave, A_out, B1, (float*)ST, DN);
        GSYNC();
        hg2_pass_b(tid, (float*)ST, DN);
        }
#endif
#ifdef DIAG_HG
        if (blockIdx.x == 0) diag_hg_naive(lds, tid, A_out, QO, B1, B2, A_hg_gn_w, (float*)(A_ws + WS_XN));
#endif
        GSYNC();
#ifndef NO_HGC
#ifdef HG_OLD
        for (int rc_ = 0; rc_ < REP_HGC; ++rc_) hg_pass_c(lds, tid, lane, wave, A_out, QO, XN, B1, B2, ST, A_hg_gn_w);
#else
        for (int rc_ = 0; rc_ < REP_HGC; ++rc_) hg2_pass_c(lds, tid, lane, wave, A_out, QO, XN, B1, B2, (const float*)ST, A_hg_gn_w);
#endif
#endif
        GSYNC();
#ifdef DIAG_HG
        if (blockIdx.x == 0) diag_hg_cmp(lds, tid, QO, (const float*)(A_ws + WS_XN), (float*)(A_ws + WS_QKNW + 1024));
#endif
        for (int rr_ = 1; rr_ < REP_R1; ++rr_) { pg8::Epi<pg8::EPI_RES> E{nullptr, A_out, A_x, mod + 2048, 1.f, XN2, DN  , A_norm2_w, mod + 4096, nullptr, nullptr};
          GEMM_PHASE(pg8::EPI_RES, XN, W_HGOUT, D, D, E); }
        { pg8::Epi<pg8::EPI_RES> E{nullptr, A_out, A_x, mod + 2048, 1.f, XN2, SSQ + 0 * M, A_norm2_w, mod + 4096, nullptr, nullptr};
          GEMM_PHASE(pg8::EPI_RES, XN, W_HGOUT, D, D, E); }
        GSYNC();
        { pg8::Epi<pg8::EPI_RELU2> E{HB, nullptr, nullptr, nullptr, 1.f, nullptr, nullptr, nullptr, nullptr, SSQ + 0 * M, BIASV + 0 * 2 * 4112};
          GEMM_PHASE_R(REP_G2, pg8::EPI_RELU2, XN2, W1_0, FF, D, E); }
        GSYNC();
        { pg8::Epi<pg8::EPI_RES> E{nullptr, A_out, A_out, mod + 5120, 1.f, XN, SSQ + 1 * M, A_norm1_w + D, MOD + 2 * 6144 + 1024, nullptr, nullptr};
          GEMM_PHASE(pg8::EPI_RES, HB, W2_0, D, FF, E); }
        GSYNC();
    }
    {
        const float* mod = MOD + 2 * 6144;
        { pg8::Epi<pg8::EPI_FOX_IN> E{QO, nullptr, nullptr, QKNW, attn_body::C2, nullptr, nullptr, nullptr, nullptr, SSQ + 1 * M, BIASV + 1 * 2 * 4112};
          GEMM_PHASE_R(REP_G3, pg8::EPI_FOX_IN, XN, W_FOXIN, 4096, D, E); }
        for (int rz_ = 0; rz_ < REP_SCAN; ++rz_) fox_fz_tail(lane, wave, XN, WFZ, A_fox_b_f, LFS, SSQ + 1 * M, BIASV + 1 * 2 * 4112 + 4096);
        GSYNC();
        { const attn_body::AttnTensors AT{(const attn_body::bf16*)QO, (const attn_body::bf16*)B1, (const attn_body::bf16*)B2, (attn_body::bf16*)XN, LFS  , (const attn_body::bf16*)B3};
          const attn_body::StaticOrder S((int)G, (int)blockIdx.x);
#ifndef NO_ATTN
          attn_body::attn_phase<attn_body::StaticOrder, ATT_THRL>((char*)lds_raw, AT, S);
#if REP_ATT > 1
          asm volatile("s_waitcnt vmcnt(0) lgkmcnt(0)\n\ts_barrier" ::: "memory");
          attn_body::attn_phase<attn_body::StaticOrder, ATT_THRL>((char*)lds_raw, AT, S);
#endif
#endif
        }
        GSYNC();
        { pg8::Epi<pg8::EPI_RES> E{nullptr, A_out, A_out, mod + 2048, 1.f, XN2, SSQ + 2 * M, A_norm2_w + D, mod + 4096, nullptr, nullptr};
          GEMM_PHASE(pg8::EPI_RES, XN, W_FOXOUT, D, D, E); }
        GSYNC();
        { pg8::Epi<pg8::EPI_RELU2> E{HB, nullptr, nullptr, nullptr, 1.f, nullptr, nullptr, nullptr, nullptr, SSQ + 2 * M, BIASV + 2 * 2 * 4112};
          GEMM_PHASE_R(REP_G4, pg8::EPI_RELU2, XN2, W1_1, FF, D, E); }
        GSYNC();
        { pg8::Epi<pg8::EPI_RES> E{nullptr, A_out, A_out, mod + 5120, 1.f, nullptr, nullptr, nullptr, nullptr, nullptr, nullptr};
          GEMM_PHASE(pg8::EPI_RES, HB, W2_1, D, FF, E); }
        GSYNC();
    }
    norm_rows(gw, NGW, lane, A_out, A_final_w, nullptr, nullptr, nullptr, A_out);
#if defined(DIAG_HG) || defined(DIAG_ATT)
    GSYNC();
    if (blockIdx.x == 0 && tid == 0) A_out[0] = 1000.0f * (20.0f + log2f(*(const float*)(A_ws + WS_QKNW + 1024) + 1e-9f));
#endif
#ifdef DIAG_TS
    GSYNC();
    if (blockIdx.x == 0 && tid == 0) { const unsigned long long* ts_ = (const unsigned long long*)(A_ws + WS_QKNW + 2048); A_out[0] = 1000.0f * 32.0f * (float)(((ts_[DIAG_TB] - ts_[DIAG_TA]) + 1600ull) / 3200ull); }
#endif
}

#undef A_ws
#undef A_x
#undef A_c
#undef A_w_mod
#undef A_b_mod
#undef A_norm1_w
#undef A_norm2_w
#undef A_hg_w_in
#undef A_hg_w_out
#undef A_hg_lb
#undef A_hg_gn_w
#undef A_fox_w_in
#undef A_fox_b_f
#undef A_fox_qn_w
#undef A_fox_kn_w
#undef A_fox_w_out
#undef A_mlp_w1
#undef A_mlp_w2
#undef A_final_w
#undef A_out
extern "C" void kernel_launch(void* const* d_in, const int* in_sizes, int n_in, void* d_out, int out_size, void* d_ws, size_t ws_size, hipStream_t stream) {
    static int grid = 0;
    if (grid == 0) {
        if (n_in != 18 || out_size != M * D || ws_size < WS_END) { fprintf(stderr, "kernel_launch: unexpected shapes (n_in %d, out %d, ws %zu)\n", n_in, out_size, ws_size); grid = -1; return; }
        int dev = 0, cus = 0, per_cu = 0;
        hipGetDevice(&dev); hipDeviceGetAttribute(&cus, hipDeviceAttributeMultiprocessorCount, dev);
        if (hipFuncSetAttribute((const void*)fwd_megakernel, hipFuncAttributeMaxDynamicSharedMemorySize, LDS_BYTES) != hipSuccess) { fprintf(stderr, "kernel_launch: hipFuncSetAttribute failed\n"); grid = -1; return; }
        if (hipOccupancyMaxActiveBlocksPerMultiprocessor(&per_cu, (const void*)fwd_megakernel, NTHR, LDS_BYTES) != hipSuccess || per_cu < 1) { fprintf(stderr, "kernel_launch: occupancy query says %d\n", per_cu); per_cu = 1; }
        (void)hipGetLastError();
        grid = cus * 1;
        if (grid != 256) fprintf(stderr, "kernel_launch: %d CUs; built for 256\n", grid);
    }
    if (grid < 0) return;
    if (hipMemsetAsync((char*)d_ws + WS_BAR, 0, BAR_BYTES, stream) != hipSuccess) { fprintf(stderr, "kernel_launch: memset of the barrier words failed\n"); return; }
    Args a{};
    for (int i = 0; i < 18; ++i) a.in[i] = (const float*)d_in[i];
    a.out = (float*)d_out; a.ws = (unsigned char*)d_ws;
    void* kargs[] = {&a};
    hipError_t e = hipLaunchCooperativeKernel((const void*)fwd_megakernel, dim3(grid), dim3(NTHR), kargs, LDS_BYTES, stream);
    if (e != hipSuccess) fprintf(stderr, "cooperative launch failed: %s (grid %d)\n", hipGetErrorString(e), grid);
}
```
